# Optimizing an MI355X kernel written in HIP

```python
import jax, jax.numpy as jnp
from jax import lax
import numpy as np

D_MODEL = 2048
BATCH = 4
SEQ = 2048
DEPTH = 2
DEC_BATCH = 8
DEC_SEQ = 4
PAST_LEN = 16384
PAGE_SIZE = 128

N_EVEN = (DEPTH + 1) // 2
N_ODD = DEPTH // 2
MIX_WIDTH = D_MODEL
A_WIDTH = MIX_WIDTH // 2
CHUNK = 128
A_GROUPS = 8
A_GROUP_DIM = A_WIDTH // A_GROUPS
SB_HEAD_DIM = 128
SB_HEADS = (MIX_WIDTH // 2) // SB_HEAD_DIM
SB_WIDTH = SB_HEADS * SB_HEAD_DIM
SB_SCALE = SB_HEAD_DIM ** -0.5
SB_BIAS_INIT = -8.0
Q_BLOCK = 128
POOL_WINDOWS = (2, 4, 8, 16)
C_GROUPS = 4
C_WIDTH = MIX_WIDTH // 2
C_GROUP_DIM = C_WIDTH // C_GROUPS
POOL_BUF = max(POOL_WINDOWS) - 1
D_WIDTH = MIX_WIDTH // 2
CONV_WIDTH = 3
FFN_DIM = 5632
EPS = 1e-6
EVEN_IN = 3 * SB_WIDTH + 2 * A_WIDTH
ODD_IN = C_WIDTH + 3 * D_WIDTH

kernel_name = 'hybrid_gmlp_stickbreak_pool_shortconv_step'


def rms_norm(x, g):
    xf = x.astype(jnp.float32)
    y = xf * lax.rsqrt(jnp.mean(xf * xf, axis=-1, keepdims=True) + EPS)
    return (y * g.astype(jnp.float32)).astype(x.dtype)


def swiglu(h, w_gate, w_up, w_down):
    return (jax.nn.silu(h @ w_gate) * (h @ w_up)) @ w_down


def sb_weights(z, mask):
    log_keep = jnp.where(mask, jax.nn.log_sigmoid(-z), 0.0)
    later = lax.cumsum(log_keep, axis=z.ndim - 1, reverse=True) - log_keep
    return jnp.where(mask, jnp.exp(jax.nn.log_sigmoid(z) + later), 0.0)


def sb_prompt(q, k, v, bias):
    b, T, H, Dh = q.shape
    nb = T // Q_BLOCK
    k_pos = jnp.arange(T)
    qb = q.reshape(b, nb, Q_BLOCK, H, Dh).swapaxes(0, 1)
    bias_f = bias.astype(jnp.float32)[None, :, None, None]

    def block(args):
        qi, blk = args
        q_pos = blk * Q_BLOCK + jnp.arange(Q_BLOCK)
        z = jnp.einsum('bqhd,bkhd->bhqk', qi, k).astype(jnp.float32) * SB_SCALE + bias_f
        a = sb_weights(z, k_pos[None, :] < q_pos[:, None])
        return jnp.einsum('bhqk,bkhd->bqhd', a.astype(v.dtype), v)

    out = lax.map(block, (qb, jnp.arange(nb)))
    return out.swapaxes(0, 1).reshape(b, T, H * Dh)


def sb_sample(q, k_new, v_new, k_past, v_past, bias):
    b, Tq, H, Dh = q.shape
    P = k_past.shape[1]
    z = jnp.concatenate([jnp.einsum('bqhd,bkhd->bhqk', q, k_past),
                         jnp.einsum('bqhd,bkhd->bhqk', q, k_new)], axis=-1).astype(jnp.float32) * SB_SCALE
    z = z + bias.astype(jnp.float32)[None, :, None, None]
    q_pos = P + jnp.arange(Tq)
    k_pos = jnp.arange(P + Tq)
    a = sb_weights(z, k_pos[None, :] < q_pos[:, None]).astype(v_new.dtype)
    out = (jnp.einsum('bhqk,bkhd->bqhd', a[..., :P], v_past)
           + jnp.einsum('bhqk,bkhd->bqhd', a[..., P:], v_new))
    return out.reshape(b, Tq, H * Dh)


def chunk_gating(au, av, ws, bs, rows):
    b, T, _ = av.shape
    nc = T // rows
    causal = jnp.tril(jnp.ones((rows, rows), dtype=bool))
    w = jnp.where(causal, ws[:, :rows, :rows], 0.0).astype(av.dtype)
    v = av.reshape(b, nc, rows, A_GROUPS, A_GROUP_DIM)
    mix = jnp.einsum('gpq,bcqgd->bcpgd', w, v) + bs[:, :rows].T[:, :, None]
    return au * mix.reshape(b, T, A_WIDTH)


def even_project(h, w_in, q_g, k_g, av_g):
    b, T, _ = h.shape
    p = h @ w_in
    q, k, v, au, av = jnp.split(p, [SB_WIDTH, 2 * SB_WIDTH, 3 * SB_WIDTH, 3 * SB_WIDTH + A_WIDTH], axis=-1)
    q = rms_norm(q.reshape(b, T, SB_HEADS, SB_HEAD_DIM), q_g)
    k = rms_norm(k.reshape(b, T, SB_HEADS, SB_HEAD_DIM), k_g)
    v = v.reshape(b, T, SB_HEADS, SB_HEAD_DIM)
    au = jax.nn.gelu(au)
    av = rms_norm(jax.nn.gelu(av), av_g)
    return q, k, v, au, av


def pool_mix(xc, prev, pos0, c_wg, c_scale):
    full = xc if prev is None else jnp.concatenate([prev, xc], axis=1)
    b, T, _ = xc.shape
    L = full.shape[1] - T
    ff = full.astype(jnp.float32).reshape(b, L + T, C_GROUPS, C_GROUP_DIM)
    cs = jnp.concatenate([jnp.zeros_like(ff[:, :1]), jnp.cumsum(ff, axis=1)], axis=1)
    win = jnp.array(POOL_WINDOWS, dtype=jnp.int32)
    hi = L + jnp.arange(T) + 1
    lo = jnp.maximum(hi[:, None] - win[None, :], 0)
    s = cs[:, hi] - cs[:, lo, jnp.arange(C_GROUPS)]
    count = jnp.minimum(pos0 + jnp.arange(T)[:, None] + 1, win[None, :]).astype(jnp.float32)
    pooled = (s / count[..., None] - ff[:, L:]).astype(xc.dtype)
    mixed = jnp.einsum('btgi,gio->btgo', pooled, c_wg).reshape(b, T, C_WIDTH) * c_scale
    return mixed, full[:, -POOL_BUF:]


def short_conv(g, prev, w):
    T = g.shape[1]
    full = jnp.concatenate([prev, g], axis=1)
    out = full[:, 0:T] * w[0]
    for tap in range(1, CONV_WIDTH):
        out = out + full[:, tap:tap + T] * w[tap]
    return out, full[:, -(CONV_WIDTH - 1):]


def odd_mixer(h, w_in, w_out, c_wg, c_scale, d_conv_w, pool_prev, conv_prev, pos0):
    p = h @ w_in
    xc, gb, gc, gh = jnp.split(p, [C_WIDTH, C_WIDTH + D_WIDTH, C_WIDTH + 2 * D_WIDTH], axis=-1)
    c_out, pool_state = pool_mix(xc, pool_prev, pos0, c_wg, c_scale)
    conv_out, conv_state = short_conv(gc * gh, conv_prev, d_conv_w)
    d_out = gb * conv_out
    return jnp.concatenate([c_out, d_out], axis=-1) @ w_out, pool_state, conv_state


def setup_inputs(seed: int = 0) -> dict:
    key = jax.random.key(seed)
    ks = jax.random.split(key, 24)
    f32 = jnp.float32
    n_pages = PAST_LEN // PAGE_SIZE
    n_used = DEC_BATCH * n_pages
    n_phys = n_used + max(1, n_used // 4)

    def dense(k, shape, fan_in):
        return jax.random.normal(k, shape, f32) * (fan_in ** -0.5)

    def gain(k, shape):
        return 1.0 + 0.05 * jax.random.normal(k, shape, f32)

    page_table = jax.random.permutation(ks[6], n_phys)[:n_used].reshape(DEC_BATCH, n_pages).astype(jnp.int32)
    return {
        'x_prompt': jax.random.normal(ks[0], (BATCH, SEQ, D_MODEL), f32),
        'x_sample': jax.random.normal(ks[1], (DEC_BATCH, DEC_SEQ, D_MODEL), f32),
        'cache_k': jax.random.normal(ks[2], (N_EVEN, n_phys, PAGE_SIZE, SB_HEADS, SB_HEAD_DIM), f32),
        'cache_v': jax.random.normal(ks[3], (N_EVEN, n_phys, PAGE_SIZE, SB_HEADS, SB_HEAD_DIM), f32),
        'state_pool': jax.random.normal(ks[4], (N_ODD, DEC_BATCH, POOL_BUF, C_WIDTH), f32),
        'state_conv': jax.random.normal(ks[5], (N_ODD, DEC_BATCH, CONV_WIDTH - 1, D_WIDTH), f32),
        'page_table': page_table,
        'norm_g': gain(ks[7], (DEPTH, 3, D_MODEL)),
        'ffn_w_gate': dense(ks[8], (DEPTH, 2, D_MODEL, FFN_DIM), D_MODEL),
        'ffn_w_up': dense(ks[9], (DEPTH, 2, D_MODEL, FFN_DIM), D_MODEL),
        'ffn_w_down': dense(ks[10], (DEPTH, 2, FFN_DIM, D_MODEL), FFN_DIM),
        'w_in_even': dense(ks[11], (N_EVEN, D_MODEL, EVEN_IN), D_MODEL),
        'w_out_even': dense(ks[12], (N_EVEN, A_WIDTH + SB_WIDTH, D_MODEL), A_WIDTH + SB_WIDTH),
        'q_norm_g': gain(ks[13], (N_EVEN, SB_HEAD_DIM)),
        'k_norm_g': gain(ks[14], (N_EVEN, SB_HEAD_DIM)),
        'sb_bias': SB_BIAS_INIT + 0.1 * jax.random.normal(ks[23], (N_EVEN, SB_HEADS), f32),
        'a_v_norm_g': gain(ks[15], (N_EVEN, A_WIDTH)),
        'a_ws': dense(ks[16], (N_EVEN, A_GROUPS, CHUNK, CHUNK), CHUNK),
        'a_bs': 1.0 + 0.02 * jax.random.normal(ks[17], (N_EVEN, A_GROUPS, CHUNK), f32),
        'w_in_odd': dense(ks[18], (N_ODD, D_MODEL, ODD_IN), D_MODEL),
        'w_out_odd': dense(ks[19], (N_ODD, C_WIDTH + D_WIDTH, D_MODEL), C_WIDTH + D_WIDTH),
        'c_wg': dense(ks[20], (N_ODD, C_GROUPS, C_GROUP_DIM, C_GROUP_DIM), C_GROUP_DIM),
        'c_scale': gain(ks[21], (N_ODD, C_WIDTH)),
        'd_conv_w': dense(ks[22], (N_ODD, CONV_WIDTH, D_WIDTH), CONV_WIDTH),
    }


def reference(x_prompt, x_sample, cache_k, cache_v, state_pool, state_conv, page_table,
              norm_g, ffn_w_gate, ffn_w_up, ffn_w_down,
              w_in_even, w_out_even, q_norm_g, k_norm_g, sb_bias, a_v_norm_g, a_ws, a_bs,
              w_in_odd, w_out_odd, c_wg, c_scale, d_conv_w):
    yp, ys = x_prompt, x_sample
    n_pages = page_table.shape[1]
    kp_l, vp_l, ks_l, vs_l, av_l = [], [], [], [], []
    pp_l, ps_l, cp_l, cs_l = [], [], [], []
    for layer in range(DEPTH):
        i = layer // 2
        yp = yp + 0.5 * swiglu(rms_norm(yp, norm_g[layer, 0]), ffn_w_gate[layer, 0], ffn_w_up[layer, 0], ffn_w_down[layer, 0])
        ys = ys + 0.5 * swiglu(rms_norm(ys, norm_g[layer, 0]), ffn_w_gate[layer, 0], ffn_w_up[layer, 0], ffn_w_down[layer, 0])
        hp = rms_norm(yp, norm_g[layer, 1])
        hs = rms_norm(ys, norm_g[layer, 1])
        if layer % 2 == 0:
            q, k, v, au, av = even_project(hp, w_in_even[i], q_norm_g[i], k_norm_g[i], a_v_norm_g[i])
            mix = jnp.concatenate([chunk_gating(au, av, a_ws[i], a_bs[i], CHUNK), sb_prompt(q, k, v, sb_bias[i])], axis=-1)
            yp = yp + mix @ w_out_even[i]
            kp_l.append(k)
            vp_l.append(v)
            q, k, v, au, av = even_project(hs, w_in_even[i], q_norm_g[i], k_norm_g[i], a_v_norm_g[i])
            k_past = cache_k[i][page_table].reshape(DEC_BATCH, n_pages * PAGE_SIZE, SB_HEADS, SB_HEAD_DIM)
            v_past = cache_v[i][page_table].reshape(DEC_BATCH, n_pages * PAGE_SIZE, SB_HEADS, SB_HEAD_DIM)
            mix = jnp.concatenate([chunk_gating(au, av, a_ws[i], a_bs[i], hs.shape[1]),
                                   sb_sample(q, k, v, k_past, v_past, sb_bias[i])], axis=-1)
            ys = ys + mix @ w_out_even[i]
            ks_l.append(k)
            vs_l.append(v)
            av_l.append(av)
        else:
            conv0 = jnp.zeros((hp.shape[0], CONV_WIDTH - 1, D_WIDTH), hp.dtype)
            m, pst, cst = odd_mixer(hp, w_in_odd[i], w_out_odd[i], c_wg[i], c_scale[i], d_conv_w[i], None, conv0, 0)
            yp = yp + m
            pp_l.append(pst)
            cp_l.append(cst)
            m, pst, cst = odd_mixer(hs, w_in_odd[i], w_out_odd[i], c_wg[i], c_scale[i], d_conv_w[i],
                                    state_pool[i], state_conv[i], PAST_LEN)
            ys = ys + m
            ps_l.append(pst)
            cs_l.append(cst)
        yp = yp + 0.5 * swiglu(rms_norm(yp, norm_g[layer, 2]), ffn_w_gate[layer, 1], ffn_w_up[layer, 1], ffn_w_down[layer, 1])
        ys = ys + 0.5 * swiglu(rms_norm(ys, norm_g[layer, 2]), ffn_w_gate[layer, 1], ffn_w_up[layer, 1], ffn_w_down[layer, 1])
    new_k_prompt = jnp.stack(kp_l)
    new_v_prompt = jnp.stack(vp_l)
    new_k_sample = jnp.stack(ks_l)
    new_v_sample = jnp.stack(vs_l)
    new_a_v_sample = jnp.stack(av_l)
    new_pool_prompt = jnp.stack(pp_l)
    new_pool_sample = jnp.stack(ps_l)
    new_conv_prompt = jnp.stack(cp_l)
    new_conv_sample = jnp.stack(cs_l)
    return (yp, ys, new_k_prompt, new_v_prompt, new_k_sample, new_v_sample, new_a_v_sample,
            new_pool_prompt, new_pool_sample, new_conv_prompt, new_conv_sample)
```

```cpp
#include <hip/hip_runtime.h>
#include <cstdio>
#include <cstdint>

#define GAS __attribute__((address_space(1)))
#define LAS __attribute__((address_space(3)))
typedef unsigned short bf16_t;
typedef short bf16x8 __attribute__((ext_vector_type(8)));
typedef short s16x4 __attribute__((ext_vector_type(4)));
typedef float f32x4 __attribute__((ext_vector_type(4)));
typedef float f32x2 __attribute__((ext_vector_type(2)));
typedef float f32x16 __attribute__((ext_vector_type(16)));
typedef unsigned u32x4 __attribute__((ext_vector_type(4)));
typedef unsigned u32x2 __attribute__((ext_vector_type(2)));

constexpr int DM = 2048, FF = 5632, SEQ = 2048, NBATCH = 4, MP = 8192, MS = 32, MT = 8448, NPAN = 33;
constexpr int NH = 8, HD = 128, AW = 1024, NPAGES = 128, PAGE = 128, DECB = 8, DECS = 4;
constexpr float EPS = 1e-6f;
constexpr float LOG2E = 1.4426950408889634f;
constexpr float QSCALE = 0.08838834764831845f * LOG2E;
constexpr size_t O_YP = 0, O_YS = 16777216, O_KP = 16842752, O_VP = 25231360, O_KS = 33619968, O_VS = 33652736, O_AV = 33685504,
                 O_PP = 33718272, O_PS = 33779712, O_CP = 33902592, O_CS = 33910784, O_END = 33927168;

constexpr size_t al(size_t x) { return (x + 1048575) & ~(size_t)1048575; }
constexpr size_t WS_CTL = 0, CTL_BYTES = 1048576;
constexpr size_t SZ_WGU = (size_t)2 * FF * DM * 2, SZ_WD = (size_t)DM * FF * 2;
constexpr size_t WS_WGU = al(WS_CTL + CTL_BYTES);
constexpr size_t WS_WD = al(WS_WGU + 4 * SZ_WGU);
constexpr size_t WS_WINE = al(WS_WD + 4 * SZ_WD);
constexpr size_t WS_WOUTE = al(WS_WINE + (size_t)5120 * DM * 2);
constexpr size_t WS_WINO = al(WS_WOUTE + (size_t)DM * DM * 2);
constexpr size_t WS_WOUTO = al(WS_WINO + (size_t)4096 * DM * 2);
constexpr size_t WS_AWS = al(WS_WOUTO + (size_t)DM * DM * 2);
constexpr size_t WS_CWGT = al(WS_AWS + 8 * 128 * 128 * 2);
constexpr size_t WS_XN = al(WS_CWGT + 1024 * 256 * 2);
constexpr size_t WS_ACT = al(WS_XN + (size_t)MT * DM * 2);
constexpr size_t WS_Y = al(WS_ACT + (size_t)MT * FF * 2);
constexpr size_t SZ_T = (size_t)MT * 1024 * 2;
constexpr size_t WS_T0 = al(WS_Y + (size_t)MT * DM * 4);
constexpr size_t WS_T1 = al(WS_T0 + SZ_T);
constexpr size_t WS_T2 = al(WS_T1 + SZ_T);
constexpr size_t WS_T3 = al(WS_T2 + SZ_T);
constexpr size_t WS_T4 = al(WS_T3 + SZ_T);
constexpr size_t WS_MIX = al(WS_T4 + SZ_T);
constexpr size_t WS_PO = al(WS_MIX + (size_t)MT * DM * 2);
constexpr size_t WS_PP = al(WS_PO + (size_t)64 * 32 * 4 * 128 * 4);
constexpr size_t WS_END = al(WS_PP + 64 * 32 * 4 * 4);
constexpr int CW_BAR = 4096, CW_QCTR = 8192, CW_SUMSQ = 16384, CW_AVSQ = 16384 + 6 * MT + 512;
static_assert((CW_AVSQ + MT) * 4 <= (int)CTL_BYTES, "ctl");

constexpr int RING_BYTES = 131072, RED_OFF = RING_BYTES, RED_BYTES = 8192, MISC_OFF = RED_OFF + RED_BYTES, LDS_BYTES = 147456;

#define LDS_WAIT() asm volatile("s_waitcnt lgkmcnt(0)" ::: "memory")
#define VM_WAIT() asm volatile("s_waitcnt vmcnt(0)" ::: "memory")
__device__ __forceinline__ unsigned cvt_pk_bf16(float lo, float hi) { unsigned r; asm volatile("v_cvt_pk_bf16_f32 %0, %1, %2" : "=v"(r) : "v"(lo), "v"(hi)); return r; }
__device__ __forceinline__ float bf_lo(unsigned w) { return __uint_as_float(w << 16); }
__device__ __forceinline__ float bf_hi(unsigned w) { return __uint_as_float(w & 0xffff0000u); }
__device__ __forceinline__ float fast_rcp(float x) { return __builtin_amdgcn_rcpf(x); }
__device__ __forceinline__ float fast_exp2(float x) { return __builtin_amdgcn_exp2f(x); }
__device__ __forceinline__ float gelu_tanh(float x) {
    const float t = x * (1.0f + 0.044715f * x * x) * (-2.0f * 0.7978845608028654f * LOG2E);
    return x * fast_rcp(1.0f + fast_exp2(t));
}
__device__ __forceinline__ float xchg32(float x, int hi) {
    auto rr = __builtin_amdgcn_permlane32_swap(__float_as_uint(x), __float_as_uint(x), false, false);
    return __uint_as_float(hi ? rr[0] : rr[1]);
}

#define XB_TMO      128
#define XB_XCNT(j)  (256  + 64 * (j))
#define XB_XSUB(j)  (1280 + 64 * (j))
#define XB_XGEN(j)  (2304 + 64 * (j))
#define XB_TOP      3328
#define XB_TOPGEN   3392
#define XCD_BAR_WORDS 3456
#define XB_SPIN_CAP (1u << 22)
__device__ __forceinline__ unsigned xb_ld(unsigned* p)              { return __hip_atomic_load(p, __ATOMIC_RELAXED, __HIP_MEMORY_SCOPE_AGENT); }
__device__ __forceinline__ unsigned xb_add(unsigned* p, unsigned v) { return __hip_atomic_fetch_add(p, v, __ATOMIC_RELAXED, __HIP_MEMORY_SCOPE_AGENT); }
__device__ __forceinline__ unsigned xb_xcc_id() { return (unsigned)__builtin_amdgcn_s_getreg((3 << 11) | 20) & 0xFu; }
#define XB_SPIN(cond, bar) do { unsigned _sp = 0; while (cond) { __builtin_amdgcn_s_sleep(1); \
    if ((++_sp & 255u) == 0u) { if (xb_ld(&(bar)[XB_TMO])) break; if (_sp > XB_SPIN_CAP) { atomicAdd(&(bar)[XB_TMO], 1u); break; } } } } while (0)
struct XcdBarrier { unsigned* bar; unsigned x; volatile LAS unsigned* st; };
__device__ __forceinline__ XcdBarrier xcd_barrier_post(unsigned* bar, volatile LAS unsigned* st) {
    XcdBarrier b; b.bar = bar; b.x = xb_xcc_id(); b.st = st;
    if (threadIdx.x == 0) (void)xb_add(&bar[XB_XCNT(b.x)], 1u);
    return b;
}
__device__ __forceinline__ void xcd_barrier_complete(unsigned* bar, unsigned x, unsigned& nloc, unsigned& nx) {
    const unsigned G = gridDim.x * gridDim.y * gridDim.z;
    unsigned sum, cnt, mine, sp = 0u;
    for (;;) {
        sum = 0u; cnt = 0u; mine = 0u;
#pragma unroll
        for (unsigned j = 0; j < 16; ++j) { const unsigned c = xb_ld(&bar[XB_XCNT(j)]); sum += c; cnt += (c > 0u) ? 1u : 0u; }
        mine = xb_ld(&bar[XB_XCNT(x)]);
        if (sum == G) break;
        __builtin_amdgcn_s_sleep(1);
        if ((++sp & 255u) == 0u) { if (xb_ld(&bar[XB_TMO])) break; if (sp > XB_SPIN_CAP) { atomicAdd(&bar[XB_TMO], 1u); break; } }
    }
    nloc = mine > 0u ? mine : 1u; nx = cnt > 0u ? cnt : 1u;
}
__device__ __forceinline__ void xcd_barrier(const XcdBarrier& b) {
    asm volatile("s_waitcnt vmcnt(0)" ::: "memory");
    __syncthreads();
    if (threadIdx.x == 0) {
        unsigned* bar = b.bar; asm volatile("" : "+s"(bar));
        unsigned bx_; asm volatile("s_getreg_b32 %0, hwreg(20, 0, 4)" : "=s"(bx_));
        bx_ &= 0xFu;
        __builtin_amdgcn_s_waitcnt(0);
        unsigned nloc = b.st[0], nx = b.st[1];
        if (nloc == 0u) { xcd_barrier_complete(bar, bx_, nloc, nx); b.st[0] = nloc; b.st[1] = nx; }
        const unsigned old = xb_add(&bar[XB_XSUB(bx_)], 1u);
        const unsigned gen = old / nloc;
        if (old + 1u == (gen + 1u) * nloc) {
            __builtin_amdgcn_fence(__ATOMIC_RELEASE, "agent");
            asm volatile("s_waitcnt vmcnt(0)" ::: "memory");
            const unsigned og = xb_add(&bar[XB_TOP], 1u);
            const unsigned tg = og / nx;
            if (og + 1u == (tg + 1u) * nx) xb_add(&bar[XB_TOPGEN], 1u);
            else XB_SPIN(xb_ld(&bar[XB_TOPGEN]) == tg, bar);
            __builtin_amdgcn_fence(__ATOMIC_ACQUIRE, "agent");
            xb_add(&bar[XB_XGEN(bx_)], 1u);
            asm volatile("s_waitcnt vmcnt(0)" ::: "memory");
        } else {
            XB_SPIN(xb_ld(&bar[XB_XGEN(bx_)]) == gen, bar);
            __builtin_amdgcn_fence(__ATOMIC_ACQUIRE, "agent");
            asm volatile("s_waitcnt vmcnt(0)" ::: "memory");
        }
    }
    __syncthreads();
}

namespace pg8 {
constexpr int BM = 256, BK = 64, HALF = 128, HTB = HALF * BK * 2, NXCD = 8, WGM = 8;
__host__ __device__ __forceinline__ int lds_byte(int r, int c) { const int st = (r >> 4) * 2 + (c >> 5), rr = r & 15, cc = c & 31, ob = rr * 64 + cc * 2; return st * 1024 + (ob ^ (((ob >> 9) & 1) << 5)); }
__host__ __device__ __forceinline__ void stage_rc(int b, int& R, int& C) { const int st = b / 1024, sb = b % 1024, swz = sb ^ (((sb >> 9) & 1) << 5); R = (st >> 1) * 16 + swz / 64; C = (st & 1) * 32 + (swz % 64) / 2; }
__host__ __device__ __forceinline__ int perm32(int rho) { const int n = rho >> 4, i = rho & 15; return 8 * (i >> 2) + 4 * n + (i & 3); }
struct Unit { int pm, pn; };
struct Gemm { const bf16_t* A; const bf16_t* Bt; int lda, ldb, K, acs; };
struct StaticOrder {
    int nM, nN, nwg, G, c;
    __device__ __forceinline__ void init(int nM_, int nN_, int G_, int c_) { asm volatile("" : "+s"(G_), "+s"(c_)); nM = nM_; nN = nN_; nwg = nM * nN; G = G_; c = c_; }
    __device__ __forceinline__ bool next(int i, Unit& u) const {
        const long L = (long)i * G + c; if (L >= nwg) return false;
        int wgid = (int)L; { const int q = nwg / NXCD, r = nwg % NXCD, xcd = wgid % NXCD, off = wgid / NXCD; wgid = (xcd < r ? xcd * (q + 1) : r * (q + 1) + (xcd - r) * q) + off; }
        const int nig = WGM * nN, gid = wgid / nig, fm = gid * WGM, gsz = (nM - fm) < WGM ? (nM - fm) : WGM;
        u.pm = fm + ((wgid % nig) % gsz); u.pn = (wgid % nig) / gsz; return true;
    }
};
template <class Epi>
__device__ __forceinline__ void gemm_phase(LAS unsigned char* lds, const Gemm g, const StaticOrder& S, const Epi& E) {
    int tid = threadIdx.x; asm volatile("" : "+v"(tid));
    const int wid = __builtin_amdgcn_readfirstlane(tid >> 6), lane = tid & 63, wr = wid >> 2, wc = wid & 3, fr = lane & 15, fq = lane >> 4;
    int K = g.K; asm volatile("" : "+s"(K)); const int nt = K / BK;
    unsigned voffA[2], voffB[2];
#pragma unroll
    for (int i = 0; i < 2; ++i) { int R, C; stage_rc(tid * 16 + i * 8192, R, C); const int Rb = (R & ~31) + perm32(R & 31);
        voffA[i] = (unsigned)(R * g.lda + C) * 2u; voffB[i] = (unsigned)(Rb * g.ldb + C) * 2u; }
    const size_t kstep = (size_t)(BK * 2);
    const size_t hstepA = (size_t)HALF * g.lda * 2, hstepB = (size_t)HALF * g.ldb * 2;
    const size_t tstepA = 2 * hstepA, tstepB = 2 * hstepB;
    const unsigned ldsw = (unsigned)wid * 1024u;
    const int aoff = lds_byte(wr * 64 + fr, fq * 8), boff = lds_byte(wc * 32 + fr, fq * 8);
#define PG8_SA(b, h) (((b) * 2 + (h)) * HTB)
#define PG8_SB(b, h) ((4 + (b) * 2 + (h)) * HTB)
#define PG8_STAGE(bufoff, gbase, voff) do { _Pragma("unroll") for (int _i = 0; _i < 2; ++_i) \
        __builtin_amdgcn_global_load_lds((const unsigned*)((const char*)(gbase) + (voff)[_i]), (LAS unsigned*)(lds + (bufoff) + ldsw + _i * 8192), 16, 0, 0); } while (0)
#define PG8_LDA(dst, b, h) do { _Pragma("unroll") for (int m = 0; m < 4; ++m) _Pragma("unroll") for (int k = 0; k < 2; ++k) dst[m][k] = *(const LAS bf16x8*)(lds + PG8_SA(b, h) + aoff + m * 2048 + k * 1024); } while (0)
#define PG8_LDB(dst, b, h) do { _Pragma("unroll") for (int n = 0; n < 2; ++n) _Pragma("unroll") for (int k = 0; k < 2; ++k) dst[n][k] = *(const LAS bf16x8*)(lds + PG8_SB(b, h) + boff + n * 2048 + k * 1024); } while (0)
#define PG8_MMA(ai, bj, At, Bt) do { __builtin_amdgcn_s_setprio(1); _Pragma("unroll") for (int m = 0; m < 4; ++m) _Pragma("unroll") for (int n = 0; n < 2; ++n) _Pragma("unroll") for (int k = 0; k < 2; ++k) \
        acc[ai][bj][m][n] = __builtin_amdgcn_mfma_f32_16x16x32_bf16(Bt[n][k], At[m][k], acc[ai][bj][m][n], 0, 0, 0); __builtin_amdgcn_s_setprio(0); } while (0)
#define PG8_WAIT_V(n) asm volatile("s_waitcnt vmcnt(" #n ")" ::: "memory")
#define PG8_WAIT_L(n) asm volatile("s_waitcnt lgkmcnt(" #n ")" ::: "memory")
#define PG8_BAR __builtin_amdgcn_s_barrier()
#define PG8_SCHED __builtin_amdgcn_sched_barrier(0)
    Unit cur, nxt; int ui = 0;
    if (!S.next(0, cur)) return;
    f32x4 acc[2][2][4][2];
#pragma unroll
    for (int a = 0; a < 2; ++a)
#pragma unroll
        for (int b = 0; b < 2; ++b)
#pragma unroll
            for (int m = 0; m < 4; ++m)
#pragma unroll
                for (int n = 0; n < 2; ++n) acc[a][b][m][n] = (f32x4){0.f, 0.f, 0.f, 0.f};
    bf16x8 At[4][2], B0[2][2], B1[2][2];
    const char* cA = (const char*)g.A + (size_t)cur.pm * tstepA + (size_t)cur.pn * g.acs * 2; const char* cB = (const char*)g.Bt + (size_t)cur.pn * tstepB;
    PG8_STAGE(PG8_SB(0, 0), cB, voffB); PG8_STAGE(PG8_SB(0, 1), cB + hstepB, voffB); PG8_STAGE(PG8_SA(0, 0), cA, voffA); PG8_STAGE(PG8_SA(0, 1), cA + hstepA, voffA);
    if (wr == 1) PG8_BAR;
    PG8_WAIT_V(2); PG8_BAR;
    PG8_STAGE(PG8_SB(1, 0), cB + kstep, voffB); PG8_STAGE(PG8_SA(1, 0), cA + kstep, voffA); PG8_STAGE(PG8_SB(1, 1), cB + hstepB + kstep, voffB);
    PG8_WAIT_V(6); PG8_BAR;
    for (;;) {
        const bool has_next = S.next(ui + 1, nxt);
        const char* nA = has_next ? (const char*)g.A + (size_t)nxt.pm * tstepA + (size_t)nxt.pn * g.acs * 2 : cA; const char* nB = has_next ? (const char*)g.Bt + (size_t)nxt.pn * tstepB : cB;
        for (int t = 0; t < nt; t += 2) {
            const bool last = (t == nt - 2);
            const char* a1 = cA + (size_t)(t + 1) * kstep;
            const char* a2 = last ? nA : cA + (size_t)(t + 2) * kstep; const char* b2 = last ? nB : cB + (size_t)(t + 2) * kstep;
            const char* a3 = a2 + kstep; const char* b3 = b2 + kstep;
            PG8_LDB(B0, 0, 0); PG8_LDB(B1, 0, 1); PG8_SCHED; PG8_LDA(At, 0, 0); PG8_STAGE(PG8_SA(1, 1), a1 + hstepA, voffA);
            PG8_WAIT_V(8); PG8_WAIT_L(0); PG8_BAR; PG8_MMA(0, 0, At, B0); PG8_MMA(0, 1, At, B1); PG8_BAR; PG8_SCHED;
            PG8_LDA(At, 0, 1); PG8_STAGE(PG8_SB(0, 0), b2, voffB); PG8_STAGE(PG8_SB(0, 1), b2 + hstepB, voffB); PG8_STAGE(PG8_SA(0, 0), a2, voffA);
            PG8_WAIT_V(8); PG8_WAIT_L(0); PG8_BAR; PG8_MMA(1, 0, At, B0); PG8_MMA(1, 1, At, B1); PG8_BAR; PG8_SCHED;
            PG8_LDB(B0, 1, 0); PG8_LDB(B1, 1, 1); PG8_SCHED; PG8_LDA(At, 1, 0); PG8_STAGE(PG8_SA(0, 1), a2 + hstepA, voffA);
            PG8_WAIT_V(8); PG8_WAIT_L(0); PG8_BAR; PG8_MMA(0, 0, At, B0); PG8_MMA(0, 1, At, B1); PG8_BAR; PG8_SCHED;
            PG8_LDA(At, 1, 1); PG8_STAGE(PG8_SB(1, 0), b3, voffB); PG8_STAGE(PG8_SB(1, 1), b3 + hstepB, voffB); PG8_STAGE(PG8_SA(1, 0), a3, voffA);
            PG8_WAIT_V(8); PG8_WAIT_L(0); PG8_BAR; PG8_MMA(1, 0, At, B0); PG8_MMA(1, 1, At, B1); PG8_BAR; PG8_SCHED;
        }
        if (wr == 0) PG8_BAR;
        { int fr2 = fr, fq2 = fq; asm volatile("" : "+v"(fr2), "+v"(fq2));
          E(acc, cur, wr, wc, fr2, fq2); }
        if (!has_next) break;
#pragma unroll
        for (int a = 0; a < 2; ++a)
#pragma unroll
            for (int b = 0; b < 2; ++b)
#pragma unroll
                for (int m = 0; m < 4; ++m)
#pragma unroll
                    for (int n = 0; n < 2; ++n) acc[a][b][m][n] = (f32x4){0.f, 0.f, 0.f, 0.f};
        cur = nxt; cA = nA; cB = nB; ++ui;
        if (wr == 1) PG8_BAR;
    }
    PG8_WAIT_V(0);
    PG8_BAR;
#undef PG8_SA
#undef PG8_SB
#undef PG8_STAGE
#undef PG8_LDA
#undef PG8_LDB
#undef PG8_MMA
#undef PG8_WAIT_V
#undef PG8_WAIT_L
#undef PG8_BAR
#undef PG8_SCHED
}

struct EpiUp {
    bf16_t* ACT; const float* sumsq;
    __device__ __forceinline__ void operator()(const f32x4 (&acc)[2][2][4][2], const Unit& u, int wr, int wc, int fr, int fq) const {
        const int row0 = u.pm * BM + wr * 64 + fr, col0 = u.pn * 128 + wc * 32 + 8 * fq;
#pragma unroll
        for (int ai = 0; ai < 2; ++ai)
#pragma unroll
            for (int m = 0; m < 4; ++m) {
                const int row = row0 + ai * HALF + m * 16;
                const float rs = __builtin_amdgcn_rsqf(sumsq[row] * (1.0f / DM) + EPS);
                float o[8];
#pragma unroll
                for (int n = 0; n < 2; ++n)
#pragma unroll
                    for (int j = 0; j < 4; ++j) { const float gq = acc[ai][0][m][n][j] * rs, up = acc[ai][1][m][n][j] * rs;
                        o[n * 4 + j] = gq * up * fast_rcp(1.0f + fast_exp2(-LOG2E * gq)); }
                u32x4 w; w.x = cvt_pk_bf16(o[0], o[1]); w.y = cvt_pk_bf16(o[2], o[3]); w.z = cvt_pk_bf16(o[4], o[5]); w.w = cvt_pk_bf16(o[6], o[7]);
                *(u32x4*)(ACT + (size_t)row * FF + col0) = w;
            }
    }
};
struct EpiRes {
    const float* base; float* out; int rowlim; bf16_t* XN; float* sumsq; float alpha;
    __device__ __forceinline__ void operator()(const f32x4 (&acc)[2][2][4][2], const Unit& u, int wr, int wc, int fr, int fq) const {
        const int row0 = u.pm * BM + wr * 64 + fr, col0 = u.pn * BM + wc * 32 + 8 * fq;
#pragma unroll
        for (int ai = 0; ai < 2; ++ai)
#pragma unroll
            for (int m = 0; m < 4; ++m) {
                const int row = row0 + ai * HALF + m * 16; const size_t off = (size_t)row * DM + col0;
                float ss = 0.f;
#pragma unroll
                for (int bj = 0; bj < 2; ++bj) {
                    const f32x4 b0 = *(const f32x4*)(base + off + bj * HALF), b1 = *(const f32x4*)(base + off + bj * HALF + 4);
                    const f32x4 v0 = b0 + acc[ai][bj][m][0] * alpha, v1 = b1 + acc[ai][bj][m][1] * alpha;
                    if (row < rowlim) { *(f32x4*)(out + off + bj * HALF) = v0; *(f32x4*)(out + off + bj * HALF + 4) = v1; }
                    u32x4 w; w.x = cvt_pk_bf16(v0[0], v0[1]); w.y = cvt_pk_bf16(v0[2], v0[3]); w.z = cvt_pk_bf16(v1[0], v1[1]); w.w = cvt_pk_bf16(v1[2], v1[3]);
                    *(u32x4*)(XN + off + bj * HALF) = w;
                    ss += (v0[0] * v0[0] + v0[1] * v0[1]) + (v0[2] * v0[2] + v0[3] * v0[3]) + (v1[0] * v1[0] + v1[1] * v1[1]) + (v1[2] * v1[2] + v1[3] * v1[3]);
                }
                ss += __shfl_xor(ss, 16); ss += __shfl_xor(ss, 32);
                if (fq == 0) atomicAdd(sumsq + row, ss);
                asm volatile("" ::: "memory");
            }
    }
};
struct EpiInEven {
    const float* sumsq; bf16_t *Q, *Kb, *V, *AU, *AV; float* dout; const float *qg, *kg; float* avsq; LAS float* red;
    __device__ __forceinline__ void operator()(const f32x4 (&acc)[2][2][4][2], const Unit& u, int wr, int wc, int fr, int fq) const {
        const int seg = u.pn >> 2, ct = (u.pn & 3) * BM;
        const int row0 = u.pm * BM + wr * 64 + fr, cw = wc * 32 + 8 * fq;
        float rs[2][4];
#pragma unroll
        for (int ai = 0; ai < 2; ++ai)
#pragma unroll
            for (int m = 0; m < 4; ++m) rs[ai][m] = __builtin_amdgcn_rsqf(sumsq[row0 + ai * HALF + m * 16] * (1.0f / DM) + EPS);
        if (seg < 2) {
#pragma unroll
            for (int ai = 0; ai < 2; ++ai)
#pragma unroll
                for (int m = 0; m < 4; ++m)
#pragma unroll
                    for (int bj = 0; bj < 2; ++bj) {
                        const f32x4 a = acc[ai][bj][m][0], b = acc[ai][bj][m][1];
                        float s = (a[0] * a[0] + a[1] * a[1]) + (a[2] * a[2] + a[3] * a[3]) + (b[0] * b[0] + b[1] * b[1]) + (b[2] * b[2] + b[3] * b[3]);
                        s += __shfl_xor(s, 16); s += __shfl_xor(s, 32);
                        if (fq == 0) red[((ai * HALF + wr * 64 + m * 16 + fr) * 2 + bj) * 4 + wc] = s;
                    }
            LDS_WAIT(); __builtin_amdgcn_s_barrier(); asm volatile("" ::: "memory");
            const float* gn = seg == 0 ? qg : kg;
            f32x4 g0 = *(const f32x4*)(gn + cw), g1 = *(const f32x4*)(gn + cw + 4);
            if (seg == 0) { g0 = g0 * QSCALE; g1 = g1 * QSCALE; }
            bf16_t* dst = seg == 0 ? Q : Kb;
#pragma unroll
            for (int ai = 0; ai < 2; ++ai)
#pragma unroll
                for (int m = 0; m < 4; ++m) {
                    const int row = row0 + ai * HALF + m * 16; const float r = rs[ai][m];
#pragma unroll
                    for (int bj = 0; bj < 2; ++bj) {
                        const f32x4 p = *(const LAS f32x4*)(red + ((ai * HALF + wr * 64 + m * 16 + fr) * 2 + bj) * 4);
                        const float ms = ((p[0] + p[1]) + (p[2] + p[3])) * r * r * (1.0f / HD);
                        const float sc = r * __builtin_amdgcn_rsqf(ms + EPS);
                        const f32x4 v0 = acc[ai][bj][m][0] * sc * g0, v1 = acc[ai][bj][m][1] * sc * g1;
                        const int col = ct + bj * HALF + cw;
                        u32x4 w; w.x = cvt_pk_bf16(v0[0], v0[1]); w.y = cvt_pk_bf16(v0[2], v0[3]); w.z = cvt_pk_bf16(v1[0], v1[1]); w.w = cvt_pk_bf16(v1[2], v1[3]);
                        *(u32x4*)(dst + (size_t)row * 1024 + col) = w;
                        if (seg == 1 && row < MP + MS) {
                            float* o = dout + (row < MP ? O_KP + (size_t)row * 1024 : O_KS + (size_t)(row - MP) * 1024) + col;
                            *(f32x4*)o = v0; *(f32x4*)(o + 4) = v1;
                        }
                    }
                }
        } else if (seg == 2) {
#pragma unroll
            for (int ai = 0; ai < 2; ++ai)
#pragma unroll
                for (int m = 0; m < 4; ++m) {
                    const int row = row0 + ai * HALF + m * 16; const float r = rs[ai][m];
#pragma unroll
                    for (int bj = 0; bj < 2; ++bj) {
                        const f32x4 v0 = acc[ai][bj][m][0] * r, v1 = acc[ai][bj][m][1] * r;
                        const int col = ct + bj * HALF + cw;
                        u32x4 w; w.x = cvt_pk_bf16(v0[0], v0[1]); w.y = cvt_pk_bf16(v0[2], v0[3]); w.z = cvt_pk_bf16(v1[0], v1[1]); w.w = cvt_pk_bf16(v1[2], v1[3]);
                        *(u32x4*)(V + (size_t)row * 1024 + col) = w;
                        if (row < MP + MS) {
                            float* o = dout + (row < MP ? O_VP + (size_t)row * 1024 : O_VS + (size_t)(row - MP) * 1024) + col;
                            *(f32x4*)o = v0; *(f32x4*)(o + 4) = v1;
                        }
                    }
                }
        } else {
            bf16_t* dst = seg == 3 ? AU : AV;
#pragma unroll
            for (int ai = 0; ai < 2; ++ai)
#pragma unroll
                for (int m = 0; m < 4; ++m) {
                    const int row = row0 + ai * HALF + m * 16; const float r = rs[ai][m];
                    float ss = 0.f;
#pragma unroll
                    for (int bj = 0; bj < 2; ++bj) {
                        float o[8];
#pragma unroll
                        for (int n = 0; n < 2; ++n)
#pragma unroll
                            for (int j = 0; j < 4; ++j) { o[n * 4 + j] = gelu_tanh(acc[ai][bj][m][n][j] * r); ss += o[n * 4 + j] * o[n * 4 + j]; }
                        const int col = ct + bj * HALF + cw;
                        u32x4 w; w.x = cvt_pk_bf16(o[0], o[1]); w.y = cvt_pk_bf16(o[2], o[3]); w.z = cvt_pk_bf16(o[4], o[5]); w.w = cvt_pk_bf16(o[6], o[7]);
                        *(u32x4*)(dst + (size_t)row * 1024 + col) = w;
                    }
                    if (seg == 4) { ss += __shfl_xor(ss, 16); ss += __shfl_xor(ss, 32); if (fq == 0) atomicAdd(avsq + row, ss); }
                }
        }
    }
};
struct EpiInOdd {
    const float* sumsq; bf16_t *XC, *GB, *G; float* dout;
    __device__ __forceinline__ void operator()(const f32x4 (&acc)[2][2][4][2], const Unit& u, int wr, int wc, int fr, int fq) const {
        const int row0 = u.pm * BM + wr * 64 + fr, cw = wc * 32 + 8 * fq;
        if (u.pn < 8) {
            const int ct = (u.pn & 3) * BM; bf16_t* dst = u.pn < 4 ? XC : GB;
#pragma unroll
            for (int ai = 0; ai < 2; ++ai)
#pragma unroll
                for (int m = 0; m < 4; ++m) {
                    const int row = row0 + ai * HALF + m * 16; const float r = __builtin_amdgcn_rsqf(sumsq[row] * (1.0f / DM) + EPS);
#pragma unroll
                    for (int bj = 0; bj < 2; ++bj) {
                        const f32x4 v0 = acc[ai][bj][m][0] * r, v1 = acc[ai][bj][m][1] * r;
                        const int col = ct + bj * HALF + cw;
                        u32x4 w; w.x = cvt_pk_bf16(v0[0], v0[1]); w.y = cvt_pk_bf16(v0[2], v0[3]); w.z = cvt_pk_bf16(v1[0], v1[1]); w.w = cvt_pk_bf16(v1[2], v1[3]);
                        *(u32x4*)(dst + (size_t)row * 1024 + col) = w;
                        if (u.pn < 4) {
                            float* o = nullptr;
                            if (row < MP) { const int t = row & (SEQ - 1); if (t >= SEQ - 15) o = dout + O_PP + ((size_t)(row >> 11) * 15 + (t - (SEQ - 15))) * 1024 + col; }
                            else if (row < MP + MS) { const int sr = row - MP; o = dout + O_PS + ((size_t)(sr >> 2) * 15 + 11 + (sr & 3)) * 1024 + col; }
                            if (o) { *(f32x4*)o = v0; *(f32x4*)(o + 4) = v1; }
                        }
                    }
                }
        } else {
            const int col = (u.pn - 8) * 128 + cw;
#pragma unroll
            for (int ai = 0; ai < 2; ++ai)
#pragma unroll
                for (int m = 0; m < 4; ++m) {
                    const int row = row0 + ai * HALF + m * 16; const float r = __builtin_amdgcn_rsqf(sumsq[row] * (1.0f / DM) + EPS); const float r2 = r * r;
                    const f32x4 v0 = acc[ai][0][m][0] * acc[ai][1][m][0] * r2, v1 = acc[ai][0][m][1] * acc[ai][1][m][1] * r2;
                    u32x4 w; w.x = cvt_pk_bf16(v0[0], v0[1]); w.y = cvt_pk_bf16(v0[2], v0[3]); w.z = cvt_pk_bf16(v1[0], v1[1]); w.w = cvt_pk_bf16(v1[2], v1[3]);
                    *(u32x4*)(G + (size_t)row * 1024 + col) = w;
                    float* o = nullptr;
                    if (row < MP) { const int t = row & (SEQ - 1); if (t >= SEQ - 2) o = dout + O_CP + ((size_t)(row >> 11) * 2 + (t - (SEQ - 2))) * 1024 + col; }
                    else if (row < MP + MS) { const int sr = row - MP; if ((sr & 3) >= 2) o = dout + O_CS + ((size_t)(sr >> 2) * 2 + ((sr & 3) - 2)) * 1024 + col; }
                    if (o) { *(f32x4*)o = v0; *(f32x4*)(o + 4) = v1; }
                }
        }
    }
};
struct EpiPool {
    bf16_t* MIX; const float* cscale;
    __device__ __forceinline__ void operator()(const f32x4 (&acc)[2][2][4][2], const Unit& u, int wr, int wc, int fr, int fq) const {
        const int row0 = u.pm * BM + wr * 64 + fr, col0 = u.pn * BM + wc * 32 + 8 * fq;
#pragma unroll
        for (int bj = 0; bj < 2; ++bj) {
            const f32x4 s0 = *(const f32x4*)(cscale + col0 + bj * HALF), s1 = *(const f32x4*)(cscale + col0 + bj * HALF + 4);
#pragma unroll
            for (int ai = 0; ai < 2; ++ai)
#pragma unroll
                for (int m = 0; m < 4; ++m) {
                    const int row = row0 + ai * HALF + m * 16;
                    const f32x4 v0 = acc[ai][bj][m][0] * s0, v1 = acc[ai][bj][m][1] * s1;
                    u32x4 w; w.x = cvt_pk_bf16(v0[0], v0[1]); w.y = cvt_pk_bf16(v0[2], v0[3]); w.z = cvt_pk_bf16(v1[0], v1[1]); w.w = cvt_pk_bf16(v1[2], v1[3]);
                    *(u32x4*)(MIX + (size_t)row * DM + col0 + bj * HALF) = w;
                }
        }
    }
};
}

namespace sba {
constexpr int SHM_K = 64 * 128 * 2, SHM_V = SHM_K;
#define KSWZ(row, colB) ((row) * 256 + ((colB) ^ (((row) & 7) << 4)))
#define SBAR() __builtin_amdgcn_sched_barrier(0)
__device__ __forceinline__ int crow(int r, int hi) { return (r & 3) + 8 * (r >> 2) + 4 * hi; }
__device__ __forceinline__ int v_st(int k, int c) { const int kk = (k & ~0xC) | ((k & 4) << 1) | ((k & 8) >> 1); return ((kk >> 3) * 4 + (c >> 5)) * 512 + ((kk & 7) * 32 + (c & 31)) * 2; }
__device__ __forceinline__ int v_rd_base(int lane) { return ((lane & 3) << 3) | (((lane >> 2) & 3) << 6) | (((lane >> 4) & 1) << 5) | (((lane >> 5) & 1) << 8); }
constexpr int v_rd_off(int d0, int ks, int half) { return d0 * 512 + ks * 4096 + half * 2048; }
template <int OFF> __device__ __forceinline__ s16x4 tr_read(int vb) {
    s16x4 r; asm volatile("ds_read_b64_tr_b16 %0, %1 offset:%2" : "=&v"(r) : "v"(vb), "i"(OFF) : "memory"); return r;
}
template <int D0> __device__ __forceinline__ void pv_one(f32x16& od, int vb, bf16x8 pa0, bf16x8 pa1, bf16x8 pa2, bf16x8 pa3) {
    const s16x4 l0 = tr_read<v_rd_off(D0, 0, 0)>(vb), h0 = tr_read<v_rd_off(D0, 0, 1)>(vb), l1 = tr_read<v_rd_off(D0, 1, 0)>(vb), h1 = tr_read<v_rd_off(D0, 1, 1)>(vb);
    const s16x4 l2 = tr_read<v_rd_off(D0, 2, 0)>(vb), h2 = tr_read<v_rd_off(D0, 2, 1)>(vb), l3 = tr_read<v_rd_off(D0, 3, 0)>(vb), h3 = tr_read<v_rd_off(D0, 3, 1)>(vb);
    asm volatile("s_waitcnt lgkmcnt(0)" ::: "memory"); SBAR();
#define PK(L, H) (bf16x8){L[0], L[1], L[2], L[3], H[0], H[1], H[2], H[3]}
    od = __builtin_amdgcn_mfma_f32_32x32x16_bf16(pa0, PK(l0, h0), od, 0, 0, 0);
    od = __builtin_amdgcn_mfma_f32_32x32x16_bf16(pa1, PK(l1, h1), od, 0, 0, 0);
    od = __builtin_amdgcn_mfma_f32_32x32x16_bf16(pa2, PK(l2, h2), od, 0, 0, 0);
    od = __builtin_amdgcn_mfma_f32_32x32x16_bf16(pa3, PK(l3, h3), od, 0, 0, 0);
#undef PK
}
__device__ __forceinline__ void qkt(f32x16& p0, f32x16& p1, const char* Ks, const bf16x8 (&qr)[8], int r32, int hi) {
    p0 = f32x16{}; p1 = f32x16{};
#pragma unroll
    for (int d0 = 0; d0 < 8; ++d0) { const int cb = (d0 * 16 + hi * 8) * 2;
        const bf16x8 b0 = *reinterpret_cast<const bf16x8*>(Ks + KSWZ(r32, cb));
        const bf16x8 b1 = *reinterpret_cast<const bf16x8*>(Ks + KSWZ(32 + r32, cb));
        p0 = __builtin_amdgcn_mfma_f32_32x32x16_bf16(b0, qr[d0], p0, 0, 0, 0);
        p1 = __builtin_amdgcn_mfma_f32_32x32x16_bf16(b1, qr[d0], p1, 0, 0, 0); }
}
__device__ __forceinline__ void sb_tile(f32x16& p0, f32x16& p1, float& C, float bias2, bool masked, int t, int k0, int hi) {
#pragma unroll
    for (int r = 0; r < 16; ++r) {
        float e0 = fast_exp2(p0[r] + bias2), e1 = fast_exp2(p1[r] + bias2);
        if (masked) { const int key = k0 + crow(r, hi); e0 = key < t ? e0 : 0.f; e1 = (key + 32) < t ? e1 : 0.f; }
        p0[r] = e0; p1[r] = e1;
    }
    float a[8], SA[9], PB[9];
#pragma unroll
    for (int j = 0; j < 4; ++j) {
        a[j] = ((1.f + p0[4 * j]) * (1.f + p0[4 * j + 1])) * ((1.f + p0[4 * j + 2]) * (1.f + p0[4 * j + 3]));
        a[4 + j] = ((1.f + p1[4 * j]) * (1.f + p1[4 * j + 1])) * ((1.f + p1[4 * j + 2]) * (1.f + p1[4 * j + 3]));
    }
    SA[8] = 1.f; PB[8] = 1.f;
#pragma unroll
    for (int j = 7; j >= 0; --j) SA[j] = SA[j + 1] * a[j];
#pragma unroll
    for (int j = 0; j < 8; ++j) PB[j] = xchg32(SA[j], hi);
#pragma unroll
    for (int j = 0; j < 8; ++j) {
        const float suf = C * SA[j + 1] * (hi ? PB[j + 1] : PB[j]);
        float inv = fast_rcp(suf * a[j]);
        if (j < 4) {
            const float e0 = p0[4 * j], e1 = p0[4 * j + 1], e2 = p0[4 * j + 2], e3 = p0[4 * j + 3];
            p0[4 * j] = e0 * inv; inv *= (1.f + e0); p0[4 * j + 1] = e1 * inv; inv *= (1.f + e1); p0[4 * j + 2] = e2 * inv; inv *= (1.f + e2); p0[4 * j + 3] = e3 * inv;
        } else {
            const int q = 4 * (j - 4);
            const float e0 = p1[q], e1 = p1[q + 1], e2 = p1[q + 2], e3 = p1[q + 3];
            p1[q] = e0 * inv; inv *= (1.f + e0); p1[q + 1] = e1 * inv; inv *= (1.f + e1); p1[q + 2] = e2 * inv; inv *= (1.f + e2); p1[q + 3] = e3 * inv;
        }
    }
    C = C * SA[0] * PB[0];
}
__device__ __forceinline__ void pack_p(const f32x16& p0, const f32x16& p1, bf16x8& pa0, bf16x8& pa1, bf16x8& pa2, bf16x8& pa3) {
#define PK4(P, BASE, OUT) do { unsigned a0 = cvt_pk_bf16(P[BASE + 0], P[BASE + 1]), a1 = cvt_pk_bf16(P[BASE + 2], P[BASE + 3]);   \
    unsigned b0 = cvt_pk_bf16(P[BASE + 4], P[BASE + 5]), b1 = cvt_pk_bf16(P[BASE + 6], P[BASE + 7]);                              \
    auto r0 = __builtin_amdgcn_permlane32_swap(a0, b0, false, false); auto r1 = __builtin_amdgcn_permlane32_swap(a1, b1, false, false); \
    u32x4 w = {r0[0], r1[0], r0[1], r1[1]}; OUT = *reinterpret_cast<bf16x8*>(&w); } while (0)
    PK4(p0, 0, pa0); PK4(p0, 8, pa1); PK4(p1, 0, pa2); PK4(p1, 8, pa3);
#undef PK4
}
__device__ __forceinline__ void attn_unit(const bf16_t* __restrict__ Qb, const bf16_t* __restrict__ Kh, const bf16_t* __restrict__ Vh, bf16_t* __restrict__ Ob, int q0, float bias2, char* lds) {
    int tid = threadIdx.x; asm volatile("" : "+v"(tid));
    const int wid = tid >> 6, lane = tid & 63, r32 = lane & 31, hi = lane >> 5;
    char* V_lds = lds; char* K_lds = lds + 2 * SHM_V;
    f32x16 o[4] = {}; bf16x8 qr[8];
    const bf16_t* Qw = Qb + (size_t)(wid * 32 + r32) * 1024 + hi * 8;
#pragma unroll
    for (int d0 = 0; d0 < 8; ++d0) qr[d0] = *reinterpret_cast<const bf16x8*>(Qw + d0 * 16);
    const int sr = tid >> 4, sc = (tid & 15) * 8, vst0 = v_st(sr, sc), vst1 = v_st(32 + sr, sc);
    const int vb0 = (int)(uintptr_t)V_lds + v_rd_base(lane);
    const int NT = (q0 + 256) >> 6, kmax = q0 + 192, tw = q0 + wid * 32, t = tw + r32;
    float C = 1.f;
    bf16x8 vs0, vs1, ks0, ks1;
#define SLOAD(k0) do { vs0 = *reinterpret_cast<const bf16x8*>(Vh + (size_t)((k0) + sr) * 1024 + sc); vs1 = *reinterpret_cast<const bf16x8*>(Vh + (size_t)((k0) + 32 + sr) * 1024 + sc); \
    ks0 = *reinterpret_cast<const bf16x8*>(Kh + (size_t)((k0) + sr) * 1024 + sc); ks1 = *reinterpret_cast<const bf16x8*>(Kh + (size_t)((k0) + 32 + sr) * 1024 + sc); } while (0)
#define SWRITE(b) do { *(bf16x8*)(V_lds + (b) * SHM_V + vst0) = vs0; *(bf16x8*)(V_lds + (b) * SHM_V + vst1) = vs1; const int kc = sc * 2; \
    *(bf16x8*)(K_lds + (b) * SHM_K + KSWZ(sr, kc)) = ks0; *(bf16x8*)(K_lds + (b) * SHM_K + KSWZ(32 + sr, kc)) = ks1; } while (0)
    __syncthreads();
    SLOAD(kmax); SWRITE(0);
    for (int j = 0; j < NT; ++j) {
        __syncthreads();
        const int k0 = kmax - 64 * j, b = j & 1;
        if (j + 1 < NT) SLOAD(k0 - 64);
        if (k0 <= tw + 30) {
            f32x16 p0, p1; bf16x8 pa0, pa1, pa2, pa3;
            qkt(p0, p1, K_lds + b * SHM_K, qr, r32, hi);
            sb_tile(p0, p1, C, bias2, k0 + 63 >= tw, t, k0, hi);
            pack_p(p0, p1, pa0, pa1, pa2, pa3);
            const int vb = vb0 + b * SHM_V;
            pv_one<0>(o[0], vb, pa0, pa1, pa2, pa3); pv_one<1>(o[1], vb, pa0, pa1, pa2, pa3); pv_one<2>(o[2], vb, pa0, pa1, pa2, pa3); pv_one<3>(o[3], vb, pa0, pa1, pa2, pa3);
        }
        if (j + 1 < NT) SWRITE(b ^ 1);
    }
#undef SLOAD
#undef SWRITE
    bf16_t* Ow = Ob + (size_t)(wid * 32) * DM;
#pragma unroll
    for (int r = 0; r < 16; ++r) { const int orow = crow(r, hi);
#pragma unroll
        for (int d0 = 0; d0 < 4; ++d0) Ow[(size_t)orow * DM + d0 * 32 + r32] = (bf16_t)(cvt_pk_bf16(o[d0][r], 0.f) & 0xffffu); }
}
__device__ __forceinline__ void gate_unit(const bf16_t* __restrict__ AVb, const bf16_t* __restrict__ AUb, const bf16_t* __restrict__ AWS, const float* __restrict__ avsq,
                                          const float* __restrict__ avg, const float* __restrict__ abs_, bf16_t* __restrict__ MIX, int R0, int g, char* lds) {
    int tid = threadIdx.x; asm volatile("" : "+v"(tid));
    const int wid = tid >> 6, lane = tid & 63, r32 = lane & 31, hi = lane >> 5, wp = wid & 3, wd = wid >> 2;
    char* V_lds = lds;
    const int sr = tid >> 4, sc = (tid & 15) * 8;
    __syncthreads();
#pragma unroll
    for (int q4 = 0; q4 < 4; ++q4) {
        const int row = q4 * 32 + sr;
        const u32x4 x = *reinterpret_cast<const u32x4*>(AVb + (size_t)(R0 + row) * 1024 + g * 128 + sc);
        const float rs = __builtin_amdgcn_rsqf(avsq[R0 + row] * (1.0f / AW) + EPS);
        u32x4 w; w.x = cvt_pk_bf16(bf_lo(x.x) * rs, bf_hi(x.x) * rs); w.y = cvt_pk_bf16(bf_lo(x.y) * rs, bf_hi(x.y) * rs);
        w.z = cvt_pk_bf16(bf_lo(x.z) * rs, bf_hi(x.z) * rs); w.w = cvt_pk_bf16(bf_lo(x.w) * rs, bf_hi(x.w) * rs);
        *(u32x4*)(V_lds + (row >> 6) * SHM_V + v_st(row & 63, sc)) = w;
    }
    __syncthreads();
    f32x16 o0 = {}, o1 = {};
    const int vb0 = (int)(uintptr_t)V_lds + v_rd_base(lane);
    const bf16_t* Wrow = AWS + (size_t)(g * 128 + wp * 32 + r32) * 128 + hi * 8;
#pragma unroll
    for (int tile = 0; tile < 2; ++tile) {
        if (tile == 1 && wp < 2) break;
        const bf16x8 pa0 = *reinterpret_cast<const bf16x8*>(Wrow + tile * 64), pa1 = *reinterpret_cast<const bf16x8*>(Wrow + tile * 64 + 16),
                     pa2 = *reinterpret_cast<const bf16x8*>(Wrow + tile * 64 + 32), pa3 = *reinterpret_cast<const bf16x8*>(Wrow + tile * 64 + 48);
        const int vb = vb0 + tile * SHM_V;
        if (wd == 0) { pv_one<0>(o0, vb, pa0, pa1, pa2, pa3); pv_one<1>(o1, vb, pa0, pa1, pa2, pa3); }
        else         { pv_one<2>(o0, vb, pa0, pa1, pa2, pa3); pv_one<3>(o1, vb, pa0, pa1, pa2, pa3); }
    }
#pragma unroll
    for (int r = 0; r < 16; ++r) {
        const int p = wp * 32 + crow(r, hi); const float bsv = abs_[g * 128 + p];
#pragma unroll
        for (int dd = 0; dd < 2; ++dd) {
            const int col = g * 128 + (wd * 2 + dd) * 32 + r32;
            const float acc = dd == 0 ? o0[r] : o1[r];
            const float mixv = acc * avg[col] + bsv;
            const float au = __uint_as_float((unsigned)AUb[(size_t)(R0 + p) * 1024 + col] << 16);
            MIX[(size_t)(R0 + p) * DM + col] = (bf16_t)(cvt_pk_bf16(au * mixv, 0.f) & 0xffffu);
        }
    }
}
}

constexpr int PTAB_OFF = MISC_OFF + 256;
__device__ __forceinline__ unsigned char* opaque_ptr(unsigned char* p) { asm volatile("" : "+s"(p)); return p; }
__device__ __forceinline__ const void* lds_ptr(volatile LAS unsigned* tab, int i) {
    const unsigned lo = __builtin_amdgcn_readfirstlane(tab[2 * i]), hi = __builtin_amdgcn_readfirstlane(tab[2 * i + 1]);
    return (const void*)(((unsigned long long)hi << 32) | lo);
}
struct Args { const void* in[24]; float* out; unsigned char* ws; };

__device__ __forceinline__ void ld8(const bf16_t* p, float (&o)[8]) { const u32x4 x = *(const u32x4*)p; o[0] = bf_lo(x.x); o[1] = bf_hi(x.x); o[2] = bf_lo(x.y); o[3] = bf_hi(x.y); o[4] = bf_lo(x.z); o[5] = bf_hi(x.z); o[6] = bf_lo(x.w); o[7] = bf_hi(x.w); }
__device__ __forceinline__ float wave_sum(float v) {
#pragma unroll
    for (int o = 1; o < 64; o <<= 1) v += __shfl_xor(v, o);
    return v;
}
__device__ __forceinline__ void tr_item(const float* __restrict__ W, int K, int N, const float* __restrict__ gain, bf16_t* __restrict__ WT, int kind, LAS float* scr, int item, int lane) {
    const int nblk = N / 32, kb = item / nblk, nb = item % nblk, k0 = 64 * kb, n0 = 32 * nb;
    int drow0 = n0;
    if (kind == 1) drow0 = 256 * (n0 >> 7) + (n0 & 127);
    else if (kind == 2) drow0 = 256 * (n0 >> 7) + 128 + (n0 & 127);
    else if (kind == 3) { if (n0 >= 3072) { const int j = n0 - 3072; drow0 = 2048 + 256 * (j >> 7) + 128 + (j & 127); } else if (n0 >= 2048) { const int j = n0 - 2048; drow0 = 2048 + 256 * (j >> 7) + (j & 127); } }
#pragma unroll 8
    for (int i = 0; i < 32; ++i) { const int kk = 2 * i + (lane >> 5); float v = W[(size_t)(k0 + kk) * N + n0 + (lane & 31)]; if (gain) v *= gain[k0 + kk]; scr[kk * 33 + (lane & 31)] = v; }
    LDS_WAIT(); asm volatile("" ::: "memory");
    const int c = lane & 7;
#pragma unroll
    for (int j = 0; j < 4; ++j) { const int n = (lane >> 3) + 8 * j; const LAS float* s = scr + (8 * c) * 33 + n;
        u32x4 o; o.x = cvt_pk_bf16(s[0 * 33], s[1 * 33]); o.y = cvt_pk_bf16(s[2 * 33], s[3 * 33]); o.z = cvt_pk_bf16(s[4 * 33], s[5 * 33]); o.w = cvt_pk_bf16(s[6 * 33], s[7 * 33]);
        *(u32x4*)(WT + (size_t)(drow0 + n) * K + k0 + 8 * c) = o; }
    LDS_WAIT(); asm volatile("" ::: "memory");
}

__global__ void __launch_bounds__(512, 2) mega_fwd(Args args) {
    extern __shared__ __attribute__((aligned(16))) unsigned char lds[];
    LAS unsigned char* L = (LAS unsigned char*)lds;
#define FRESH_IDS() int tid = threadIdx.x; asm volatile("" : "+v"(tid)); int G = G0, bx = bx0; asm volatile("" : "+s"(G), "+s"(bx)); const int lane = tid & 63, wave = __builtin_amdgcn_readfirstlane(tid >> 6); const int gw = bx * 8 + wave, NGW = G * 8; (void)lane; (void)gw; (void)NGW
    const int G0 = gridDim.x, bx0 = blockIdx.x;
#define WSP(T, off) ((T*)(opaque_ptr(args.ws) + (off)))
#define INP(T, i) ((const T*)lds_ptr((volatile LAS unsigned*)(L + PTAB_OFF), (i)))
#define CTLP ((unsigned*)(opaque_ptr(args.ws) + WS_CTL))
#define SUMSQP(k) ((float*)(opaque_ptr(args.ws) + WS_CTL) + CW_SUMSQ + (k) * MT)
#define AVSQP ((float*)(opaque_ptr(args.ws) + WS_CTL) + CW_AVSQ)
#define DOUT ((float*)opaque_ptr((unsigned char*)args.out))
    { const int tid = threadIdx.x;
    for (int u = tid; u < (LDS_BYTES - MISC_OFF) / 4; u += 512) ((LAS unsigned*)(L + MISC_OFF))[u] = 0u;
    __syncthreads();
    if (tid < 24) { const unsigned long long p = (unsigned long long)args.in[tid]; ((LAS unsigned*)(L + PTAB_OFF))[2 * tid] = (unsigned)p; ((LAS unsigned*)(L + PTAB_OFF))[2 * tid + 1] = (unsigned)(p >> 32); }
    __syncthreads(); }
    XcdBarrier bar = xcd_barrier_post(CTLP + CW_BAR, (volatile LAS unsigned*)(L + MISC_OFF + 32));

    {
        FRESH_IDS();
        LAS float* scr = (LAS float*)(L + wave * 16384);
        constexpr int IT_G = 32 * 176, IT_INE = 32 * 160, IT_O = 32 * 64, IT_INO = 32 * 128, IT_CW = 4 * 32;
        constexpr int NIT = 12 * IT_G + IT_INE + IT_O + IT_INO + IT_O + IT_CW;
        const float* norm_g = INP(float, 7);
        for (int it = gw; it < NIT; it += NGW) {
            int r = it;
            if (r < 12 * IT_G) {
                const int seg = r / IT_G, which = seg >> 2, lf = seg & 3, l = lf >> 1, f = lf & 1; r -= seg * IT_G;
                if (which == 0) tr_item(INP(float, 8) + (size_t)lf * DM * FF, DM, FF, norm_g + (l * 3 + f * 2) * DM, WSP(bf16_t, WS_WGU) + (size_t)lf * 2 * FF * DM, 1, scr, r, lane);
                else if (which == 1) tr_item(INP(float, 9) + (size_t)lf * DM * FF, DM, FF, norm_g + (l * 3 + f * 2) * DM, WSP(bf16_t, WS_WGU) + (size_t)lf * 2 * FF * DM, 2, scr, r, lane);
                else tr_item(INP(float, 10) + (size_t)lf * FF * DM, FF, DM, nullptr, WSP(bf16_t, WS_WD) + (size_t)lf * DM * FF, 0, scr, r, lane);
                continue;
            }
            r -= 12 * IT_G;
            if (r < IT_INE) { tr_item(INP(float, 11), DM, 5120, norm_g + 1 * DM, WSP(bf16_t, WS_WINE), 0, scr, r, lane); continue; } r -= IT_INE;
            if (r < IT_O) { tr_item(INP(float, 12), DM, DM, nullptr, WSP(bf16_t, WS_WOUTE), 0, scr, r, lane); continue; } r -= IT_O;
            if (r < IT_INO) { tr_item(INP(float, 19), DM, 4096, norm_g + 4 * DM, WSP(bf16_t, WS_WINO), 3, scr, r, lane); continue; } r -= IT_INO;
            if (r < IT_O) { tr_item(INP(float, 20), DM, DM, nullptr, WSP(bf16_t, WS_WOUTO), 0, scr, r, lane); continue; } r -= IT_O;
            { const int gi = r / 32; tr_item(INP(float, 21) + (size_t)gi * 65536, 256, 256, nullptr, WSP(bf16_t, WS_CWGT) + (size_t)gi * 65536, 0, scr, r % 32, lane); }
        }
        {
            const float* x_prompt = INP(float, 0); const float* x_sample = INP(float, 1);
            float* Y = WSP(float, WS_Y); bf16_t* XN = WSP(bf16_t, WS_XN); float* SQ = SUMSQP(0);
            for (int m = gw; m < MT; m += NGW) {
                const float* src = m < MP ? x_prompt + (size_t)m * DM : (m < MP + MS ? x_sample + (size_t)(m - MP) * DM : nullptr);
                float ss = 0.f;
#pragma unroll
                for (int j = 0; j < 8; ++j) {
                    const int c = 4 * lane + 256 * j;
                    f32x4 v = src ? *(const f32x4*)(src + c) : (f32x4){0.f, 0.f, 0.f, 0.f};
                    *(f32x4*)(Y + (size_t)m * DM + c) = v;
                    u32x2 w; w.x = cvt_pk_bf16(v[0], v[1]); w.y = cvt_pk_bf16(v[2], v[3]);
                    *(u32x2*)(XN + (size_t)m * DM + c) = w;
                    ss += (v[0] * v[0] + v[1] * v[1]) + (v[2] * v[2] + v[3] * v[3]);
                }
                ss = wave_sum(ss);
                if (lane == 0) SQ[m] = ss;
            }
        }
        {
            const float* a_ws = INP(float, 17); bf16_t* AWS = WSP(bf16_t, WS_AWS);
            for (int i = bx * 512 + tid; i < 8 * 128 * 128; i += G * 512) { const int p = (i >> 7) & 127, q = i & 127; AWS[i] = q <= p ? (bf16_t)(cvt_pk_bf16(a_ws[i], 0.f) & 0xffffu) : (bf16_t)0; }
            const float* state_pool = INP(float, 4); float* dout = DOUT;
            for (int i = bx * 512 + tid; i < DECB * 11 * 1024; i += G * 512) { const int b = i / (11 * 1024), rem = i % (11 * 1024); dout[O_PS + (size_t)b * 15 * 1024 + rem] = state_pool[(size_t)b * 15 * 1024 + 4 * 1024 + rem]; }
        }
    }
    xcd_barrier(bar);

    for (int layer = 0; layer < 2; ++layer) {
        for (int hs = 0; hs < 2; ++hs) {
            const int lf = layer * 2 + hs;
            {
                pg8::Gemm g{WSP(bf16_t, WS_XN), WSP(bf16_t, WS_WGU) + (size_t)lf * 2 * FF * DM, DM, DM, DM, 0};
                pg8::StaticOrder S; S.init(NPAN, 44, G0, bx0);
                pg8::EpiUp E{WSP(bf16_t, WS_ACT), SUMSQP(layer * 3 + hs * 2)};
                pg8::gemm_phase<pg8::EpiUp>(L, g, S, E);
            }
            xcd_barrier(bar);
            {
                const bool fin = (layer == 1 && hs == 1);
                pg8::Gemm g{WSP(bf16_t, WS_ACT), WSP(bf16_t, WS_WD) + (size_t)lf * DM * FF, FF, FF, FF, 0};
                pg8::StaticOrder S; S.init(NPAN, 8, G0, bx0);
                const int ni = hs == 0 ? layer * 3 + 1 : (layer + 1) * 3;
                pg8::EpiRes E{WSP(float, WS_Y), fin ? DOUT : WSP(float, WS_Y), fin ? MP + MS : MT, WSP(bf16_t, WS_XN), fin ? AVSQP : SUMSQP(ni), 0.5f};
                pg8::gemm_phase<pg8::EpiRes>(L, g, S, E);
            }
            if (layer == 1 && hs == 1) break;
            xcd_barrier(bar);
            if (hs == 1) continue;
            if (layer == 0) {
                {
                    pg8::Gemm g{WSP(bf16_t, WS_XN), WSP(bf16_t, WS_WINE), DM, DM, DM, 0};
                    pg8::StaticOrder S; S.init(NPAN, 20, G0, bx0);
                    pg8::EpiInEven E{SUMSQP(1), WSP(bf16_t, WS_T0), WSP(bf16_t, WS_T1), WSP(bf16_t, WS_T2), WSP(bf16_t, WS_T3), WSP(bf16_t, WS_T4), DOUT, INP(float, 13), INP(float, 14), AVSQP, (LAS float*)(L + RED_OFF)};
                    pg8::gemm_phase<pg8::EpiInEven>(L, g, S, E);
                }
                xcd_barrier(bar);
                {
                    FRESH_IDS();
                    for (int gu = bx; gu < 512; gu += G)
                        sba::gate_unit(WSP(bf16_t, WS_T4), WSP(bf16_t, WS_T3), WSP(bf16_t, WS_AWS), AVSQP, INP(float, 16), INP(float, 18), WSP(bf16_t, WS_MIX), (gu >> 3) * 128, gu & 7, (char*)lds);
                    for (int au = bx; au < 256; au += G) {
                        const int qb = 7 - (au >> 5), bh = au & 31, b = bh >> 3, h = bh & 7;
                        const size_t rb = (size_t)b * SEQ;
                        sba::attn_unit(WSP(bf16_t, WS_T0) + (rb + qb * 256) * 1024 + h * HD, WSP(bf16_t, WS_T1) + rb * 1024 + h * HD, WSP(bf16_t, WS_T2) + rb * 1024 + h * HD,
                                       WSP(bf16_t, WS_MIX) + (rb + qb * 256) * DM + 1024 + h * HD, qb * 256, INP(float, 15)[h] * LOG2E, (char*)lds);
                    }
                    if (bx < MS) {
                        const int row = MP + bx, b = bx >> 2, p = bx & 3;
                        const bf16_t* T3 = WSP(bf16_t, WS_T3); const bf16_t* T4 = WSP(bf16_t, WS_T4); bf16_t* MIX = WSP(bf16_t, WS_MIX);
                        const float* AVSQ = AVSQP; const float* a_v_norm_g = INP(float, 16); const float* a_ws = INP(float, 17); const float* a_bs = INP(float, 18); float* dout = DOUT;
                        for (int c = tid; c < AW; c += 512) {
                            const int gi = c >> 7; float mixv = a_bs[gi * 128 + p];
                            for (int q = 0; q <= p; ++q) {
                                const int rq = MP + b * 4 + q;
                                const float avn = __uint_as_float((unsigned)T4[(size_t)rq * 1024 + c] << 16) * __builtin_amdgcn_rsqf(AVSQ[rq] * (1.0f / AW) + EPS) * a_v_norm_g[c];
                                mixv += a_ws[(size_t)gi * 16384 + p * 128 + q] * avn;
                                if (q == p) dout[O_AV + (size_t)bx * 1024 + c] = avn;
                            }
                            const float au = __uint_as_float((unsigned)T3[(size_t)row * 1024 + c] << 16);
                            MIX[(size_t)row * DM + c] = (bf16_t)(cvt_pk_bf16(au * mixv, 0.f) & 0xffffu);
                        }
                    }
                    {
                        const bf16_t* T0 = WSP(bf16_t, WS_T0); const float* cache_k = INP(float, 2); const float* cache_v = INP(float, 3); const int* page_table = INP(int, 6);
                        const float* sb_bias = INP(float, 15); float* PO = WSP(float, WS_PO); float* PP = WSP(float, WS_PP); unsigned* qctr = CTLP + CW_QCTR;
                        for (;;) {
                            int item = 0;
                            if (lane == 0) item = (int)atomicAdd(qctr, 1u);
                            item = __builtin_amdgcn_readfirstlane(item);
                            if (item >= 64 * 32) break;
                            const int bh = item >> 5, run = item & 31, b = bh >> 3, h = bh & 7, hi = lane >> 5, l32 = lane & 31;
                            f32x4 qv[4];
#pragma unroll
                            for (int qi = 0; qi < 4; ++qi) { const u32x2 w = *(const u32x2*)(T0 + (size_t)(MP + b * 4 + qi) * 1024 + h * HD + 4 * l32);
                                qv[qi] = (f32x4){bf_lo(w.x), bf_hi(w.x), bf_lo(w.y), bf_hi(w.y)}; }
                            const float bias2 = sb_bias[h] * LOG2E;
                            f32x4 o[4] = {};
                            float C = 1.f;
                            const int qsel = (lane >> 3) & 3;
                            for (int pg = run * 4 + 3; pg >= run * 4; --pg) {
                                const int phys = page_table[b * NPAGES + pg];
                                const float* kb = cache_k + ((size_t)phys * PAGE * NH + h) * HD + 4 * l32;
                                const float* vb = cache_v + ((size_t)phys * PAGE * NH + h) * HD + 4 * l32;
                                for (int c8 = 15; c8 >= 0; --c8) {
                                    f32x4 kk[4], vv[4];
#pragma unroll
                                    for (int s = 0; s < 4; ++s) { const int tok = c8 * 8 + 7 - 2 * s - hi; kk[s] = *(const f32x4*)(kb + (size_t)tok * NH * HD); vv[s] = *(const f32x4*)(vb + (size_t)tok * NH * HD); }
#pragma unroll
                                    for (int s = 0; s < 4; ++s) {
                                        float d0 = (kk[s][0] * qv[0][0] + kk[s][1] * qv[0][1]) + (kk[s][2] * qv[0][2] + kk[s][3] * qv[0][3]);
                                        float d1 = (kk[s][0] * qv[1][0] + kk[s][1] * qv[1][1]) + (kk[s][2] * qv[1][2] + kk[s][3] * qv[1][3]);
                                        float d2 = (kk[s][0] * qv[2][0] + kk[s][1] * qv[2][1]) + (kk[s][2] * qv[2][2] + kk[s][3] * qv[2][3]);
                                        float d3 = (kk[s][0] * qv[3][0] + kk[s][1] * qv[3][1]) + (kk[s][2] * qv[3][2] + kk[s][3] * qv[3][3]);
                                        const bool b4 = (lane & 16) != 0, b3 = (lane & 8) != 0;
                                        float ka = b4 ? d2 : d0, kb2 = b4 ? d3 : d1, sa = b4 ? d0 : d2, sb = b4 ? d1 : d3;
                                        ka += __shfl_xor(sa, 16); kb2 += __shfl_xor(sb, 16);
                                        float kc = b3 ? kb2 : ka, sc2 = b3 ? ka : kb2;
                                        kc += __shfl_xor(sc2, 8);
                                        kc += __shfl_xor(kc, 4); kc += __shfl_xor(kc, 2); kc += __shfl_xor(kc, 1);
                                        const float e = fast_exp2(kc + bias2), f = 1.f + e;
                                        const float fo = xchg32(f, hi);
                                        const float Cn = C * f * fo;
                                        const float A = e * fast_rcp(hi ? Cn : C * f);
                                        C = Cn;
                                        const float A0 = __shfl(A, (lane & 32) | 0), A1 = __shfl(A, (lane & 32) | 8), A2 = __shfl(A, (lane & 32) | 16), A3 = __shfl(A, (lane & 32) | 24);
                                        o[0] += vv[s] * A0; o[1] += vv[s] * A1; o[2] += vv[s] * A2; o[3] += vv[s] * A3;
                                    }
                                }
                            }
#pragma unroll
                            for (int qi = 0; qi < 4; ++qi) {
#pragma unroll
                                for (int j = 0; j < 4; ++j) o[qi][j] += xchg32(o[qi][j], hi);
                                if (hi == 0) *(f32x4*)(PO + ((size_t)item * 4 + qi) * HD + 4 * l32) = o[qi];
                            }
                            if ((lane & 39) == 0) PP[(size_t)item * 4 + qsel] = C;
                        }
                    }
                }
                xcd_barrier(bar);
                {
                    FRESH_IDS();
                    const bf16_t* T0 = WSP(bf16_t, WS_T0); const bf16_t* T1 = WSP(bf16_t, WS_T1); const bf16_t* T2 = WSP(bf16_t, WS_T2); bf16_t* MIX = WSP(bf16_t, WS_MIX);
                    const float* sb_bias = INP(float, 15); const float* PO = WSP(float, WS_PO); const float* PP = WSP(float, WS_PP);
                    for (int bh = gw; bh < 64; bh += NGW) {
                        const int b = bh >> 3, h = bh & 7; const float bias2 = sb_bias[h] * LOG2E;
                        float qd[4][2], kd[4][2], vd[4][2];
#pragma unroll
                        for (int i = 0; i < 4; ++i) {
                            const size_t ro = (size_t)(MP + b * 4 + i) * 1024 + h * HD + 2 * lane;
                            const unsigned qw = *(const unsigned*)(T0 + ro), kw = *(const unsigned*)(T1 + ro), vw = *(const unsigned*)(T2 + ro);
                            qd[i][0] = bf_lo(qw); qd[i][1] = bf_hi(qw); kd[i][0] = bf_lo(kw); kd[i][1] = bf_hi(kw); vd[i][0] = bf_lo(vw); vd[i][1] = bf_hi(vw);
                        }
#pragma unroll
                        for (int i = 0; i < 4; ++i) {
                            float o0 = 0.f, o1 = 0.f, P = 1.f;
#pragma unroll
                            for (int j = 3; j >= 0; --j) {
                                if (j < i) {
                                    const float z = wave_sum(qd[i][0] * kd[j][0] + qd[i][1] * kd[j][1]) + bias2;
                                    const float e = fast_exp2(z); P *= (1.f + e);
                                    const float A = e / P; o0 += A * vd[j][0]; o1 += A * vd[j][1];
                                }
                            }
                            float scale = 1.f / P;
                            for (int run = 31; run >= 0; --run) {
                                const size_t it = (size_t)bh * 32 + run;
                                const f32x2 po = *(const f32x2*)(PO + (it * 4 + i) * HD + 2 * lane);
                                o0 += po[0] * scale; o1 += po[1] * scale;
                                scale = scale / PP[it * 4 + i];
                            }
                            *(unsigned*)(MIX + (size_t)(MP + b * 4 + i) * DM + 1024 + h * HD + 2 * lane) = cvt_pk_bf16(o0, o1);
                        }
                    }
                }
                xcd_barrier(bar);
                {
                    pg8::Gemm g{WSP(bf16_t, WS_MIX), WSP(bf16_t, WS_WOUTE), DM, DM, DM, 0};
                    pg8::StaticOrder S; S.init(NPAN, 8, G0, bx0);
                    pg8::EpiRes E{WSP(float, WS_Y), WSP(float, WS_Y), MT, WSP(bf16_t, WS_XN), SUMSQP(2), 1.0f};
                    pg8::gemm_phase<pg8::EpiRes>(L, g, S, E);
                }
                xcd_barrier(bar);
            } else {
                {
                    pg8::Gemm g{WSP(bf16_t, WS_XN), WSP(bf16_t, WS_WINO), DM, DM, DM, 0};
                    pg8::StaticOrder S; S.init(NPAN, 16, G0, bx0);
                    pg8::EpiInOdd E{SUMSQP(4), WSP(bf16_t, WS_T0), WSP(bf16_t, WS_T1), WSP(bf16_t, WS_T2), DOUT};
                    pg8::gemm_phase<pg8::EpiInOdd>(L, g, S, E);
                }
                xcd_barrier(bar);
                {
                    FRESH_IDS();
                    const bf16_t* T0 = WSP(bf16_t, WS_T0); const bf16_t* T1 = WSP(bf16_t, WS_T1); const bf16_t* T2 = WSP(bf16_t, WS_T2); bf16_t* T3 = WSP(bf16_t, WS_T3); bf16_t* MIX = WSP(bf16_t, WS_MIX);
                    const float* state_pool = INP(float, 4); const float* state_conv = INP(float, 5); const float* d_conv_w = INP(float, 23);
                    for (int it = bx * 512 + tid; it < (MP + MS) * 128; it += G * 512) {
                        const int row = it >> 7, c = (it & 127) * 8, grp = c >> 8, win = 2 << grp;
                        float acc[8] = {0.f, 0.f, 0.f, 0.f, 0.f, 0.f, 0.f, 0.f}, self[8] = {0.f, 0.f, 0.f, 0.f, 0.f, 0.f, 0.f, 0.f}, gsum[8];
                        float cnt;
                        if (row < MP) {
                            const int t = row & (SEQ - 1); const int n = t + 1 < win ? t + 1 : win; cnt = (float)n;
                            for (int k = 0; k < n; ++k) { float v[8]; ld8(T0 + (size_t)(row - k) * 1024 + c, v);
#pragma unroll
                                for (int j = 0; j < 8; ++j) { acc[j] += v[j]; if (k == 0) self[j] = v[j]; } }
                            float g0[8], g1[8], g2[8];
                            ld8(T2 + (size_t)row * 1024 + c, g2);
                            ld8(T2 + (size_t)(t >= 1 ? row - 1 : row) * 1024 + c, g1);
                            ld8(T2 + (size_t)(t >= 2 ? row - 2 : row) * 1024 + c, g0);
                            const float m1 = t >= 1 ? 1.f : 0.f, m0 = t >= 2 ? 1.f : 0.f;
#pragma unroll
                            for (int j = 0; j < 8; ++j) gsum[j] = g0[j] * m0 * d_conv_w[c + j] + g1[j] * m1 * d_conv_w[1024 + c + j] + g2[j] * d_conv_w[2048 + c + j];
                        } else {
                            const int sr = row - MP, b = sr >> 2, i = sr & 3; cnt = (float)win;
                            for (int k = 0; k < win; ++k) {
                                const int fi = 15 + i - k; float v[8];
                                if (fi >= 15) ld8(T0 + (size_t)(MP + b * 4 + (fi - 15)) * 1024 + c, v);
                                else { const float* sp = state_pool + ((size_t)b * 15 + fi) * 1024 + c;
#pragma unroll
                                    for (int j = 0; j < 8; ++j) v[j] = sp[j]; }
#pragma unroll
                                for (int j = 0; j < 8; ++j) { acc[j] += v[j]; if (k == 0) self[j] = v[j]; }
                            }
#pragma unroll
                            for (int j = 0; j < 8; ++j) gsum[j] = 0.f;
                            for (int k = 0; k < 3; ++k) {
                                const int gi = i - 2 + k; float gg[8];
                                if (gi >= 0) ld8(T2 + (size_t)(MP + b * 4 + gi) * 1024 + c, gg);
                                else { const float* sp = state_conv + ((size_t)b * 2 + (gi + 2)) * 1024 + c;
#pragma unroll
                                    for (int j = 0; j < 8; ++j) gg[j] = sp[j]; }
#pragma unroll
                                for (int j = 0; j < 8; ++j) gsum[j] += gg[j] * d_conv_w[k * 1024 + c + j];
                            }
                        }
                        const float ic = 1.0f / cnt;
                        float gbv[8]; ld8(T1 + (size_t)row * 1024 + c, gbv);
                        u32x4 wp, wd;
                        wp.x = cvt_pk_bf16(acc[0] * ic - self[0], acc[1] * ic - self[1]); wp.y = cvt_pk_bf16(acc[2] * ic - self[2], acc[3] * ic - self[3]);
                        wp.z = cvt_pk_bf16(acc[4] * ic - self[4], acc[5] * ic - self[5]); wp.w = cvt_pk_bf16(acc[6] * ic - self[6], acc[7] * ic - self[7]);
                        wd.x = cvt_pk_bf16(gbv[0] * gsum[0], gbv[1] * gsum[1]); wd.y = cvt_pk_bf16(gbv[2] * gsum[2], gbv[3] * gsum[3]);
                        wd.z = cvt_pk_bf16(gbv[4] * gsum[4], gbv[5] * gsum[5]); wd.w = cvt_pk_bf16(gbv[6] * gsum[6], gbv[7] * gsum[7]);
                        *(u32x4*)(T3 + (size_t)row * 1024 + c) = wp;
                        *(u32x4*)(MIX + (size_t)row * DM + 1024 + c) = wd;
                    }
                }
                xcd_barrier(bar);
                {
                    pg8::Gemm g{WSP(bf16_t, WS_T3), WSP(bf16_t, WS_CWGT), 1024, 256, 256, 256};
                    pg8::StaticOrder S; S.init(NPAN, 4, G0, bx0);
                    pg8::EpiPool E{WSP(bf16_t, WS_MIX), INP(float, 22)};
                    pg8::gemm_phase<pg8::EpiPool>(L, g, S, E);
                }
                xcd_barrier(bar);
                {
                    pg8::Gemm g{WSP(bf16_t, WS_MIX), WSP(bf16_t, WS_WOUTO), DM, DM, DM, 0};
                    pg8::StaticOrder S; S.init(NPAN, 8, G0, bx0);
                    pg8::EpiRes E{WSP(float, WS_Y), WSP(float, WS_Y), MT, WSP(bf16_t, WS_XN), SUMSQP(5), 1.0f};
                    pg8::gemm_phase<pg8::EpiRes>(L, g, S, E);
                }
                xcd_barrier(bar);
            }
        }
    }
}

extern "C" void kernel_launch(void* const* d_in, const int* in_sizes, int n_in, void* d_out, int out_size, void* d_ws, size_t ws_size, hipStream_t stream) {
    static int grid = 0;
    if (grid == 0) {
        if (n_in != 24 || ws_size < WS_END || out_size != (int)O_END) { fprintf(stderr, "kernel_launch: unexpected problem (n_in %d, out %d, ws %zu)\n", n_in, out_size, ws_size); grid = -1; return; }
        int dev = 0, cus = 0, per_cu = 0;
        if (hipGetDevice(&dev) != hipSuccess || hipDeviceGetAttribute(&cus, hipDeviceAttributeMultiprocessorCount, dev) != hipSuccess) { grid = -1; return; }
        if (hipFuncSetAttribute((const void*)mega_fwd, hipFuncAttributeMaxDynamicSharedMemorySize, LDS_BYTES) != hipSuccess) { fprintf(stderr, "kernel_launch: hipFuncSetAttribute failed\n"); grid = -1; return; }
        if (hipOccupancyMaxActiveBlocksPerMultiprocessor(&per_cu, (const void*)mega_fwd, 512, LDS_BYTES) != hipSuccess || per_cu < 1) { fprintf(stderr, "kernel_launch: occupancy query says %d\n", per_cu); }
        (void)hipGetLastError();
        grid = cus;
    }
    if (grid < 0) return;
    (void)hipMemsetAsync((char*)d_ws + WS_CTL, 0, CTL_BYTES, stream);
    Args a{};
    for (int i = 0; i < 24; ++i) a.in[i] = d_in[i];
    a.out = (float*)d_out; a.ws = (unsigned char*)d_ws;
    hipLaunchKernelGGL(mega_fwd, dim3(grid), dim3(512), LDS_BYTES, stream, a);
}
```

```cpp
#include <hip/hip_runtime.h>
#include <cstdio>
#include <cstdint>

#define GAS __attribute__((address_space(1)))
#define LAS __attribute__((address_space(3)))
typedef unsigned short bf16_t;
typedef short bf16x8 __attribute__((ext_vector_type(8)));
typedef short s16x4 __attribute__((ext_vector_type(4)));
typedef float f32x4 __attribute__((ext_vector_type(4)));
typedef float f32x2 __attribute__((ext_vector_type(2)));
typedef float f32x16 __attribute__((ext_vector_type(16)));
typedef unsigned u32x4 __attribute__((ext_vector_type(4)));
typedef unsigned u32x2 __attribute__((ext_vector_type(2)));

#ifndef FP8_DOWN_FROM
#define FP8_DOWN_FROM 3
#endif
constexpr int G_UP = 242, G_INE = 220;
#ifndef REP_PRO
#define REP_PRO 1
#endif
#ifndef REP_UP
#define REP_UP 1
#endif
#ifndef REP_MIX
#define REP_MIX 1
#endif
#ifndef REP_BAR
#define REP_BAR 1
#endif
#ifndef REP_ODD
#define REP_ODD 1
#endif
#ifndef REP_CMB
#define REP_CMB 1
#endif
constexpr int DM = 2048, FF = 5632, SEQ = 2048, NBATCH = 4, MP = 8192, MS = 32, MT = 8448, NPAN = 33;
constexpr int NH = 8, HD = 128, AW = 1024, NPAGES = 128, PAGE = 128, DECB = 8, DECS = 4;
constexpr float EPS = 1e-6f;
constexpr float LOG2E = 1.4426950408889634f;
constexpr float QSCALE = 0.08838834764831845f * LOG2E;
constexpr size_t O_YP = 0, O_YS = 16777216, O_KP = 16842752, O_VP = 25231360, O_KS = 33619968, O_VS = 33652736, O_AV = 33685504,
                 O_PP = 33718272, O_PS = 33779712, O_CP = 33902592, O_CS = 33910784, O_END = 33927168;

constexpr size_t al(size_t x) { return (x + 1048575) & ~(size_t)1048575; }
constexpr size_t WS_CTL = 0, CTL_BYTES = 1048576;
constexpr size_t SZ_WGU = (size_t)2 * FF * DM * 2, SZ_WD = (size_t)DM * FF * 2;
constexpr size_t WS_WGU = al(WS_CTL + CTL_BYTES);
constexpr size_t WS_WD = al(WS_WGU + 4 * SZ_WGU);
constexpr size_t WS_WINE = al(WS_WD + 4 * SZ_WD);
constexpr size_t WS_WOUTE = al(WS_WINE + (size_t)5120 * DM * 2);
constexpr size_t WS_WINO = al(WS_WOUTE + (size_t)DM * DM * 2);
constexpr size_t WS_WOUTO = al(WS_WINO + (size_t)4096 * DM * 2);
constexpr size_t WS_AWS = al(WS_WOUTO + (size_t)DM * DM * 2);
constexpr size_t WS_CWGT = al(WS_AWS + 8 * 128 * 128 * 2);
constexpr size_t WS_XN = al(WS_CWGT + 1024 * 256 * 2);
constexpr size_t WS_ACT = al(WS_XN + (size_t)MT * DM * 2);
constexpr size_t WS_Y = al(WS_ACT + (size_t)MT * FF * 2);
constexpr size_t SZ_T = (size_t)MT * 1024 * 2;
constexpr size_t WS_T0 = al(WS_Y + (size_t)MT * DM * 4);
constexpr size_t WS_T1 = al(WS_T0 + SZ_T);
constexpr size_t WS_T2 = al(WS_T1 + SZ_T);
constexpr size_t WS_T3 = al(WS_T2 + SZ_T);
constexpr size_t WS_T4 = al(WS_T3 + SZ_T);
constexpr size_t WS_MIX = al(WS_T4 + SZ_T);
constexpr size_t WS_PO = al(WS_MIX + (size_t)MT * DM * 2);
constexpr size_t WS_PP = al(WS_PO + (size_t)64 * 32 * 4 * 128 * 4);
constexpr size_t WS_SLAB = al(WS_PP + 64 * 32 * 4 * 4);
constexpr size_t WS_PART = al(WS_SLAB + (size_t)22 * 32 * 2048 * 4);
constexpr size_t WS_XNQ = al(WS_PART + (size_t)MP * 32 * 4);
constexpr size_t WS_END = al(WS_XNQ + (size_t)MT * DM);
constexpr int CW_BAR = 4096, CW_QCTR = 8192, CW_CONV = 9216, CW_GATE = 12288  , CW_SUMSQ = 16384, CW_AVSQ = 16384 + 6 * MT + 512;
static_assert((CW_AVSQ + MT) * 4 <= 1048576, "ctl");

constexpr int RING_BYTES = 131072, RED_OFF = RING_BYTES, RED_BYTES = 8192, MISC_OFF = RED_OFF + RED_BYTES, LDS_BYTES = 147456;

#define LDS_WAIT() asm volatile("s_waitcnt lgkmcnt(0)" ::: "memory")
#define VM_WAIT() asm volatile("s_waitcnt vmcnt(0)" ::: "memory")
__device__ __forceinline__ unsigned cvt_pk_bf16(float lo, float hi) { unsigned r; asm volatile("v_cvt_pk_bf16_f32 %0, %1, %2" : "=v"(r) : "v"(lo), "v"(hi)); return r; }
__device__ __forceinline__ unsigned pk_fp8x4(float a, float b, float c, float d) {
    a = fminf(fmaxf(a, -440.f), 440.f); b = fminf(fmaxf(b, -440.f), 440.f); c = fminf(fmaxf(c, -440.f), 440.f); d = fminf(fmaxf(d, -440.f), 440.f);
    int w = __builtin_amdgcn_cvt_pk_fp8_f32(a, b, 0, false); w = __builtin_amdgcn_cvt_pk_fp8_f32(c, d, w, true); return (unsigned)w;
}
constexpr float S8_W = 64.f, S8_ACT = 8.f;
constexpr float SQ_W = 127.f / 0.0884f;
__host__ __device__ constexpr float sqx_of(int lf) { return 127.f / (lf == 0 ? 4.5f : (lf == 1 ? 5.5f : (lf == 2 ? 6.5f : 7.0f))); }
__device__ __forceinline__ unsigned pk_i8x4(float a, float b, float c, float d) {
    const int ia = (int)__builtin_rintf(fminf(fmaxf(a, -127.f), 127.f)), ib = (int)__builtin_rintf(fminf(fmaxf(b, -127.f), 127.f)),
              ic = (int)__builtin_rintf(fminf(fmaxf(c, -127.f), 127.f)), id = (int)__builtin_rintf(fminf(fmaxf(d, -127.f), 127.f));
    return ((unsigned)ia & 0xffu) | (((unsigned)ib & 0xffu) << 8) | (((unsigned)ic & 0xffu) << 16) | ((unsigned)id << 24);
}
__device__ __forceinline__ float bf_lo(unsigned w) { return __uint_as_float(w << 16); }
__device__ __forceinline__ float bf_hi(unsigned w) { return __uint_as_float(w & 0xffff0000u); }
__device__ __forceinline__ float fast_rcp(float x) { return __builtin_amdgcn_rcpf(x); }
__device__ __forceinline__ float fast_exp2(float x) { return __builtin_amdgcn_exp2f(x); }
__device__ __forceinline__ float gelu_tanh(float x) {
    const float t = x * (1.0f + 0.044715f * x * x) * (-2.0f * 0.7978845608028654f * LOG2E);
    return x * fast_rcp(1.0f + fast_exp2(t));
}
__device__ __forceinline__ float xchg32(float x, int hi) {
    auto rr = __builtin_amdgcn_permlane32_swap(__float_as_uint(x), __float_as_uint(x), false, false);
    return __uint_as_float(hi ? rr[0] : rr[1]);
}

template <int CTRL> __device__ __forceinline__ float dppf(float x) { return __int_as_float(__builtin_amdgcn_update_dpp(0, __float_as_int(x), CTRL, 0xf, 0xf, true)); }
__device__ __forceinline__ float xchg16(float x, bool b4) { auto rr = __builtin_amdgcn_permlane16_swap(__float_as_uint(x), __float_as_uint(x), false, false); return __uint_as_float(b4 ? rr[0] : rr[1]); }
__device__ __forceinline__ float sum_x16(float x) { auto rr = __builtin_amdgcn_permlane16_swap(__float_as_uint(x), __float_as_uint(x), false, false); return __uint_as_float(rr[0]) + __uint_as_float(rr[1]); }
__device__ __forceinline__ float sum_x32(float x) { auto rr = __builtin_amdgcn_permlane32_swap(__float_as_uint(x), __float_as_uint(x), false, false); return __uint_as_float(rr[0]) + __uint_as_float(rr[1]); }
__device__ __forceinline__ float sum_row16(float x) { x += dppf<0xB1>(x); x += dppf<0x4E>(x); x += dppf<0x141>(x); x += dppf<0x140>(x); return x; }
__device__ __forceinline__ int fresh_tid(int wave0) { int l; asm volatile("v_mbcnt_lo_u32_b32 %0, -1, 0\n\tv_mbcnt_hi_u32_b32 %0, -1, %0" : "=v"(l)); return wave0 * 64 + l; }
#define XB_TMO      128
#define XB_XCNT(j)  (256  + 64 * (j))
#define XB_XSUB(j)  (1280 + 64 * (j))
#define XB_XGEN(j)  (2304 + 64 * (j))
#define XB_TOP      3328
#define XB_TOPGEN   3392
#define XCD_BAR_WORDS 3456
#define XB_SPIN_CAP (1u << 22)
__device__ __forceinline__ unsigned xb_ld(unsigned* p)              { return __hip_atomic_load(p, __ATOMIC_RELAXED, __HIP_MEMORY_SCOPE_AGENT); }
__device__ __forceinline__ unsigned xb_add(unsigned* p, unsigned v) { return __hip_atomic_fetch_add(p, v, __ATOMIC_RELAXED, __HIP_MEMORY_SCOPE_AGENT); }
__device__ __forceinline__ unsigned xb_xcc_id() { return (unsigned)__builtin_amdgcn_s_getreg((3 << 11) | 20) & 0xFu; }
#define XB_SPIN(cond, bar) do { unsigned _sp = 0; while (cond) { __builtin_amdgcn_s_sleep(1); \
    if ((++_sp & 255u) == 0u) { if (xb_ld(&(bar)[XB_TMO])) break; if (_sp > XB_SPIN_CAP) { atomicAdd(&(bar)[XB_TMO], 1u); break; } } } } while (0)
struct XcdBarrier { unsigned* bar; unsigned x; volatile LAS unsigned* st; };
__device__ __forceinline__ XcdBarrier xcd_barrier_post(unsigned* bar, volatile LAS unsigned* st, int wave0) {
    XcdBarrier b; b.bar = bar; b.x = (unsigned)wave0; b.st = st;
    if (fresh_tid(wave0) == 0) (void)xb_add(&bar[XB_XCNT(xb_xcc_id())], 1u);
    return b;
}
__device__ __forceinline__ void xcd_barrier_complete(unsigned* bar, unsigned x, unsigned& nloc, unsigned& nx) {
    const unsigned G = gridDim.x * gridDim.y * gridDim.z;
    unsigned sum, cnt, mine, sp = 0u;
    for (;;) {
        sum = 0u; cnt = 0u; mine = 0u;
#pragma unroll
        for (unsigned j = 0; j < 16; ++j) { const unsigned c = xb_ld(&bar[XB_XCNT(j)]); sum += c; cnt += (c > 0u) ? 1u : 0u; }
        mine = xb_ld(&bar[XB_XCNT(x)]);
        if (sum == G) break;
        __builtin_amdgcn_s_sleep(1);
        if ((++sp & 255u) == 0u) { if (xb_ld(&bar[XB_TMO])) break; if (sp > XB_SPIN_CAP) { atomicAdd(&bar[XB_TMO], 1u); break; } }
    }
    nloc = mine > 0u ? mine : 1u; nx = cnt > 0u ? cnt : 1u;
}
__device__ __forceinline__ void xcd_barrier1(const XcdBarrier& b) {
    asm volatile("s_waitcnt vmcnt(0)" ::: "memory");
    __syncthreads();
    if (fresh_tid((int)b.x) == 0) {
        unsigned* bar = b.bar; asm volatile("" : "+s"(bar));
        unsigned bx_; asm volatile("s_getreg_b32 %0, hwreg(20, 0, 4)" : "=s"(bx_));
        bx_ &= 0xFu;
        __builtin_amdgcn_s_waitcnt(0);
        unsigned nloc = b.st[0], nx = b.st[1];
        if (nloc == 0u) { xcd_barrier_complete(bar, bx_, nloc, nx); b.st[0] = nloc; b.st[1] = nx; }
        const unsigned old = xb_add(&bar[XB_XSUB(bx_)], 1u);
        const unsigned gen = old / nloc;
        if (old + 1u == (gen + 1u) * nloc) {
            __builtin_amdgcn_fence(__ATOMIC_RELEASE, "agent");
            asm volatile("s_waitcnt vmcnt(0)" ::: "memory");
            const unsigned og = xb_add(&bar[XB_TOP], 1u);
            const unsigned tg = og / nx;
            if (og + 1u == (tg + 1u) * nx) xb_add(&bar[XB_TOPGEN], 1u);
            else XB_SPIN(xb_ld(&bar[XB_TOPGEN]) == tg, bar);
            __builtin_amdgcn_fence(__ATOMIC_ACQUIRE, "agent");
            xb_add(&bar[XB_XGEN(bx_)], 1u);
            asm volatile("s_waitcnt vmcnt(0)" ::: "memory");
        } else {
            XB_SPIN(xb_ld(&bar[XB_XGEN(bx_)]) == gen, bar);
            __builtin_amdgcn_fence(__ATOMIC_ACQUIRE, "agent");
            asm volatile("s_waitcnt vmcnt(0)" ::: "memory");
        }
    }
    __syncthreads();
}

__device__ __forceinline__ void xcd_barrier(const XcdBarrier& b) { for (int r = 0; r < REP_BAR; ++r) xcd_barrier1(b); }
namespace pg8 {
constexpr int BM = 256, BK = 64, HALF = 128, HTB = HALF * BK * 2, NXCD = 8, WGM = 8;
__host__ __device__ __forceinline__ int lds_byte(int r, int c) { const int st = (r >> 4) * 2 + (c >> 5), rr = r & 15, cc = c & 31, ob = rr * 64 + cc * 2; return st * 1024 + (ob ^ (((ob >> 9) & 1) << 5)); }
__host__ __device__ __forceinline__ void stage_rc(int b, int& R, int& C) { const int st = b / 1024, sb = b % 1024, swz = sb ^ (((sb >> 9) & 1) << 5); R = (st >> 1) * 16 + swz / 64; C = (st & 1) * 32 + (swz % 64) / 2; }
__host__ __device__ __forceinline__ int perm32(int rho) { const int n = rho >> 4, i = rho & 15; return 8 * (i >> 2) + 4 * n + (i & 3); }
struct Unit { int pm, pn, kt0, nkt; };
struct Gemm { const void* A; const void* Bt; int lda, ldb, K, acs; };
struct StaticOrder {
    int nM, nN, nwg, G, c, S, ntk, i0 = 0, dpm = -1, dpn = 0; bool same = false;
    __device__ __forceinline__ void init(int nM_, int nN_, int G_, int c_, int S_ = 0, int ntk_ = 0) { asm volatile("" : "+s"(G_), "+s"(c_)); nM = nM_; nN = nN_; nwg = nM * nN; G = G_; c = c_; S = S_; ntk = ntk_; }
    __device__ __forceinline__ bool next(int i, Unit& u) const {
        if (dpm >= 0) { u.pm = dpm; u.pn = dpn; u.kt0 = 0; u.nkt = ntk; return i == 0; }
        const long L = (long)(i + i0) * G + c;
        const bool is_main = L < nwg;
        const int s = (int)(L - nwg), Sd = S > 0 ? S : 1;
        if (!is_main && s >= nN * S) return false;
        int wgid = is_main ? (int)L : 0; { const int q = nwg / NXCD, r = nwg % NXCD, xcd = wgid % NXCD, off = wgid / NXCD; wgid = (xcd < r ? xcd * (q + 1) : r * (q + 1) + (xcd - r) * q) + off; }
        const int nig = WGM * nN, gid = wgid / nig, fm = gid * WGM, gsz = (nM - fm) < WGM ? (nM - fm) : WGM;
        const int nks = ntk / Sd;
        u.pm = is_main ? fm + ((wgid % nig) % gsz) : 32; u.pn = is_main ? (wgid % nig) / gsz : s % nN;
        u.kt0 = is_main ? 0 : (s / nN) * nks; u.nkt = is_main ? ntk : nks; if (same) { u.pm = 0; u.pn = 0; } return true;
    }
};
template <class Epi, int MODE = 0  >
__device__ __forceinline__ void gemm_phase(LAS unsigned char* lds, const Gemm g, const StaticOrder& S, const Epi& E, int wave0, unsigned* gate = nullptr, unsigned need = 0u) {
    const int tid = fresh_tid(wave0);
    const int wid = __builtin_amdgcn_readfirstlane(tid >> 6), lane = tid & 63, wr = wid >> 2, wc = wid & 3, fr = lane & 15, fq = lane >> 4;
    int K = g.K, lda_ = g.lda, ldb_ = g.ldb; asm volatile("" : "+s"(K), "+s"(lda_), "+s"(ldb_));
    unsigned voffA[2], voffB[2];
#pragma unroll
    for (int i = 0; i < 2; ++i) { int R, C; stage_rc(tid * 16 + i * 8192, R, C); const int Rb = (R & ~31) + perm32(R & 31);
        voffA[i] = (unsigned)(R * lda_ + C * 2); voffB[i] = (unsigned)(Rb * ldb_ + C * 2); }
    const size_t kstep = (size_t)(BK * 2);
    const size_t hstepA = (size_t)HALF * lda_, hstepB = (size_t)HALF * ldb_;
    const size_t tstepA = 2 * hstepA, tstepB = 2 * hstepB;
    const unsigned ldsw = (unsigned)wid * 1024u;
    const int aoff = lds_byte(wr * 64 + fr, fq * 8), boff = lds_byte(wc * 32 + fr, fq * 8);
#define PG8_SA(b, h) (((b) * 2 + (h)) * HTB)
#define PG8_SB(b, h) ((4 + (b) * 2 + (h)) * HTB)
#define PG8_STAGE(bufoff, gbase, voff) do { _Pragma("unroll") for (int _i = 0; _i < 2; ++_i) \
        __builtin_amdgcn_global_load_lds((const GAS unsigned*)((gbase) + (voff)[_i]), (LAS unsigned*)(lds + (bufoff) + ldsw + _i * 8192), 16, 0, 0); } while (0)
#define PG8_LDA(dst, b, h) do { _Pragma("unroll") for (int m = 0; m < 4; ++m) _Pragma("unroll") for (int k = 0; k < 2; ++k) dst[m][k] = *(const LAS bf16x8*)(lds + PG8_SA(b, h) + aoff + m * 2048 + k * 1024); } while (0)
#define PG8_LDB(dst, b, h) do { _Pragma("unroll") for (int n = 0; n < 2; ++n) _Pragma("unroll") for (int k = 0; k < 2; ++k) dst[n][k] = *(const LAS bf16x8*)(lds + PG8_SB(b, h) + boff + n * 2048 + k * 1024); } while (0)
#define PG8_MMA(ai, bj, At, Bt) do { __builtin_amdgcn_s_setprio(1); _Pragma("unroll") for (int m = 0; m < 4; ++m) _Pragma("unroll") for (int n = 0; n < 2; ++n) { \
        if constexpr (MODE == 2) { typedef int v4i_ __attribute__((ext_vector_type(4))); \
            _Pragma("unroll") for (int k = 0; k < 2; ++k) acc[ai][bj][m][n] = __builtin_bit_cast(f32x4, __builtin_amdgcn_mfma_i32_16x16x64_i8(__builtin_bit_cast(v4i_, Bt[n][k]), __builtin_bit_cast(v4i_, At[m][k]), __builtin_bit_cast(v4i_, acc[ai][bj][m][n]), 0, 0, 0)); \
        } else if constexpr (MODE == 1) { typedef int v8i_ __attribute__((ext_vector_type(8))); typedef int v4i_ __attribute__((ext_vector_type(4))); \
            const v4i_ b0_ = __builtin_bit_cast(v4i_, Bt[n][0]), b1_ = __builtin_bit_cast(v4i_, Bt[n][1]), a0_ = __builtin_bit_cast(v4i_, At[m][0]), a1_ = __builtin_bit_cast(v4i_, At[m][1]); \
            const v8i_ bb_ = {b0_[0], b0_[1], b0_[2], b0_[3], b1_[0], b1_[1], b1_[2], b1_[3]}, aa_ = {a0_[0], a0_[1], a0_[2], a0_[3], a1_[0], a1_[1], a1_[2], a1_[3]}; \
            acc[ai][bj][m][n] = __builtin_amdgcn_mfma_scale_f32_16x16x128_f8f6f4(bb_, aa_, acc[ai][bj][m][n], 0, 0, 0, 0x7f7f7f7f, 0, 0x7f7f7f7f); \
        } else { _Pragma("unroll") for (int k = 0; k < 2; ++k) acc[ai][bj][m][n] = __builtin_amdgcn_mfma_f32_16x16x32_bf16(Bt[n][k], At[m][k], acc[ai][bj][m][n], 0, 0, 0); } } \
        __builtin_amdgcn_s_setprio(0); } while (0)
#define PG8_WAIT_V(n) asm volatile("s_waitcnt vmcnt(" #n ")" ::: "memory")
#define PG8_WAIT_L(n) asm volatile("s_waitcnt lgkmcnt(" #n ")" ::: "memory")
#define PG8_BAR __builtin_amdgcn_s_barrier()
#define PG8_SCHED __builtin_amdgcn_sched_barrier(0)
    Unit cur, nxt; int ui = 0;
    if (!S.next(0, cur)) return;
    f32x4 acc[2][2][4][2];
#pragma unroll
    for (int a = 0; a < 2; ++a)
#pragma unroll
        for (int b = 0; b < 2; ++b)
#pragma unroll
            for (int m = 0; m < 4; ++m)
#pragma unroll
                for (int n = 0; n < 2; ++n) acc[a][b][m][n] = (f32x4){0.f, 0.f, 0.f, 0.f};
    bf16x8 At[4][2], B0[2][2], B1[2][2];
    const GAS char* cA = (const GAS char*)g.A + (size_t)cur.pm * tstepA + (size_t)cur.pn * g.acs + (size_t)cur.kt0 * kstep; const GAS char* cB = (const GAS char*)g.Bt + (size_t)cur.pn * tstepB + (size_t)cur.kt0 * kstep;
    PG8_STAGE(PG8_SB(0, 0), cB, voffB); PG8_STAGE(PG8_SB(0, 1), cB + hstepB, voffB); PG8_STAGE(PG8_SA(0, 0), cA, voffA); PG8_STAGE(PG8_SA(0, 1), cA + hstepA, voffA);
    if (wr == 1) PG8_BAR;
    PG8_WAIT_V(2); PG8_BAR;
    PG8_STAGE(PG8_SB(1, 0), cB + kstep, voffB); PG8_STAGE(PG8_SA(1, 0), cA + kstep, voffA); PG8_STAGE(PG8_SB(1, 1), cB + hstepB + kstep, voffB);
    PG8_WAIT_V(6); PG8_BAR;
    for (;;) {
        const bool has_next = S.next(ui + 1, nxt);
        const GAS char* nA = has_next ? (const GAS char*)g.A + (size_t)nxt.pm * tstepA + (size_t)nxt.pn * g.acs + (size_t)nxt.kt0 * kstep : cA; const GAS char* nB = has_next ? (const GAS char*)g.Bt + (size_t)nxt.pn * tstepB + (size_t)nxt.kt0 * kstep : cB;
        const int nt = cur.nkt;
        for (int t = 0; t < nt; t += 2) {
            asm volatile("" : "+v"(voffA[0]), "+v"(voffA[1]), "+v"(voffB[0]), "+v"(voffB[1]));
            const bool last = (t == nt - 2);
            const GAS char* a1 = cA + (size_t)(t + 1) * kstep;
            const GAS char* a2 = last ? nA : cA + (size_t)(t + 2) * kstep; const GAS char* b2 = last ? nB : cB + (size_t)(t + 2) * kstep;
            const GAS char* a3 = a2 + kstep; const GAS char* b3 = b2 + kstep;
            PG8_LDB(B0, 0, 0); PG8_LDB(B1, 0, 1); PG8_SCHED; PG8_LDA(At, 0, 0); PG8_STAGE(PG8_SA(1, 1), a1 + hstepA, voffA);
            PG8_WAIT_V(8); PG8_WAIT_L(0); PG8_BAR; PG8_MMA(0, 0, At, B0); PG8_MMA(0, 1, At, B1); PG8_BAR; PG8_SCHED;
            PG8_LDA(At, 0, 1); PG8_STAGE(PG8_SB(0, 0), b2, voffB); PG8_STAGE(PG8_SB(0, 1), b2 + hstepB, voffB); PG8_STAGE(PG8_SA(0, 0), a2, voffA);
            PG8_WAIT_V(8); PG8_WAIT_L(0); PG8_BAR; PG8_MMA(1, 0, At, B0); PG8_MMA(1, 1, At, B1); PG8_BAR; PG8_SCHED;
            PG8_LDB(B0, 1, 0); PG8_LDB(B1, 1, 1); PG8_SCHED; PG8_LDA(At, 1, 0); PG8_STAGE(PG8_SA(0, 1), a2 + hstepA, voffA);
            PG8_WAIT_V(8); PG8_WAIT_L(0); PG8_BAR; PG8_MMA(0, 0, At, B0); PG8_MMA(0, 1, At, B1); PG8_BAR; PG8_SCHED;
            PG8_LDA(At, 1, 1); PG8_STAGE(PG8_SB(1, 0), b3, voffB); PG8_STAGE(PG8_SB(1, 1), b3 + hstepB, voffB); PG8_STAGE(PG8_SA(1, 0), a3, voffA);
            PG8_WAIT_V(8); PG8_WAIT_L(0); PG8_BAR; PG8_MMA(1, 0, At, B0); PG8_MMA(1, 1, At, B1); PG8_BAR; PG8_SCHED;
        }
        if (wr == 0) PG8_BAR;
        if (gate != nullptr && ui == 0) {
            if (wid == 0) {
                unsigned sp = 0u; while (xb_ld(gate) < need) { __builtin_amdgcn_s_sleep(2); if (++sp > XB_SPIN_CAP) break; }
                __builtin_amdgcn_fence(__ATOMIC_ACQUIRE, "agent"); asm volatile("s_waitcnt vmcnt(0)" ::: "memory");
            }
            asm volatile("" ::: "memory"); PG8_BAR; asm volatile("" ::: "memory");
        }
        { int fr2 = fr, fq2 = fq; asm volatile("" : "+v"(fr2), "+v"(fq2));
          E(acc, cur, wr, wc, fr2, fq2); }
        if (!has_next) break;
#pragma unroll
        for (int a = 0; a < 2; ++a)
#pragma unroll
            for (int b = 0; b < 2; ++b)
#pragma unroll
                for (int m = 0; m < 4; ++m)
#pragma unroll
                    for (int n = 0; n < 2; ++n) acc[a][b][m][n] = (f32x4){0.f, 0.f, 0.f, 0.f};
        cur = nxt; cA = nA; cB = nB; ++ui;
        if (wr == 1) PG8_BAR;
    }
    PG8_WAIT_V(0);
    PG8_BAR;
#undef PG8_SA
#undef PG8_SB
#undef PG8_STAGE
#undef PG8_LDA
#undef PG8_LDB
#undef PG8_MMA
#undef PG8_WAIT_V
#undef PG8_WAIT_L
#undef PG8_BAR
#undef PG8_SCHED
}

template <int IN  , bool OUT8> struct EpiUpT {
    void* ACT; const float* sumsq; float inq;
    __device__ __forceinline__ void operator()(const f32x4 (&acc)[2][2][4][2], const Unit& u, int wr, int wc, int fr, int fq) const {
        const int row0 = u.pm * BM + wr * 64 + fr, col0 = u.pn * 128 + wc * 32 + 8 * fq;
        float rs[2][4];
#pragma unroll
        for (int ai = 0; ai < 2; ++ai)
#pragma unroll
            for (int m = 0; m < 4; ++m) rs[ai][m] = sumsq[row0 + ai * HALF + m * 16];
#pragma unroll
        for (int ai = 0; ai < 2; ++ai)
#pragma unroll
            for (int m = 0; m < 4; ++m) {
                const int row = row0 + ai * HALF + m * 16;
                const float r = __builtin_amdgcn_rsqf(rs[ai][m] * (1.0f / DM) + EPS) * (IN == 2 ? inq : 1.0f);
                const float rg = r * -LOG2E, ru = r * ((OUT8 ? S8_ACT : 1.0f) * (-1.0f / LOG2E));
                float o[8];
#pragma unroll
                for (int n = 0; n < 2; ++n)
#pragma unroll
                    for (int j = 0; j < 4; j += 2) {
                        f32x2 gi, ui;
                        gi[0] = (IN == 2 ? (float)__float_as_int(acc[ai][0][m][n][j]) : acc[ai][0][m][n][j]); gi[1] = (IN == 2 ? (float)__float_as_int(acc[ai][0][m][n][j + 1]) : acc[ai][0][m][n][j + 1]);
                        ui[0] = (IN == 2 ? (float)__float_as_int(acc[ai][1][m][n][j]) : acc[ai][1][m][n][j]); ui[1] = (IN == 2 ? (float)__float_as_int(acc[ai][1][m][n][j + 1]) : acc[ai][1][m][n][j + 1]);
                        const f32x2 t = gi * rg, us = ui * ru, p = t * us;
                        f32x2 e; e[0] = fast_exp2(t[0]); e[1] = fast_exp2(t[1]);
                        const f32x2 d = e + 1.0f;
                        f32x2 rc; rc[0] = fast_rcp(d[0]); rc[1] = fast_rcp(d[1]);
                        const f32x2 o2 = p * rc;
                        o[n * 4 + j] = o2[0]; o[n * 4 + j + 1] = o2[1];
                    }
                if constexpr (OUT8) { u32x2 w; w.x = pk_fp8x4(o[0], o[1], o[2], o[3]); w.y = pk_fp8x4(o[4], o[5], o[6], o[7]);
                    *(u32x2*)((unsigned char*)ACT + (size_t)row * FF + col0) = w; }
                else { u32x4 w; w.x = cvt_pk_bf16(o[0], o[1]); w.y = cvt_pk_bf16(o[2], o[3]); w.z = cvt_pk_bf16(o[4], o[5]); w.w = cvt_pk_bf16(o[6], o[7]);
                    *(u32x4*)((bf16_t*)ACT + (size_t)row * FF + col0) = w; }
            }
    }
};
struct EpiRes {
    const float* base; float* out; bf16_t* XN; float* PART; float alpha_; float* SLAB; unsigned char* XN8 = nullptr; float sqx = 1.f;
    __device__ __forceinline__ void operator()(const f32x4 (&acc)[2][2][4][2], const Unit& u, int wr, int wc, int fr, int fq) const {
        const int col0 = u.pn * BM + wc * 32 + 8 * fq;
        const float alpha = alpha_;
        if (u.pm == 32) {
            if (wr == 0) {
                float* sl = SLAB + (size_t)(u.kt0 / u.nkt) * (MS * DM);
#pragma unroll
                for (int m = 0; m < 2; ++m)
#pragma unroll
                    for (int bj = 0; bj < 2; ++bj)
#pragma unroll
                        for (int n = 0; n < 2; ++n) *(f32x4*)(sl + (size_t)(m * 16 + fr) * DM + col0 + bj * HALF + n * 4) = acc[0][bj][m][n];
            }
            return;
        }
        const int row0 = u.pm * BM + wr * 64 + fr;
#pragma unroll
        for (int ai = 0; ai < 2; ++ai) {
            f32x4 bv[4][2][2];
#pragma unroll
            for (int m = 0; m < 4; ++m)
#pragma unroll
                for (int bj = 0; bj < 2; ++bj) { const float* bp = base + (size_t)(row0 + ai * HALF + m * 16) * DM + col0 + bj * HALF; bv[m][bj][0] = *(const f32x4*)bp; bv[m][bj][1] = *(const f32x4*)(bp + 4); }
#pragma unroll
            for (int m = 0; m < 4; ++m) {
                const int row = row0 + ai * HALF + m * 16; const size_t off = (size_t)row * DM + col0;
                float ss = 0.f;
#pragma unroll
                for (int bj = 0; bj < 2; ++bj) {
                    const f32x4 v0 = bv[m][bj][0] + acc[ai][bj][m][0] * alpha, v1 = bv[m][bj][1] + acc[ai][bj][m][1] * alpha;
                    *(f32x4*)(out + off + bj * HALF) = v0; *(f32x4*)(out + off + bj * HALF + 4) = v1;
                    if (XN8) { u32x2 w8; w8.x = pk_i8x4(v0[0] * sqx, v0[1] * sqx, v0[2] * sqx, v0[3] * sqx); w8.y = pk_i8x4(v1[0] * sqx, v1[1] * sqx, v1[2] * sqx, v1[3] * sqx);
                        *(u32x2*)(XN8 + off + bj * HALF) = w8; }
                    else { u32x4 w; w.x = cvt_pk_bf16(v0[0], v0[1]); w.y = cvt_pk_bf16(v0[2], v0[3]); w.z = cvt_pk_bf16(v1[0], v1[1]); w.w = cvt_pk_bf16(v1[2], v1[3]);
                        *(u32x4*)(XN + off + bj * HALF) = w; }
                    ss += (v0[0] * v0[0] + v0[1] * v0[1]) + (v0[2] * v0[2] + v0[3] * v0[3]) + (v1[0] * v1[0] + v1[1] * v1[1]) + (v1[2] * v1[2] + v1[3] * v1[3]);
                }
                ss = sum_x32(sum_x16(ss));
                if (fq == 0) PART[(size_t)row * 32 + u.pn * 4 + wc] = ss;
            }
            asm volatile("" ::: "memory");
        }
    }
};
struct EpiInEven {
    const float* sumsq; bf16_t *Q, *Kb, *V, *AU, *AV; float* dout; const float *qg, *kg; float* avsq; LAS float* red;
    __device__ __forceinline__ void operator()(const f32x4 (&acc)[2][2][4][2], const Unit& u, int wr, int wc, int fr, int fq) const {
        const int seg = u.pn >> 2, ct = (u.pn & 3) * BM;
        const int row0 = u.pm * BM + wr * 64 + fr, cw = wc * 32 + 8 * fq;
        float rs[2][4];
#pragma unroll
        for (int ai = 0; ai < 2; ++ai)
#pragma unroll
            for (int m = 0; m < 4; ++m) rs[ai][m] = __builtin_amdgcn_rsqf(sumsq[row0 + ai * HALF + m * 16] * (1.0f / DM) + EPS);
        if (seg < 2) {
#pragma unroll
            for (int ai = 0; ai < 2; ++ai)
#pragma unroll
                for (int m = 0; m < 4; ++m)
#pragma unroll
                    for (int bj = 0; bj < 2; ++bj) {
                        const f32x4 a = acc[ai][bj][m][0], b = acc[ai][bj][m][1];
                        float s = (a[0] * a[0] + a[1] * a[1]) + (a[2] * a[2] + a[3] * a[3]) + (b[0] * b[0] + b[1] * b[1]) + (b[2] * b[2] + b[3] * b[3]);
                        s = sum_x32(sum_x16(s));
                        if (fq == 0) red[((ai * HALF + wr * 64 + m * 16 + fr) * 2 + bj) * 4 + wc] = s;
                    }
            LDS_WAIT(); __builtin_amdgcn_s_barrier(); asm volatile("" ::: "memory");
            const float* gn = seg == 0 ? qg : kg;
            f32x4 g0 = *(const f32x4*)(gn + cw), g1 = *(const f32x4*)(gn + cw + 4);
            if (seg == 0) { g0 = g0 * QSCALE; g1 = g1 * QSCALE; }
            bf16_t* dst = seg == 0 ? Q : Kb;
#pragma unroll
            for (int ai = 0; ai < 2; ++ai)
#pragma unroll
                for (int m = 0; m < 4; ++m) {
                    const int row = row0 + ai * HALF + m * 16; const float r = rs[ai][m];
#pragma unroll
                    for (int bj = 0; bj < 2; ++bj) {
                        const f32x4 p = *(const LAS f32x4*)(red + ((ai * HALF + wr * 64 + m * 16 + fr) * 2 + bj) * 4);
                        const float ms = ((p[0] + p[1]) + (p[2] + p[3])) * r * r * (1.0f / HD);
                        const float sc = r * __builtin_amdgcn_rsqf(ms + EPS);
                        const f32x4 v0 = acc[ai][bj][m][0] * sc * g0, v1 = acc[ai][bj][m][1] * sc * g1;
                        const int col = ct + bj * HALF + cw;
                        u32x4 w; w.x = cvt_pk_bf16(v0[0], v0[1]); w.y = cvt_pk_bf16(v0[2], v0[3]); w.z = cvt_pk_bf16(v1[0], v1[1]); w.w = cvt_pk_bf16(v1[2], v1[3]);
                        *(u32x4*)(dst + (size_t)row * 1024 + col) = w;
                        if (seg == 1 && row < MP + MS) {
                            float* o = dout + (row < MP ? O_KP + (size_t)row * 1024 : O_KS + (size_t)(row - MP) * 1024) + col;
                            __builtin_nontemporal_store(v0, (f32x4*)o); __builtin_nontemporal_store(v1, (f32x4*)(o + 4));
                        }
                    }
                }
        } else if (seg == 2) {
#pragma unroll
            for (int ai = 0; ai < 2; ++ai)
#pragma unroll
                for (int m = 0; m < 4; ++m) {
                    const int row = row0 + ai * HALF + m * 16; const float r = rs[ai][m];
#pragma unroll
                    for (int bj = 0; bj < 2; ++bj) {
                        const f32x4 v0 = acc[ai][bj][m][0] * r, v1 = acc[ai][bj][m][1] * r;
                        const int col = ct + bj * HALF + cw;
                        u32x4 w; w.x = cvt_pk_bf16(v0[0], v0[1]); w.y = cvt_pk_bf16(v0[2], v0[3]); w.z = cvt_pk_bf16(v1[0], v1[1]); w.w = cvt_pk_bf16(v1[2], v1[3]);
                        *(u32x4*)(V + (size_t)row * 1024 + col) = w;
                        if (row < MP + MS) {
                            float* o = dout + (row < MP ? O_VP + (size_t)row * 1024 : O_VS + (size_t)(row - MP) * 1024) + col;
                            __builtin_nontemporal_store(v0, (f32x4*)o); __builtin_nontemporal_store(v1, (f32x4*)(o + 4));
                        }
                    }
                }
        } else {
            bf16_t* dst = seg == 3 ? AU : AV;
#pragma unroll
            for (int ai = 0; ai < 2; ++ai)
#pragma unroll
                for (int m = 0; m < 4; ++m) {
                    const int row = row0 + ai * HALF + m * 16; const float r = rs[ai][m];
                    float ss = 0.f;
#pragma unroll
                    for (int bj = 0; bj < 2; ++bj) {
                        float o[8];
#pragma unroll
                        for (int n = 0; n < 2; ++n)
#pragma unroll
                            for (int j = 0; j < 4; ++j) { o[n * 4 + j] = gelu_tanh(acc[ai][bj][m][n][j] * r); ss += o[n * 4 + j] * o[n * 4 + j]; }
                        const int col = ct + bj * HALF + cw;
                        u32x4 w; w.x = cvt_pk_bf16(o[0], o[1]); w.y = cvt_pk_bf16(o[2], o[3]); w.z = cvt_pk_bf16(o[4], o[5]); w.w = cvt_pk_bf16(o[6], o[7]);
                        *(u32x4*)(dst + (size_t)row * 1024 + col) = w;
                    }
                    if (seg == 4) { ss = sum_x32(sum_x16(ss)); if (fq == 0) atomicAdd(avsq + row, ss); }
                }
        }
    }
};
struct EpiInOdd {
    const float* sumsq; bf16_t *XC, *GB, *G; float* dout; float* SP;
    __device__ __forceinline__ void operator()(const f32x4 (&acc)[2][2][4][2], const Unit& u, int wr, int wc, int fr, int fq) const {
        const int row0 = u.pm * BM + wr * 64 + fr, cw = wc * 32 + 8 * fq;
        if (u.pm == 32) {
            if (wr == 0) {
                float* sl = SP + (size_t)(u.kt0 / u.nkt) * (MS * 4096);
#pragma unroll
                for (int m = 0; m < 2; ++m)
#pragma unroll
                    for (int bj = 0; bj < 2; ++bj)
#pragma unroll
                        for (int n = 0; n < 2; ++n) *(f32x4*)(sl + (size_t)(m * 16 + fr) * 4096 + u.pn * BM + bj * HALF + cw + n * 4) = acc[0][bj][m][n];
            }
            return;
        }
        if (u.pn < 8) {
            const int ct = (u.pn & 3) * BM; bf16_t* dst = u.pn < 4 ? XC : GB;
#pragma unroll
            for (int ai = 0; ai < 2; ++ai)
#pragma unroll
                for (int m = 0; m < 4; ++m) {
                    const int row = row0 + ai * HALF + m * 16; const float r = __builtin_amdgcn_rsqf(sumsq[row] * (1.0f / DM) + EPS);
#pragma unroll
                    for (int bj = 0; bj < 2; ++bj) {
                        const f32x4 v0 = acc[ai][bj][m][0] * r, v1 = acc[ai][bj][m][1] * r;
                        const int col = ct + bj * HALF + cw;
                        u32x4 w; w.x = cvt_pk_bf16(v0[0], v0[1]); w.y = cvt_pk_bf16(v0[2], v0[3]); w.z = cvt_pk_bf16(v1[0], v1[1]); w.w = cvt_pk_bf16(v1[2], v1[3]);
                        *(u32x4*)(dst + (size_t)row * 1024 + col) = w;
                        if (u.pn < 4) {
                            float* o = nullptr;
                            if (row < MP) { const int t = row & (SEQ - 1); if (t >= SEQ - 15) o = dout + O_PP + ((size_t)(row >> 11) * 15 + (t - (SEQ - 15))) * 1024 + col; }
                            else if (row < MP + MS) { const int sr = row - MP; o = dout + O_PS + ((size_t)(sr >> 2) * 15 + 11 + (sr & 3)) * 1024 + col; }
                            if (o) { *(f32x4*)o = v0; *(f32x4*)(o + 4) = v1; }
                        }
                    }
                }
        } else {
            const int col = (u.pn - 8) * 128 + cw;
#pragma unroll
            for (int ai = 0; ai < 2; ++ai)
#pragma unroll
                for (int m = 0; m < 4; ++m) {
                    const int row = row0 + ai * HALF + m * 16; const float r = __builtin_amdgcn_rsqf(sumsq[row] * (1.0f / DM) + EPS); const float r2 = r * r;
                    const f32x4 v0 = acc[ai][0][m][0] * acc[ai][1][m][0] * r2, v1 = acc[ai][0][m][1] * acc[ai][1][m][1] * r2;
                    u32x4 w; w.x = cvt_pk_bf16(v0[0], v0[1]); w.y = cvt_pk_bf16(v0[2], v0[3]); w.z = cvt_pk_bf16(v1[0], v1[1]); w.w = cvt_pk_bf16(v1[2], v1[3]);
                    *(u32x4*)(G + (size_t)row * 1024 + col) = w;
                    float* o = nullptr;
                    if (row < MP) { const int t = row & (SEQ - 1); if (t >= SEQ - 2) o = dout + O_CP + ((size_t)(row >> 11) * 2 + (t - (SEQ - 2))) * 1024 + col; }
                    else if (row < MP + MS) { const int sr = row - MP; if ((sr & 3) >= 2) o = dout + O_CS + ((size_t)(sr >> 2) * 2 + ((sr & 3) - 2)) * 1024 + col; }
                    if (o) { *(f32x4*)o = v0; *(f32x4*)(o + 4) = v1; }
                }
        }
    }
};
struct EpiPool {
    bf16_t* MIX; const float* cscale;
    __device__ __forceinline__ void operator()(const f32x4 (&acc)[2][2][4][2], const Unit& u, int wr, int wc, int fr, int fq) const {
        const int row0 = u.pm * BM + wr * 64 + fr, col0 = u.pn * BM + wc * 32 + 8 * fq;
#pragma unroll
        for (int bj = 0; bj < 2; ++bj) {
            const f32x4 s0 = *(const f32x4*)(cscale + col0 + bj * HALF), s1 = *(const f32x4*)(cscale + col0 + bj * HALF + 4);
#pragma unroll
            for (int ai = 0; ai < 2; ++ai)
#pragma unroll
                for (int m = 0; m < 4; ++m) {
                    const int row = row0 + ai * HALF + m * 16;
                    const f32x4 v0 = acc[ai][bj][m][0] * s0, v1 = acc[ai][bj][m][1] * s1;
                    u32x4 w; w.x = cvt_pk_bf16(v0[0], v0[1]); w.y = cvt_pk_bf16(v0[2], v0[3]); w.z = cvt_pk_bf16(v1[0], v1[1]); w.w = cvt_pk_bf16(v1[2], v1[3]);
                    *(u32x4*)(MIX + (size_t)row * DM + col0 + bj * HALF) = w;
                }
        }
    }
};
}

namespace sba {
constexpr int SHM_K = 64 * 128 * 2, SHM_V = SHM_K;
#define KSWZ(row, colB) ((row) * 256 + ((colB) ^ (((row) & 7) << 4)))
#define SBAR() __builtin_amdgcn_sched_barrier(0)
__device__ __forceinline__ int crow(int r, int hi) { return (r & 3) + 8 * (r >> 2) + 4 * hi; }
__device__ __forceinline__ int v_st(int k, int c) { const int kk = (k & ~0xC) | ((k & 4) << 1) | ((k & 8) >> 1); return ((kk >> 3) * 4 + (c >> 5)) * 512 + ((kk & 7) * 32 + (c & 31)) * 2; }
__device__ __forceinline__ int v_rd_base(int lane) { return ((lane & 3) << 3) | (((lane >> 2) & 3) << 6) | (((lane >> 4) & 1) << 5) | (((lane >> 5) & 1) << 8); }
constexpr int v_rd_off(int d0, int ks, int half) { return d0 * 512 + ks * 4096 + half * 2048; }
template <int OFF> __device__ __forceinline__ s16x4 tr_read(int vb) {
    s16x4 r; asm volatile("ds_read_b64_tr_b16 %0, %1 offset:%2" : "=&v"(r) : "v"(vb), "i"(OFF) : "memory"); return r;
}
template <int D0> __device__ __forceinline__ void pv_one(f32x16& od, int vb, bf16x8 pa0, bf16x8 pa1, bf16x8 pa2, bf16x8 pa3) {
    const s16x4 l0 = tr_read<v_rd_off(D0, 0, 0)>(vb), h0 = tr_read<v_rd_off(D0, 0, 1)>(vb), l1 = tr_read<v_rd_off(D0, 1, 0)>(vb), h1 = tr_read<v_rd_off(D0, 1, 1)>(vb);
    const s16x4 l2 = tr_read<v_rd_off(D0, 2, 0)>(vb), h2 = tr_read<v_rd_off(D0, 2, 1)>(vb), l3 = tr_read<v_rd_off(D0, 3, 0)>(vb), h3 = tr_read<v_rd_off(D0, 3, 1)>(vb);
    asm volatile("s_waitcnt lgkmcnt(0)" ::: "memory"); SBAR();
#define PK(L, H) (bf16x8){L[0], L[1], L[2], L[3], H[0], H[1], H[2], H[3]}
    od = __builtin_amdgcn_mfma_f32_32x32x16_bf16(pa0, PK(l0, h0), od, 0, 0, 0);
    od = __builtin_amdgcn_mfma_f32_32x32x16_bf16(pa1, PK(l1, h1), od, 0, 0, 0);
    od = __builtin_amdgcn_mfma_f32_32x32x16_bf16(pa2, PK(l2, h2), od, 0, 0, 0);
    od = __builtin_amdgcn_mfma_f32_32x32x16_bf16(pa3, PK(l3, h3), od, 0, 0, 0);
#undef PK
}
__device__ __forceinline__ void qkt(f32x16& p0, f32x16& p1, const char* Ks, const bf16x8 (&qr)[8], int r32, int hi) {
    p0 = f32x16{}; p1 = f32x16{};
#pragma unroll
    for (int d0 = 0; d0 < 8; ++d0) { const int cb = (d0 * 16 + hi * 8) * 2;
        const bf16x8 b0 = *reinterpret_cast<const bf16x8*>(Ks + KSWZ(r32, cb));
        const bf16x8 b1 = *reinterpret_cast<const bf16x8*>(Ks + KSWZ(32 + r32, cb));
        p0 = __builtin_amdgcn_mfma_f32_32x32x16_bf16(b0, qr[d0], p0, 0, 0, 0);
        p1 = __builtin_amdgcn_mfma_f32_32x32x16_bf16(b1, qr[d0], p1, 0, 0, 0); }
}
__device__ __forceinline__ void sb_tile(f32x16& p0, f32x16& p1, float& C, float bias2, bool masked, int t, int k0, int hi) {
#pragma unroll
    for (int r = 0; r < 16; ++r) {
        float e0 = fast_exp2(p0[r] + bias2), e1 = fast_exp2(p1[r] + bias2);
        if (masked) { const int key = k0 + crow(r, hi); e0 = key < t ? e0 : 0.f; e1 = (key + 32) < t ? e1 : 0.f; }
        p0[r] = e0; p1[r] = e1;
    }
    float a[8], SA[9], PB[9];
#pragma unroll
    for (int j = 0; j < 4; ++j) {
        a[j] = ((1.f + p0[4 * j]) * (1.f + p0[4 * j + 1])) * ((1.f + p0[4 * j + 2]) * (1.f + p0[4 * j + 3]));
        a[4 + j] = ((1.f + p1[4 * j]) * (1.f + p1[4 * j + 1])) * ((1.f + p1[4 * j + 2]) * (1.f + p1[4 * j + 3]));
    }
    SA[8] = 1.f; PB[8] = 1.f;
#pragma unroll
    for (int j = 7; j >= 0; --j) SA[j] = SA[j + 1] * a[j];
#pragma unroll
    for (int j = 0; j < 8; ++j) PB[j] = xchg32(SA[j], hi);
#pragma unroll
    for (int j = 0; j < 8; ++j) {
        const float suf = C * SA[j + 1] * (hi ? PB[j + 1] : PB[j]);
        float inv = fast_rcp(suf * a[j]);
        if (j < 4) {
            const float e0 = p0[4 * j], e1 = p0[4 * j + 1], e2 = p0[4 * j + 2], e3 = p0[4 * j + 3];
            p0[4 * j] = e0 * inv; inv *= (1.f + e0); p0[4 * j + 1] = e1 * inv; inv *= (1.f + e1); p0[4 * j + 2] = e2 * inv; inv *= (1.f + e2); p0[4 * j + 3] = e3 * inv;
        } else {
            const int q = 4 * (j - 4);
            const float e0 = p1[q], e1 = p1[q + 1], e2 = p1[q + 2], e3 = p1[q + 3];
            p1[q] = e0 * inv; inv *= (1.f + e0); p1[q + 1] = e1 * inv; inv *= (1.f + e1); p1[q + 2] = e2 * inv; inv *= (1.f + e2); p1[q + 3] = e3 * inv;
        }
    }
    C = C * SA[0] * PB[0];
}
__device__ __forceinline__ void pack_p(const f32x16& p0, const f32x16& p1, bf16x8& pa0, bf16x8& pa1, bf16x8& pa2, bf16x8& pa3) {
#define PK4(P, BASE, OUT) do { unsigned a0 = cvt_pk_bf16(P[BASE + 0], P[BASE + 1]), a1 = cvt_pk_bf16(P[BASE + 2], P[BASE + 3]);   \
    unsigned b0 = cvt_pk_bf16(P[BASE + 4], P[BASE + 5]), b1 = cvt_pk_bf16(P[BASE + 6], P[BASE + 7]);                              \
    auto r0 = __builtin_amdgcn_permlane32_swap(a0, b0, false, false); auto r1 = __builtin_amdgcn_permlane32_swap(a1, b1, false, false); \
    u32x4 w = {r0[0], r1[0], r0[1], r1[1]}; OUT = *reinterpret_cast<bf16x8*>(&w); } while (0)
    PK4(p0, 0, pa0); PK4(p0, 8, pa1); PK4(p1, 0, pa2); PK4(p1, 8, pa3);
#undef PK4
}
__device__ __forceinline__ void attn_unit(const bf16_t* __restrict__ Qb, const bf16_t* __restrict__ Kh, const bf16_t* __restrict__ Vh, bf16_t* __restrict__ Ob, int q0, float bias2, char* lds, int wave0) {
    const int tid = fresh_tid(wave0);
    const int wid = tid >> 6, lane = tid & 63, r32 = lane & 31, hi = lane >> 5;
    char* V_lds = lds; char* K_lds = lds + 2 * SHM_V;
    f32x16 o[4] = {}; bf16x8 qr[8];
    const bf16_t* Qw = Qb + (size_t)(wid * 32 + r32) * 1024 + hi * 8;
#pragma unroll
    for (int d0 = 0; d0 < 8; ++d0) qr[d0] = *reinterpret_cast<const bf16x8*>(Qw + d0 * 16);
    const int sr = tid >> 4, sc = (tid & 15) * 8, vst0 = v_st(sr, sc), vst1 = v_st(32 + sr, sc);
    const int vb0 = (int)(uintptr_t)V_lds + v_rd_base(lane);
    const int NT = (q0 + 256) >> 6, kmax = q0 + 192, tw = q0 + wid * 32, t = tw + r32;
    float C = 1.f;
    bf16x8 vs0, vs1, ks0, ks1;
#define SLOAD(k0) do { vs0 = *reinterpret_cast<const bf16x8*>(Vh + (size_t)((k0) + sr) * 1024 + sc); vs1 = *reinterpret_cast<const bf16x8*>(Vh + (size_t)((k0) + 32 + sr) * 1024 + sc); \
    ks0 = *reinterpret_cast<const bf16x8*>(Kh + (size_t)((k0) + sr) * 1024 + sc); ks1 = *reinterpret_cast<const bf16x8*>(Kh + (size_t)((k0) + 32 + sr) * 1024 + sc); } while (0)
#define SWRITE(b) do { *(bf16x8*)(V_lds + (b) * SHM_V + vst0) = vs0; *(bf16x8*)(V_lds + (b) * SHM_V + vst1) = vs1; const int kc = sc * 2; \
    *(bf16x8*)(K_lds + (b) * SHM_K + KSWZ(sr, kc)) = ks0; *(bf16x8*)(K_lds + (b) * SHM_K + KSWZ(32 + sr, kc)) = ks1; } while (0)
    __syncthreads();
    SLOAD(kmax); SWRITE(0);
    for (int j = 0; j < NT; ++j) {
        __syncthreads();
        const int k0 = kmax - 64 * j, b = j & 1;
        if (j + 1 < NT) SLOAD(k0 - 64);
        if (k0 <= tw + 30) {
            f32x16 p0, p1; bf16x8 pa0, pa1, pa2, pa3;
            qkt(p0, p1, K_lds + b * SHM_K, qr, r32, hi);
            sb_tile(p0, p1, C, bias2, k0 + 63 >= tw, t, k0, hi);
            pack_p(p0, p1, pa0, pa1, pa2, pa3);
            const int vb = vb0 + b * SHM_V;
            pv_one<0>(o[0], vb, pa0, pa1, pa2, pa3); pv_one<1>(o[1], vb, pa0, pa1, pa2, pa3); pv_one<2>(o[2], vb, pa0, pa1, pa2, pa3); pv_one<3>(o[3], vb, pa0, pa1, pa2, pa3);
        }
        if (j + 1 < NT) SWRITE(b ^ 1);
    }
#undef SLOAD
#undef SWRITE
    bf16_t* Ow = Ob + (size_t)(wid * 32) * DM;
#pragma unroll
    for (int r = 0; r < 16; ++r) { const int orow = crow(r, hi);
#pragma unroll
        for (int d0 = 0; d0 < 4; ++d0) Ow[(size_t)orow * DM + d0 * 32 + r32] = (bf16_t)(cvt_pk_bf16(o[d0][r], 0.f) & 0xffffu); }
}
__device__ __forceinline__ void gate_unit(const bf16_t* __restrict__ AVb, const bf16_t* __restrict__ AUb, const bf16_t* __restrict__ AWS, const float* __restrict__ avsq,
                                          const float* __restrict__ avg, const float* __restrict__ abs_, bf16_t* __restrict__ MIX, int R0, int g, char* lds, int wave0) {
    const int tid = fresh_tid(wave0);
    const int wid = tid >> 6, lane = tid & 63, r32 = lane & 31, hi = lane >> 5, wp = wid & 3, wd = wid >> 2;
    char* V_lds = lds;
    const int sr = tid >> 4, sc = (tid & 15) * 8;
    __syncthreads();
#pragma unroll
    for (int q4 = 0; q4 < 4; ++q4) {
        const int row = q4 * 32 + sr;
        const u32x4 x = *reinterpret_cast<const u32x4*>(AVb + (size_t)(R0 + row) * 1024 + g * 128 + sc);
        const float rs = __builtin_amdgcn_rsqf(avsq[R0 + row] * (1.0f / AW) + EPS);
        u32x4 w; w.x = cvt_pk_bf16(bf_lo(x.x) * rs, bf_hi(x.x) * rs); w.y = cvt_pk_bf16(bf_lo(x.y) * rs, bf_hi(x.y) * rs);
        w.z = cvt_pk_bf16(bf_lo(x.z) * rs, bf_hi(x.z) * rs); w.w = cvt_pk_bf16(bf_lo(x.w) * rs, bf_hi(x.w) * rs);
        *(u32x4*)(V_lds + (row >> 6) * SHM_V + v_st(row & 63, sc)) = w;
    }
    __syncthreads();
    f32x16 o0 = {}, o1 = {};
    const int vb0 = (int)(uintptr_t)V_lds + v_rd_base(lane);
    const bf16_t* Wrow = AWS + (size_t)(g * 128 + wp * 32 + r32) * 128 + hi * 8;
#pragma unroll
    for (int tile = 0; tile < 2; ++tile) {
        if (tile == 1 && wp < 2) break;
        const bf16x8 pa0 = *reinterpret_cast<const bf16x8*>(Wrow + tile * 64), pa1 = *reinterpret_cast<const bf16x8*>(Wrow + tile * 64 + 16),
                     pa2 = *reinterpret_cast<const bf16x8*>(Wrow + tile * 64 + 32), pa3 = *reinterpret_cast<const bf16x8*>(Wrow + tile * 64 + 48);
        const int vb = vb0 + tile * SHM_V;
        if (wd == 0) { pv_one<0>(o0, vb, pa0, pa1, pa2, pa3); pv_one<1>(o1, vb, pa0, pa1, pa2, pa3); }
        else         { pv_one<2>(o0, vb, pa0, pa1, pa2, pa3); pv_one<3>(o1, vb, pa0, pa1, pa2, pa3); }
    }
#pragma unroll
    for (int r = 0; r < 16; ++r) {
        const int p = wp * 32 + crow(r, hi); const float bsv = abs_[g * 128 + p];
#pragma unroll
        for (int dd = 0; dd < 2; ++dd) {
            const int col = g * 128 + (wd * 2 + dd) * 32 + r32;
            const float acc = dd == 0 ? o0[r] : o1[r];
            const float mixv = acc * avg[col] + bsv;
            const float au = __uint_as_float((unsigned)AUb[(size_t)(R0 + p) * 1024 + col] << 16);
            MIX[(size_t)(R0 + p) * DM + col] = (bf16_t)(cvt_pk_bf16(au * mixv, 0.f) & 0xffffu);
        }
    }
}
}

constexpr int PTAB_OFF = MISC_OFF + 256;
__device__ __forceinline__ unsigned char* opaque_ptr(unsigned char* p) { asm volatile("" : "+s"(p)); return p; }
__device__ __forceinline__ const void* lds_ptr(volatile LAS unsigned* tab, int i) {
    const unsigned lo = __builtin_amdgcn_readfirstlane(tab[2 * i]), hi = __builtin_amdgcn_readfirstlane(tab[2 * i + 1]);
    return (const void*)(((unsigned long long)hi << 32) | lo);
}
struct Args { const void* in[24]; float* out; unsigned char* ws; };

__device__ __forceinline__ void ld8(const bf16_t* p, float (&o)[8]) { const u32x4 x = *(const u32x4*)p; o[0] = bf_lo(x.x); o[1] = bf_hi(x.x); o[2] = bf_lo(x.y); o[3] = bf_hi(x.y); o[4] = bf_lo(x.z); o[5] = bf_hi(x.z); o[6] = bf_lo(x.w); o[7] = bf_hi(x.w); }
__device__ __forceinline__ void sp_sum8(const float* __restrict__ SP, int r, int col, float (&o)[8]) {
    f32x4 a = {0.f, 0.f, 0.f, 0.f}, b = {0.f, 0.f, 0.f, 0.f};
#pragma unroll
    for (int s = 0; s < 8; ++s) { const float* p = SP + ((size_t)s * MS + r) * 4096 + col; a += *(const f32x4*)p; b += *(const f32x4*)(p + 4); }
    o[0] = a[0]; o[1] = a[1]; o[2] = a[2]; o[3] = a[3]; o[4] = b[0]; o[5] = b[1]; o[6] = b[2]; o[7] = b[3];
}
__device__ __forceinline__ float wave_sum(float v) {
    v = sum_x32(sum_x16(sum_row16(v)));
    return v;
}
__device__ __forceinline__ void tr_item(const float* __restrict__ W, int K, int N, const float* __restrict__ gain, bf16_t* __restrict__ WT, int kind, LAS float* scr, int item, int lane) {
    const int nblk = N / 32, kb = item / nblk, nb = item % nblk, k0 = 64 * kb, n0 = 32 * nb;
    int drow0 = n0;
    if (kind == 1) drow0 = 256 * (n0 >> 7) + (n0 & 127);
    else if (kind == 2) drow0 = 256 * (n0 >> 7) + 128 + (n0 & 127);
    else if (kind == 3) { if (n0 >= 3072) { const int j = n0 - 3072; drow0 = 2048 + 256 * (j >> 7) + 128 + (j & 127); } else if (n0 >= 2048) { const int j = n0 - 2048; drow0 = 2048 + 256 * (j >> 7) + (j & 127); } }
    {
        const int kr = lane >> 3, nc = (lane & 7) * 4;
        f32x4 v[8];
#pragma unroll
        for (int i = 0; i < 8; ++i) v[i] = __builtin_nontemporal_load((const f32x4*)(W + (size_t)(k0 + 8 * i + kr) * N + n0 + nc));
#pragma unroll
        for (int i = 0; i < 8; ++i) { const int kk = 8 * i + kr; f32x4 x = v[i]; if (gain) x = x * gain[k0 + kk];
            scr[kk * 33 + nc] = x[0]; scr[kk * 33 + nc + 1] = x[1]; scr[kk * 33 + nc + 2] = x[2]; scr[kk * 33 + nc + 3] = x[3]; }
    }
    LDS_WAIT(); asm volatile("" ::: "memory");
    const int c = lane & 7;
#pragma unroll
    for (int j = 0; j < 4; ++j) { const int n = (lane >> 3) + 8 * j; const LAS float* s = scr + (8 * c) * 33 + n;
        u32x4 o; o.x = cvt_pk_bf16(s[0 * 33], s[1 * 33]); o.y = cvt_pk_bf16(s[2 * 33], s[3 * 33]); o.z = cvt_pk_bf16(s[4 * 33], s[5 * 33]); o.w = cvt_pk_bf16(s[6 * 33], s[7 * 33]);
        *(u32x4*)(WT + (size_t)(drow0 + n) * K + k0 + 8 * c) = o; }
    LDS_WAIT(); asm volatile("" ::: "memory");
}

__device__ __forceinline__ void tr_item8(const float* __restrict__ W, int K, int N, const float* __restrict__ gain, unsigned char* __restrict__ WT8, int kind, LAS float* scr, int item, int lane, float scale, bool i8) {
    const int nblk = N / 32, kb = item / nblk, nb = item % nblk, k0 = 64 * kb, n0 = 32 * nb;
    int drow0 = n0;
    if (kind == 1) drow0 = 256 * (n0 >> 7) + (n0 & 127);
    else if (kind == 2) drow0 = 256 * (n0 >> 7) + 128 + (n0 & 127);
    {
        const int kr = lane >> 3, nc = (lane & 7) * 4;
        f32x4 v[8];
#pragma unroll
        for (int i = 0; i < 8; ++i) v[i] = __builtin_nontemporal_load((const f32x4*)(W + (size_t)(k0 + 8 * i + kr) * N + n0 + nc));
#pragma unroll
        for (int i = 0; i < 8; ++i) { const int kk = 8 * i + kr; const f32x4 x = v[i] * (gain ? gain[k0 + kk] * scale : scale);
            scr[kk * 33 + nc] = x[0]; scr[kk * 33 + nc + 1] = x[1]; scr[kk * 33 + nc + 2] = x[2]; scr[kk * 33 + nc + 3] = x[3]; }
    }
    LDS_WAIT(); asm volatile("" ::: "memory");
    const int c = lane & 7;
#pragma unroll
    for (int j = 0; j < 4; ++j) { const int n = (lane >> 3) + 8 * j; const LAS float* s = scr + (8 * c) * 33 + n;
        u32x2 o;
        if (i8) { o.x = pk_i8x4(s[0 * 33], s[1 * 33], s[2 * 33], s[3 * 33]); o.y = pk_i8x4(s[4 * 33], s[5 * 33], s[6 * 33], s[7 * 33]); }
        else    { o.x = pk_fp8x4(s[0 * 33], s[1 * 33], s[2 * 33], s[3 * 33]); o.y = pk_fp8x4(s[4 * 33], s[5 * 33], s[6 * 33], s[7 * 33]); }
        *(u32x2*)(WT8 + (size_t)(drow0 + n) * K + k0 + 8 * c) = o; }
    LDS_WAIT(); asm volatile("" ::: "memory");
}
__device__ __forceinline__ void unpack8(const u32x4& x, float (&o)[8]) { o[0] = bf_lo(x.x); o[1] = bf_hi(x.x); o[2] = bf_lo(x.y); o[3] = bf_hi(x.y); o[4] = bf_lo(x.z); o[5] = bf_hi(x.z); o[6] = bf_lo(x.w); o[7] = bf_hi(x.w); }
template <int WIN> __device__ __forceinline__ void pool_run(const bf16_t* __restrict__ XC, bf16_t* __restrict__ PO_, int R0, int t0, int c) {
    u32x4 x[15 + WIN];
#pragma unroll
    for (int i = 0; i < 15 + WIN; ++i) { const int dt = i - (WIN - 1); const bool ok = t0 + dt >= 0;
        x[i] = *(const u32x4*)(XC + (size_t)(R0 + (ok ? dt : 0)) * 1024 + c); if (!ok) x[i] = (u32x4){0u, 0u, 0u, 0u}; }
    float S[8] = {0.f, 0.f, 0.f, 0.f, 0.f, 0.f, 0.f, 0.f};
#pragma unroll
    for (int i = 0; i < WIN - 1; ++i) { float v[8]; unpack8(x[i], v);
#pragma unroll
        for (int j = 0; j < 8; ++j) S[j] += v[j]; }
#pragma unroll
    for (int j = 0; j < 16; ++j) {
        float v[8]; unpack8(x[j + WIN - 1], v);
#pragma unroll
        for (int e = 0; e < 8; ++e) S[e] += v[e];
        const int n = t0 + j + 1 < WIN ? t0 + j + 1 : WIN; const float ic = 1.0f / (float)n;
        u32x4 w; w.x = cvt_pk_bf16(S[0] * ic - v[0], S[1] * ic - v[1]); w.y = cvt_pk_bf16(S[2] * ic - v[2], S[3] * ic - v[3]);
        w.z = cvt_pk_bf16(S[4] * ic - v[4], S[5] * ic - v[5]); w.w = cvt_pk_bf16(S[6] * ic - v[6], S[7] * ic - v[7]);
        *(u32x4*)(PO_ + (size_t)(R0 + j) * 1024 + c) = w;
        float u[8]; unpack8(x[j], u);
#pragma unroll
        for (int e = 0; e < 8; ++e) S[e] -= u[e];
    }
}
__device__ __forceinline__ void conv_run8(const bf16_t* __restrict__ GBp, const bf16_t* __restrict__ Gp, const float* __restrict__ cwp, bf16_t* __restrict__ MIX, int R0, int t0, int c) {
    u32x4 g[10], gb[8];
#pragma unroll
    for (int i = 0; i < 10; ++i) { const int dt = i - 2; const bool ok = t0 + dt >= 0; g[i] = *(const u32x4*)(Gp + (size_t)(R0 + (ok ? dt : 0)) * 1024 + c); if (!ok) g[i] = (u32x4){0u, 0u, 0u, 0u}; }
#pragma unroll
    for (int i = 0; i < 8; ++i) gb[i] = *(const u32x4*)(GBp + (size_t)(R0 + i) * 1024 + c);
    float cw[3][8];
#pragma unroll
    for (int k = 0; k < 3; ++k) { const f32x4 a = *(const f32x4*)(cwp + k * 1024 + c), b2 = *(const f32x4*)(cwp + k * 1024 + c + 4);
        cw[k][0] = a[0]; cw[k][1] = a[1]; cw[k][2] = a[2]; cw[k][3] = a[3]; cw[k][4] = b2[0]; cw[k][5] = b2[1]; cw[k][6] = b2[2]; cw[k][7] = b2[3]; }
#pragma unroll
    for (int j = 0; j < 8; ++j) {
        float a0[8], a1[8], a2[8], b[8], o[8]; unpack8(g[j], a0); unpack8(g[j + 1], a1); unpack8(g[j + 2], a2); unpack8(gb[j], b);
#pragma unroll
        for (int e = 0; e < 8; ++e) o[e] = b[e] * (a0[e] * cw[0][e] + a1[e] * cw[1][e] + a2[e] * cw[2][e]);
        u32x4 w; w.x = cvt_pk_bf16(o[0], o[1]); w.y = cvt_pk_bf16(o[2], o[3]); w.z = cvt_pk_bf16(o[4], o[5]); w.w = cvt_pk_bf16(o[6], o[7]);
        *(u32x4*)(MIX + (size_t)(R0 + j) * DM + 1024 + c) = w;
    }
}
__device__ __forceinline__ void residual_fixup(const float* __restrict__ PART, const float* __restrict__ SLAB, int mode, const float* __restrict__ Y, float* __restrict__ out, bf16_t* __restrict__ XN,
                                               float* __restrict__ sumsq, int gw, int NGW, int lane, unsigned char* __restrict__ XN8 = nullptr, float sqx = 1.f) {
    const int S = mode == 0 ? 22 : (mode == 1 ? 11 : 8); const float alpha = mode == 0 ? 0.5f : (mode == 1 ? 0.5f / (S8_ACT * S8_W) : 1.0f);
    for (int it = gw; it < MS * 8; it += NGW) {
        const int r = it >> 3, c = (it & 7) * 256 + 4 * lane; const size_t ro = (size_t)(MP + r) * DM + c;
        f32x4 a = {0.f, 0.f, 0.f, 0.f};
        {
            f32x4 sv[22];
#pragma unroll
            for (int s = 0; s < 22; ++s) sv[s] = *(const f32x4*)(SLAB + ((size_t)(s < S ? s : 0) * MS + r) * DM + c);
#pragma unroll
            for (int s = 0; s < 22; ++s) a += sv[s] * (s < S ? 1.f : 0.f);
        }
        const f32x4 v = *(const f32x4*)(Y + ro) + a * alpha;
        *(f32x4*)(out + ro) = v;
        if (XN8) *(unsigned*)(XN8 + ro) = pk_i8x4(v[0] * sqx, v[1] * sqx, v[2] * sqx, v[3] * sqx);
        else { u32x2 w; w.x = cvt_pk_bf16(v[0], v[1]); w.y = cvt_pk_bf16(v[2], v[3]); *(u32x2*)(XN + ro) = w; }
        const float ss = wave_sum((v[0] * v[0] + v[1] * v[1]) + (v[2] * v[2] + v[3] * v[3]));
        if (lane == 0) atomicAdd(sumsq + MP + r, ss);
    }
}

__device__ __forceinline__ void fixup_tasks(const float* __restrict__ PART, const float* __restrict__ SLAB, int mode, const float* __restrict__ Y, float* __restrict__ out, bf16_t* __restrict__ XN,
                                            float* __restrict__ sumsq, int w, int NW, int lane, unsigned char* __restrict__ XN8 = nullptr, float sqx = 1.f) {
    const int S = mode == 0 ? 22 : (mode == 1 ? 11 : 8); const float alpha = mode == 0 ? 0.5f : (mode == 1 ? 0.5f / (S8_ACT * S8_W) : 1.0f);
    for (int b = w * 4; b < MP / 8; b += NW * 4) {
        f32x4 p[4];
#pragma unroll
        for (int j = 0; j < 4; ++j) p[j] = *(const f32x4*)(PART + ((size_t)(b + j) * 8 + (lane >> 3)) * 32 + (lane & 7) * 4);
#pragma unroll
        for (int j = 0; j < 4; ++j) {
            float v = (p[j][0] + p[j][1]) + (p[j][2] + p[j][3]);
            v += dppf<0xB1>(v); v += dppf<0x4E>(v); v += dppf<0x141>(v);
            if ((lane & 7) == 0) sumsq[(b + j) * 8 + (lane >> 3)] = v;
        }
    }
    for (int it = w; it < MS * 8; it += NW) {
        const int r = it >> 3, c = (it & 7) * 256 + 4 * lane; const size_t ro = (size_t)(MP + r) * DM + c;
        f32x4 a = {0.f, 0.f, 0.f, 0.f};
        {
            f32x4 sv[22];
#pragma unroll
            for (int s = 0; s < 22; ++s) sv[s] = *(const f32x4*)(SLAB + ((size_t)(s < S ? s : 0) * MS + r) * DM + c);
#pragma unroll
            for (int s = 0; s < 22; ++s) a += sv[s] * (s < S ? 1.f : 0.f);
        }
        const f32x4 v = *(const f32x4*)(Y + ro) + a * alpha;
        *(f32x4*)(out + ro) = v;
        if (XN8) *(unsigned*)(XN8 + ro) = pk_i8x4(v[0] * sqx, v[1] * sqx, v[2] * sqx, v[3] * sqx);
        else { u32x2 w2; w2.x = cvt_pk_bf16(v[0], v[1]); w2.y = cvt_pk_bf16(v[2], v[3]); *(u32x2*)(XN + ro) = w2; }
        const float ss = wave_sum((v[0] * v[0] + v[1] * v[1]) + (v[2] * v[2] + v[3] * v[3]));
        if (lane == 0) atomicAdd(sumsq + MP + r, ss);
    }
}

__global__ void __launch_bounds__(512, 2) mega_fwd(Args args) {
    extern __shared__ __attribute__((aligned(16))) unsigned char lds[];
    LAS unsigned char* L = (LAS unsigned char*)lds;
#define FRESH_IDS() const int tid = fresh_tid(wave0); int G = G0, bx = bx0; asm volatile("" : "+s"(G), "+s"(bx)); const int lane = tid & 63, wave = wave0; const int gw = bx * 8 + wave, NGW = G * 8; (void)lane; (void)gw; (void)NGW
    const int G0 = gridDim.x, bx0 = blockIdx.x;
#define WSP(T, off) ((T*)(opaque_ptr(args.ws) + (off)))
#define INP(T, i) ((const T*)lds_ptr((volatile LAS unsigned*)(L + PTAB_OFF), (i)))
#define CTLP ((unsigned*)(opaque_ptr(args.ws) + WS_CTL))
#define SUMSQP(k) ((float*)(opaque_ptr(args.ws) + WS_CTL) + CW_SUMSQ + (k) * MT)
#define AVSQP ((float*)(opaque_ptr(args.ws) + WS_CTL) + CW_AVSQ)
#define DOUT ((float*)opaque_ptr((unsigned char*)args.out))
    const int wave0 = __builtin_amdgcn_readfirstlane(threadIdx.x >> 6);
    { const int tid = fresh_tid(wave0);
    for (int u = tid; u < (LDS_BYTES - MISC_OFF) / 4; u += 512) ((LAS unsigned*)(L + MISC_OFF))[u] = 0u;
    __syncthreads();
    if (tid < 24) { const unsigned long long p = (unsigned long long)args.in[tid]; ((LAS unsigned*)(L + PTAB_OFF))[2 * tid] = (unsigned)p; ((LAS unsigned*)(L + PTAB_OFF))[2 * tid + 1] = (unsigned)(p >> 32); }
    __syncthreads(); }
    XcdBarrier bar = xcd_barrier_post(CTLP + CW_BAR, (volatile LAS unsigned*)(L + MISC_OFF + 32), wave0);

    constexpr int IT_G = 32 * 176, IT_INE = 32 * 160, IT_O = 32 * 64, IT_INO = 32 * 128, IT_CW = 4 * 32;
    constexpr int NIT = 12 * IT_G + IT_INE + IT_O + IT_INO + IT_O + IT_CW;
#define CONV_IT(it_) do { \
            int r = (it_); \
            if (r < 12 * IT_G) { \
                const int seg = r / IT_G, which = seg >> 2, lf = seg & 3, l = lf >> 1, f = lf & 1; r -= seg * IT_G; \
                  \
                if (which == 0) tr_item8(INP(float, 8) + (size_t)lf * DM * FF, DM, FF, norm_g + (l * 3 + f * 2) * DM, (unsigned char*)(WSP(bf16_t, WS_WGU) + (size_t)lf * 2 * FF * DM), 1, scr, r, lane, SQ_W, true); \
                else if (which == 1) tr_item8(INP(float, 9) + (size_t)lf * DM * FF, DM, FF, norm_g + (l * 3 + f * 2) * DM, (unsigned char*)(WSP(bf16_t, WS_WGU) + (size_t)lf * 2 * FF * DM), 2, scr, r, lane, SQ_W, true); \
                else if (lf >= FP8_DOWN_FROM) tr_item8(INP(float, 10) + (size_t)lf * FF * DM, FF, DM, nullptr, (unsigned char*)(WSP(bf16_t, WS_WD) + (size_t)lf * DM * FF), 0, scr, r, lane, S8_W, false); \
                else tr_item(INP(float, 10) + (size_t)lf * FF * DM, FF, DM, nullptr, WSP(bf16_t, WS_WD) + (size_t)lf * DM * FF, 0, scr, r, lane); \
                break; \
            } \
            r -= 12 * IT_G; \
            if (r < IT_INE) { tr_item(INP(float, 11), DM, 5120, norm_g + 1 * DM, WSP(bf16_t, WS_WINE), 0, scr, r, lane); break; } r -= IT_INE; \
            if (r < IT_O) { tr_item(INP(float, 12), DM, DM, nullptr, WSP(bf16_t, WS_WOUTE), 0, scr, r, lane); break; } r -= IT_O; \
            if (r < IT_INO) { tr_item(INP(float, 19), DM, 4096, norm_g + 4 * DM, WSP(bf16_t, WS_WINO), 3, scr, r, lane); break; } r -= IT_INO; \
            if (r < IT_O) { tr_item(INP(float, 20), DM, DM, nullptr, WSP(bf16_t, WS_WOUTO), 0, scr, r, lane); break; } r -= IT_O; \
            { const int gi = r / 32; tr_item(INP(float, 21) + (size_t)gi * 65536, 256, 256, nullptr, WSP(bf16_t, WS_CWGT) + (size_t)gi * 65536, 0, scr, r % 32, lane); } \
        } while (0)

#define CONV_WIN2(lo1_, hi1_, lo2_, hi2_, k_) do { FRESH_IDS(); LAS float* scr = (LAS float*)(L + wave * 16384); const float* norm_g = INP(float, 7); unsigned* ctr_ = CTLP + CW_CONV + 64 * (k_); \
        const int n1_ = (hi1_) - (lo1_), nt_ = n1_ + (hi2_) - (lo2_); \
        for (;;) { int base_ = 0; if (lane == 0) base_ = (int)atomicAdd(ctr_, 4u); base_ = __builtin_amdgcn_readfirstlane(base_); if (base_ >= nt_) break; \
            for (int j_ = 0; j_ < 4; ++j_) { const int w_ = base_ + j_; if (w_ < nt_) CONV_IT(w_ < n1_ ? (lo1_) + w_ : (lo2_) + (w_ - n1_)); } } } while (0)
#define CONV_TAIL(lo_, hi_, w_, nw_) do { FRESH_IDS(); LAS float* scr = (LAS float*)(L + wave * 16384); const float* norm_g = INP(float, 7); \
        for (int q_ = (lo_) + (w_); q_ < (hi_); q_ += (nw_)) CONV_IT(q_); } while (0)
#define GATE_ARRIVE(k_) do { asm volatile("s_waitcnt vmcnt(0)" ::: "memory"); __syncthreads(); \
        if (fresh_tid(wave0) == 0) { __builtin_amdgcn_fence(__ATOMIC_RELEASE, "agent"); asm volatile("s_waitcnt vmcnt(0)" ::: "memory"); (void)xb_add(CTLP + CW_GATE + 64 * (k_), 1u); } } while (0)
#define GATE_WAIT(k_, need_) do { if (wave0 == 0) { unsigned sp_ = 0u; while (xb_ld(CTLP + CW_GATE + 64 * (k_)) < (unsigned)(need_)) { __builtin_amdgcn_s_sleep(2); if (++sp_ > XB_SPIN_CAP) break; } \
            __builtin_amdgcn_fence(__ATOMIC_ACQUIRE, "agent"); asm volatile("s_waitcnt vmcnt(0)" ::: "memory"); } __syncthreads(); } while (0)
    for (int rep = 0; rep < REP_PRO; ++rep) {
        if (rep) xcd_barrier(bar);
        FRESH_IDS();
        LAS float* scr = (LAS float*)(L + wave * 16384);
        const float* norm_g = INP(float, 7);
        constexpr int NDEF = 9632 + 4000 + 2820 + 1280 + 3140 + 3000 + 4000 + 3048 + 992 + 896;
        for (int k = gw; k < NIT - NDEF; k += NGW) {
            int it = k;
            if (it >= 5632) it += 15264 - 5632;
            if (it >= 16896) it += 20896 - 16896;
            if (it >= 28160) it += 30980 - 28160;
            if (it >= 33792) it += 35072 - 33792;
            if (it >= 39424) it += 42564 - 39424;
            if (it >= 50688) it += 53688 - 50688;
            if (it >= 61952) it += 65952 - 61952;
            if (it >= 71704) it += 74752 - 71704;
            if (it >= 78848) it += 80736 - 78848;
            CONV_IT(it);
        }
        {
            const float* x_prompt = INP(float, 0); const float* x_sample = INP(float, 1);
            unsigned char* XNQ = WSP(unsigned char, WS_XNQ); float* SQ = SUMSQP(0);
            for (int m = NGW - 1 - gw; m < MT; m += NGW) {
                const float* src = m < MP ? x_prompt + (size_t)m * DM : (m < MP + MS ? x_sample + (size_t)(m - MP) * DM : nullptr);
                float ss = 0.f;
#pragma unroll
                for (int j = 0; j < 8; ++j) {
                    const int c = 4 * lane + 256 * j;
                    f32x4 v = src ? __builtin_nontemporal_load((const f32x4*)(src + c)) : (f32x4){0.f, 0.f, 0.f, 0.f};
                    *(unsigned*)(XNQ + (size_t)m * DM + c) = pk_i8x4(v[0] * sqx_of(0), v[1] * sqx_of(0), v[2] * sqx_of(0), v[3] * sqx_of(0));
                    ss += (v[0] * v[0] + v[1] * v[1]) + (v[2] * v[2] + v[3] * v[3]);
                }
                ss = wave_sum(ss);
                if (lane == 0) SQ[m] = ss;
            }
        }
        {
            const float* a_ws = INP(float, 17); bf16_t* AWS = WSP(bf16_t, WS_AWS);
            for (int i = bx * 512 + tid; i < 8 * 128 * 128; i += G * 512) { const int p = (i >> 7) & 127, q = i & 127; AWS[i] = q <= p ? (bf16_t)(cvt_pk_bf16(a_ws[i], 0.f) & 0xffffu) : (bf16_t)0; }
            const float* state_pool = INP(float, 4); float* dout = DOUT;
            for (int i = bx * 512 + tid; i < DECB * 11 * 1024; i += G * 512) { const int b = i / (11 * 1024), rem = i % (11 * 1024); dout[O_PS + (size_t)b * 15 * 1024 + rem] = state_pool[(size_t)b * 15 * 1024 + 4 * 1024 + rem]; }
        }
    }
    xcd_barrier(bar);

    for (int layer = 0; layer < 2; ++layer) {
        for (int hs = 0; hs < 2; ++hs) {
            const int lf = layer * 2 + hs;
            const bool dn8 = (lf >= FP8_DOWN_FROM);
            for (int rep = 0; rep < REP_UP; ++rep) {
                if (rep) xcd_barrier(bar);
                if (bx0 >= G_UP) {
                    if (rep == 0 && lf > 0) {
                        const int w_ = (bx0 - G_UP) * 8 + wave0, nw_ = (G0 - G_UP) * 8; const int lane_ = fresh_tid(wave0) & 63;
                        if (lf == 1)      fixup_tasks(WSP(float, WS_PART), WSP(float, WS_SLAB), 2, WSP(float, WS_Y), WSP(float, WS_Y), WSP(bf16_t, WS_XN), SUMSQP(2), w_, nw_, lane_, WSP(unsigned char, WS_XNQ), sqx_of(1));
                        else if (lf == 2) fixup_tasks(WSP(float, WS_PART), WSP(float, WS_SLAB), 0, WSP(float, WS_Y), WSP(float, WS_Y), WSP(bf16_t, WS_XN), SUMSQP(3), w_, nw_, lane_, WSP(unsigned char, WS_XNQ), sqx_of(2));
                        else              fixup_tasks(WSP(float, WS_PART), WSP(float, WS_SLAB), 2, WSP(float, WS_Y), WSP(float, WS_Y), WSP(bf16_t, WS_XN), SUMSQP(5), w_, nw_, lane_, WSP(unsigned char, WS_XNQ), sqx_of(3));
                        GATE_ARRIVE(lf);
                    }
                    if (rep == 0) { if (lf == 0) CONV_WIN2(71704, 74752, 5632, 6584, 1); else if (lf == 1) CONV_WIN2(11264, 15264, 0, 0, 3); else if (lf == 2) CONV_WIN2(16896, 20896, 0, 0, 4); else CONV_WIN2(61952, 65952, 0, 0, 5); }
                } else if (dn8) {
                    pg8::Gemm g{WSP(unsigned char, WS_XNQ), (const unsigned char*)(WSP(bf16_t, WS_WGU) + (size_t)lf * 2 * FF * DM), DM, DM, DM, 0};
                    pg8::StaticOrder S; S.init(NPAN, 44, G_UP, bx0, 0, 16);
                    pg8::EpiUpT<2, true> E{WSP(unsigned char, WS_ACT), SUMSQP(layer * 3 + hs * 2), 1.0f / (sqx_of(3) * SQ_W)};
                    pg8::gemm_phase<pg8::EpiUpT<2, true>, 2>(L, g, S, E, wave0, lf > 0 ? CTLP + CW_GATE + 64 * lf : nullptr, (unsigned)(G0 - G_UP));
                } else {
                    pg8::Gemm g{WSP(unsigned char, WS_XNQ), (const unsigned char*)(WSP(bf16_t, WS_WGU) + (size_t)lf * 2 * FF * DM), DM, DM, DM, 0};
                    pg8::StaticOrder S; S.init(NPAN, 44, G_UP, bx0, 0, 16);
                    pg8::EpiUpT<2, false> E{WSP(bf16_t, WS_ACT), SUMSQP(layer * 3 + hs * 2), 1.0f / ((lf == 0 ? sqx_of(0) : (lf == 1 ? sqx_of(1) : sqx_of(2))) * SQ_W)};
                    pg8::gemm_phase<pg8::EpiUpT<2, false>, 2>(L, g, S, E, wave0, lf > 0 ? CTLP + CW_GATE + 64 * lf : nullptr, (unsigned)(G0 - G_UP));
                }
            }
            xcd_barrier(bar);
            const bool fin = (layer == 1 && hs == 1);
            const int ni = hs == 0 ? layer * 3 + 1 : (layer + 1) * 3;
            if (dn8) {
                pg8::Gemm g{WSP(unsigned char, WS_ACT), (const unsigned char*)(WSP(bf16_t, WS_WD) + (size_t)lf * DM * FF), FF, FF, FF, 0};
                pg8::StaticOrder S; S.init(32, 8, G0, bx0, 11, 44);
                pg8::EpiRes E{WSP(float, WS_Y), fin ? DOUT : WSP(float, WS_Y), WSP(bf16_t, WS_XN), WSP(float, WS_PART), 0.5f / (S8_ACT * S8_W), WSP(float, WS_SLAB)};
                pg8::gemm_phase<pg8::EpiRes, 1>(L, g, S, E, wave0);
            } else {
                pg8::Gemm g{WSP(bf16_t, WS_ACT), WSP(bf16_t, WS_WD) + (size_t)lf * DM * FF, FF * 2, FF * 2, FF, 0};
                pg8::StaticOrder S; S.init(32, 8, G0, bx0, 22, 88);
                pg8::EpiRes E{lf == 0 ? INP(float, 0) : WSP(float, WS_Y), fin ? DOUT : WSP(float, WS_Y), WSP(bf16_t, WS_XN), WSP(float, WS_PART), 0.5f, WSP(float, WS_SLAB), hs == 1 ? WSP(unsigned char, WS_XNQ) : nullptr, sqx_of(2)};
                pg8::gemm_phase<pg8::EpiRes>(L, g, S, E, wave0);
                if (bx0 >= 176) {
                    if (lf == 0) CONV_TAIL(33792, 34432, (bx0 - 176) * 8 + wave0, (G0 - 176) * 8); else if (lf == 1) CONV_TAIL(34432, 35072, (bx0 - 176) * 8 + wave0, (G0 - 176) * 8); else CONV_TAIL(41924, 42564, (bx0 - 176) * 8 + wave0, (G0 - 176) * 8);
                }
            }
            xcd_barrier(bar);
            if (fin) {
                if (dn8) { FRESH_IDS(); residual_fixup(WSP(float, WS_PART), WSP(float, WS_SLAB), 1, WSP(float, WS_Y), DOUT, WSP(bf16_t, WS_XN), AVSQP, gw, NGW, lane); }
                else     { FRESH_IDS(); residual_fixup(WSP(float, WS_PART), WSP(float, WS_SLAB), 0, WSP(float, WS_Y), DOUT, WSP(bf16_t, WS_XN), AVSQP, gw, NGW, lane); }
                break;
            }
            if (hs == 1) continue;
            if (layer == 0) {
                {
                    pg8::Gemm g{WSP(bf16_t, WS_XN), WSP(bf16_t, WS_WINE), DM * 2, DM * 2, DM, 0};
                    pg8::StaticOrder S; S.init(NPAN, 20, G_INE, bx0, 0, 32);
                    pg8::EpiInEven E{SUMSQP(1), WSP(bf16_t, WS_T0), WSP(bf16_t, WS_T1), WSP(bf16_t, WS_T2), WSP(bf16_t, WS_T3), WSP(bf16_t, WS_T4), DOUT, INP(float, 13), INP(float, 14), AVSQP, (LAS float*)(L + RED_OFF)};
                    if (bx0 < G_INE) pg8::gemm_phase<pg8::EpiInEven>(L, g, S, E, wave0, CTLP + CW_GATE + 64 * 4, (unsigned)(G0 - G_INE));
                    else {
                        { const int w_ = (bx0 - G_INE) * 8 + wave0, nw_ = (G0 - G_INE) * 8; const int lane_ = fresh_tid(wave0) & 63;
                          fixup_tasks(WSP(float, WS_PART), WSP(float, WS_SLAB), 0, INP(float, 1) - (size_t)MP * DM, WSP(float, WS_Y), WSP(bf16_t, WS_XN), SUMSQP(1), w_, nw_, lane_);
                          GATE_ARRIVE(4); }
                        CONV_WIN2(6584, 11264, 28160, 30980, 2);
                    }
                }
                xcd_barrier(bar);
                for (int rep = 0; rep < REP_MIX; ++rep) {
                    if (rep) xcd_barrier(bar);
                    FRESH_IDS();
                    if (rep == 0 && (bx < G / 2 || G < 2)) {
                        const int nb = G < 2 ? 1 : G / 2, b0 = bx;
                        for (int gu = b0; gu < 512; gu += nb)
                            sba::gate_unit(WSP(bf16_t, WS_T4), WSP(bf16_t, WS_T3), WSP(bf16_t, WS_AWS), AVSQP, INP(float, 16), INP(float, 18), WSP(bf16_t, WS_MIX), (gu >> 3) * 128, gu & 7, (char*)lds, wave0);
                    }
                    if (rep == 0 && (bx < G / 2 || G < 2)) {
                        const int na = G < 2 ? 1 : G / 2;
                        for (int pu = bx; pu < 128; pu += na) {
#pragma unroll 1
                            for (int half = 0; half < 2; ++half) {
                                const int j = pu >> 5, qb = half == 0 ? 7 - j : j, bh = pu & 31, b = bh >> 3, h = bh & 7;
                                const size_t rb = (size_t)b * SEQ;
                                sba::attn_unit(WSP(bf16_t, WS_T0) + (rb + qb * 256) * 1024 + h * HD, WSP(bf16_t, WS_T1) + rb * 1024 + h * HD, WSP(bf16_t, WS_T2) + rb * 1024 + h * HD,
                                               WSP(bf16_t, WS_MIX) + (rb + qb * 256) * DM + 1024 + h * HD, qb * 256, INP(float, 15)[h] * LOG2E, (char*)lds, wave0);
                            }
                        }
                    }
                    if (bx < MS) {
                        const int row = MP + bx, b = bx >> 2, p = bx & 3;
                        const bf16_t* T3 = WSP(bf16_t, WS_T3); const bf16_t* T4 = WSP(bf16_t, WS_T4); bf16_t* MIX = WSP(bf16_t, WS_MIX);
                        const float* AVSQ = AVSQP; const float* a_v_norm_g = INP(float, 16); const float* a_ws = INP(float, 17); const float* a_bs = INP(float, 18); float* dout = DOUT;
                        for (int c = tid; c < AW; c += 512) {
                            const int gi = c >> 7; float mixv = a_bs[gi * 128 + p];
                            for (int q = 0; q <= p; ++q) {
                                const int rq = MP + b * 4 + q;
                                const float avn = __uint_as_float((unsigned)T4[(size_t)rq * 1024 + c] << 16) * __builtin_amdgcn_rsqf(AVSQ[rq] * (1.0f / AW) + EPS) * a_v_norm_g[c];
                                mixv += a_ws[(size_t)gi * 16384 + p * 128 + q] * avn;
                                if (q == p) dout[O_AV + (size_t)bx * 1024 + c] = avn;
                            }
                            const float au = __uint_as_float((unsigned)T3[(size_t)row * 1024 + c] << 16);
                            MIX[(size_t)row * DM + c] = (bf16_t)(cvt_pk_bf16(au * mixv, 0.f) & 0xffffu);
                        }
                    }
                    {
                        const bf16_t* T0 = WSP(bf16_t, WS_T0); const float* cache_k = INP(float, 2); const float* cache_v = INP(float, 3); const int* page_table = INP(int, 6);
                        const float* sb_bias = INP(float, 15); float* PO = WSP(float, WS_PO); float* PP = WSP(float, WS_PP); unsigned* qctr = CTLP + CW_QCTR + 64 * rep;
                        for (;;) {
                            int item = 0;
                            if (lane == 0) item = (int)atomicAdd(qctr, 1u);
                            item = __builtin_amdgcn_readfirstlane(item);
                            if (item >= 64 * 32) break;
                            const int h = item & 7, run = (item >> 3) & 31, b = item >> 8, bh = b * 8 + h, pidx = bh * 32 + run, hi = lane >> 5, l32 = lane & 31;
                            f32x4 qv[4];
#pragma unroll
                            for (int qi = 0; qi < 4; ++qi) { const u32x2 w = *(const u32x2*)(T0 + (size_t)(MP + b * 4 + qi) * 1024 + h * HD + 4 * l32);
                                qv[qi] = (f32x4){bf_lo(w.x), bf_hi(w.x), bf_lo(w.y), bf_hi(w.y)}; }
                            const float bias2 = sb_bias[h] * LOG2E;
                            f32x4 o[4] = {};
                            float C = 1.f;
                            const int qsel = (lane >> 3) & 3;
                            int phys[4];
#pragma unroll
                            for (int p4 = 0; p4 < 4; ++p4) phys[p4] = page_table[b * NPAGES + run * 4 + p4];
                            const size_t lane_off = (size_t)h * HD + 4 * l32;
#define SA_LOAD(KK, VV, ci) do { const int _pg = (ci) >> 4, _c8 = (ci) & 15; const int _ph = _pg == 0 ? phys[0] : (_pg == 1 ? phys[1] : (_pg == 2 ? phys[2] : phys[3])); \
    const size_t _base = ((size_t)_ph * PAGE) * (NH * HD) + lane_off; _Pragma("unroll") for (int s_ = 0; s_ < 4; ++s_) { const int tok = _c8 * 8 + 7 - 2 * s_ - hi; \
        KK[s_] = __builtin_nontemporal_load((const f32x4*)(cache_k + _base + (size_t)tok * (NH * HD))); VV[s_] = __builtin_nontemporal_load((const f32x4*)(cache_v + _base + (size_t)tok * (NH * HD))); } } while (0)
#define SA_COMPUTE(KK, VV) do { _Pragma("unroll") for (int s_ = 0; s_ < 4; ++s_) { \
        float d0 = (KK[s_][0] * qv[0][0] + KK[s_][1] * qv[0][1]) + (KK[s_][2] * qv[0][2] + KK[s_][3] * qv[0][3]); \
        float d1 = (KK[s_][0] * qv[1][0] + KK[s_][1] * qv[1][1]) + (KK[s_][2] * qv[1][2] + KK[s_][3] * qv[1][3]); \
        float d2 = (KK[s_][0] * qv[2][0] + KK[s_][1] * qv[2][1]) + (KK[s_][2] * qv[2][2] + KK[s_][3] * qv[2][3]); \
        float d3 = (KK[s_][0] * qv[3][0] + KK[s_][1] * qv[3][1]) + (KK[s_][2] * qv[3][2] + KK[s_][3] * qv[3][3]); \
        float ka = b4 ? d2 : d0, kb2 = b4 ? d3 : d1, sa = b4 ? d0 : d2, sb = b4 ? d1 : d3; \
        ka += xchg16(sa, b4); kb2 += xchg16(sb, b4);                                    \
        float kc = b3 ? kb2 : ka, sc2 = b3 ? ka : kb2; \
        kc += dppf<0x128>(sc2);                                                          \
        kc += dppf<0xB1>(kc); kc += dppf<0x4E>(kc); kc += dppf<0x141>(kc);               \
        const float e = fast_exp2(kc + bias2), f = 1.f + e; const float fo = xchg32(f, hi); const float Cn = C * f * fo; \
        const float A = e * fast_rcp(hi ? Cn : C * f); C = Cn; \
        const float Ab = dppf<0x128>(A); const float alo = b3 ? Ab : A, ahi = b3 ? A : Ab;     \
        const float olo = xchg16(alo, b4), ohi = xchg16(ahi, b4);                       \
        const float A0 = b4 ? olo : alo, A1 = b4 ? ohi : ahi, A2 = b4 ? alo : olo, A3 = b4 ? ahi : ohi; \
        o[0] += VV[s_] * A0; o[1] += VV[s_] * A1; o[2] += VV[s_] * A2; o[3] += VV[s_] * A3; } } while (0)
                            const bool b4 = (lane & 16) != 0, b3 = (lane & 8) != 0;
                            f32x4 kA[4], vA[4], kB[4], vB[4];
                            SA_LOAD(kA, vA, 63);
                            for (int ci = 63; ci >= 1; ci -= 2) {
                                SA_LOAD(kB, vB, ci - 1);
                                SA_COMPUTE(kA, vA);
                                if (ci >= 2) SA_LOAD(kA, vA, ci - 2);
                                SA_COMPUTE(kB, vB);
                            }
#undef SA_LOAD
#undef SA_COMPUTE
#pragma unroll
                            for (int qi = 0; qi < 4; ++qi) {
#pragma unroll
                                for (int j = 0; j < 4; ++j) o[qi][j] += xchg32(o[qi][j], hi);
                                if (hi == 0) *(f32x4*)(PO + ((size_t)pidx * 4 + qi) * HD + 4 * l32) = o[qi];
                            }
                            if ((lane & 39) == 0) PP[(size_t)pidx * 4 + qsel] = C;
                        }
                    }
                }
                xcd_barrier(bar);
                if (bx0 >= G0 - 32) {
                    FRESH_IDS();
                    const int cw_ = (bx0 - (G0 - 32)) * 8 + wave0;
                    const bf16_t* T0 = WSP(bf16_t, WS_T0); const bf16_t* T1 = WSP(bf16_t, WS_T1); const bf16_t* T2 = WSP(bf16_t, WS_T2); bf16_t* MIX = WSP(bf16_t, WS_MIX);
                    const float* sb_bias = INP(float, 15); const float* PO = WSP(float, WS_PO); const float* PP = WSP(float, WS_PP);
                    for (int bhi = cw_; bhi < 256; bhi += 256) {
                        const int bh = bhi >> 2, i = bhi & 3, b = bh >> 3, h = bh & 7; const float bias2 = sb_bias[h] * LOG2E;
                        float pp[32]; f32x2 po[32];
#pragma unroll
                        for (int run = 0; run < 32; ++run) { const size_t it = (size_t)bh * 32 + run; pp[run] = PP[it * 4 + i]; po[run] = *(const f32x2*)(PO + (it * 4 + i) * HD + 2 * lane); }
                        const size_t rq = (size_t)(MP + b * 4 + i) * 1024 + h * HD + 2 * lane;
                        const unsigned qw = *(const unsigned*)(T0 + rq); const float q0 = bf_lo(qw), q1 = bf_hi(qw);
                        float o0 = 0.f, o1 = 0.f, P = 1.f;
#pragma unroll
                        for (int j = 2; j >= 0; --j) {
                            if (j < i) {
                                const size_t rk = (size_t)(MP + b * 4 + j) * 1024 + h * HD + 2 * lane;
                                const unsigned kw = *(const unsigned*)(T1 + rk), vw = *(const unsigned*)(T2 + rk);
                                const float z = wave_sum(q0 * bf_lo(kw) + q1 * bf_hi(kw)) + bias2;
                                const float e = fast_exp2(z); P *= (1.f + e);
                                const float A = e / P; o0 += A * bf_lo(vw); o1 += A * bf_hi(vw);
                            }
                        }
                        float scale = 1.f / P;
#pragma unroll
                        for (int run = 31; run >= 0; --run) { o0 += po[run][0] * scale; o1 += po[run][1] * scale; scale = scale / pp[run]; }
                        *(unsigned*)(MIX + (size_t)(MP + b * 4 + i) * DM + 1024 + h * HD + 2 * lane) = cvt_pk_bf16(o0, o1);
                    }
                    GATE_ARRIVE(6);
                }
                {
                    pg8::Gemm g{WSP(bf16_t, WS_MIX), WSP(bf16_t, WS_WOUTE), DM * 2, DM * 2, DM, 0};
                    pg8::StaticOrder S; S.init(32, 8, G0, bx0, 0, 32);
                    pg8::EpiRes E{WSP(float, WS_Y), WSP(float, WS_Y), WSP(bf16_t, WS_XN), WSP(float, WS_PART), 1.0f, WSP(float, WS_SLAB), WSP(unsigned char, WS_XNQ), sqx_of(1)};
                    pg8::gemm_phase<pg8::EpiRes>(L, g, S, E, wave0);
                    if (bx0 < 64) {
                        GATE_WAIT(6, 32);
                        pg8::StaticOrder S2; S2.init(32, 8, G0, bx0, 8, 32); S2.i0 = (256 - bx0 + G0 - 1) / G0;
                        pg8::gemm_phase<pg8::EpiRes>(L, g, S2, E, wave0);
                    } else if (bx0 < G0 - 32) CONV_TAIL(50688, 53688, (bx0 - 64) * 8 + wave0, (G0 - 96) * 8);
                }
                xcd_barrier(bar);
            } else {
                {
                    pg8::Gemm g{WSP(bf16_t, WS_XN), WSP(bf16_t, WS_WINO), DM * 2, DM * 2, DM, 0};
                    pg8::StaticOrder S; S.init(32, 16, G0, bx0, 8, 32);
                    pg8::EpiInOdd E{SUMSQP(4), WSP(bf16_t, WS_T0), WSP(bf16_t, WS_T1), WSP(bf16_t, WS_T2), DOUT, WSP(float, WS_SLAB)};
                    if (bx0 >= G0 - 16) { const int w_ = (bx0 - (G0 - 16)) * 8 + wave0; const int lane_ = fresh_tid(wave0) & 63;
                        fixup_tasks(WSP(float, WS_PART), WSP(float, WS_SLAB), 0, WSP(float, WS_Y), WSP(float, WS_Y), WSP(bf16_t, WS_XN), SUMSQP(4), w_, 128, lane_);
                        GATE_ARRIVE(5); }
                    pg8::gemm_phase<pg8::EpiInOdd>(L, g, S, E, wave0, CTLP + CW_GATE + 64 * 5, 16u);
                    if (bx0 >= 128 && bx0 < G0 - 16) CONV_TAIL(79840, 80736, (bx0 - 128) * 8 + wave0, (G0 - 144) * 8);
                }
                xcd_barrier(bar);
                {
                    FRESH_IDS();
                    const bf16_t* T0 = WSP(bf16_t, WS_T0); const bf16_t* T1 = WSP(bf16_t, WS_T1); const bf16_t* T2 = WSP(bf16_t, WS_T2); bf16_t* T3 = WSP(bf16_t, WS_T3); bf16_t* MIX = WSP(bf16_t, WS_MIX);
                    const float* d_conv_w = INP(float, 23);
                    if (bx < 128) {
                        const int it = bx * 512 + tid;
                        const int grp = it >> 14, run = (it >> 5) & 511, c = grp * 256 + (it & 31) * 8, R0 = run * 16, t0 = R0 & (SEQ - 1);
                        if (grp == 0) pool_run<2>(T0, T3, R0, t0, c); else if (grp == 1) pool_run<4>(T0, T3, R0, t0, c); else if (grp == 2) pool_run<8>(T0, T3, R0, t0, c); else pool_run<16>(T0, T3, R0, t0, c);
                    } else if (bx >= NPAN * 4) {
                        for (int it = (bx - NPAN * 4) * 512 + tid; it < 512 * 128; it += (G - NPAN * 4) * 512) {
                            const int run = it >> 7, c = (it & 127) * 8, R0 = run * 16, t0 = R0 & (SEQ - 1);
                            conv_run8(T1, T2, d_conv_w, MIX, R0, t0, c); conv_run8(T1, T2, d_conv_w, MIX, R0 + 8, t0 + 8, c);
                        }
                    }
                    if (bx >= 128 && bx < NPAN * 4) {
                        const int g_ = bx - 128, win = 2 << g_;
                        const float* SP = WSP(float, WS_SLAB); const float* SQ = SUMSQP(4); const float* state_pool = INP(float, 4); const float* state_conv = INP(float, 5); float* dout = DOUT;
                        LAS float* XCs = (LAS float*)L; LAS float* GGs = XCs + 32 * 256; LAS float* GBs = GGs + 32 * 256;
                        for (int q = tid; q < MS * 32; q += 512) {
                            const int r = q >> 5, cc = (q & 31) * 8, c = g_ * 256 + cc, gcol = 2048 + 256 * (c >> 7) + (c & 127);
                            const float rs = __builtin_amdgcn_rsqf(SQ[MP + r] * (1.0f / DM) + EPS);
                            float xc[8], gc[8], gh[8], gb[8];
                            sp_sum8(SP, r, c, xc); sp_sum8(SP, r, gcol, gc); sp_sum8(SP, r, gcol + 128, gh); sp_sum8(SP, r, 1024 + c, gb);
#pragma unroll
                            for (int h = 0; h < 2; ++h) {
                                f32x4 a, d, e;
#pragma unroll
                                for (int j = 0; j < 4; ++j) { a[j] = xc[h * 4 + j] * rs; d[j] = gc[h * 4 + j] * gh[h * 4 + j] * rs * rs; e[j] = gb[h * 4 + j] * rs; }
                                *(LAS f32x4*)(XCs + r * 256 + cc + h * 4) = a; *(LAS f32x4*)(GGs + r * 256 + cc + h * 4) = d; *(LAS f32x4*)(GBs + r * 256 + cc + h * 4) = e;
                            }
                        }
                        __syncthreads();
                        for (int q = tid; q < MS * 32; q += 512) {
                            const int sr = q >> 5, cc = (q & 31) * 8, c = g_ * 256 + cc, b = sr >> 2, i = sr & 3, row = MP + sr;
                            float acc[8], self[8], gsum[8], gbv[8];
#pragma unroll
                            for (int h = 0; h < 2; ++h) { const f32x4 a = *(const LAS f32x4*)(XCs + sr * 256 + cc + h * 4), e = *(const LAS f32x4*)(GBs + sr * 256 + cc + h * 4);
#pragma unroll
                                for (int j = 0; j < 4; ++j) { self[h * 4 + j] = a[j]; acc[h * 4 + j] = a[j]; gbv[h * 4 + j] = e[j]; gsum[h * 4 + j] = 0.f; } }
#pragma unroll
                            for (int k = 1; k <= 3; ++k) {
                                const float mk = (k <= i && k < win) ? 1.f : 0.f; const int r2 = sr - (k <= i ? k : 0);
#pragma unroll
                                for (int h = 0; h < 2; ++h) { const f32x4 a = *(const LAS f32x4*)(XCs + r2 * 256 + cc + h * 4);
#pragma unroll
                                    for (int j = 0; j < 4; ++j) acc[h * 4 + j] += a[j] * mk; }
                            }
                            const int lo = 15 + i - (win - 1);
#pragma unroll 5
                            for (int fi = 0; fi < 15; ++fi) {
                                const float* sp = state_pool + ((size_t)b * 15 + fi) * 1024 + c; const f32x4 a = *(const f32x4*)sp, d = *(const f32x4*)(sp + 4); const float mk = fi >= lo ? 1.f : 0.f;
#pragma unroll
                                for (int j = 0; j < 4; ++j) { acc[j] += a[j] * mk; acc[4 + j] += d[j] * mk; }
                            }
#pragma unroll
                            for (int j = 0; j < 8; ++j) dout[O_PS + ((size_t)b * 15 + 11 + i) * 1024 + c + j] = self[j];
#pragma unroll
                            for (int k = 0; k < 3; ++k) {
                                const int gi = i - 2 + k; float gg[8];
                                if (gi >= 0) {
#pragma unroll
                                    for (int h = 0; h < 2; ++h) { const f32x4 d = *(const LAS f32x4*)(GGs + (b * 4 + gi) * 256 + cc + h * 4);
#pragma unroll
                                        for (int j = 0; j < 4; ++j) gg[h * 4 + j] = d[j]; }
                                    if (k == 2 && i >= 2) {
#pragma unroll
                                        for (int j = 0; j < 8; ++j) dout[O_CS + ((size_t)b * 2 + (i - 2)) * 1024 + c + j] = gg[j]; }
                                } else { const float* sp = state_conv + ((size_t)b * 2 + (gi + 2)) * 1024 + c;
#pragma unroll
                                    for (int j = 0; j < 8; ++j) gg[j] = sp[j]; }
                                const f32x4 w0 = *(const f32x4*)(d_conv_w + k * 1024 + c), w1 = *(const f32x4*)(d_conv_w + k * 1024 + c + 4);
#pragma unroll
                                for (int j = 0; j < 4; ++j) { gsum[j] += gg[j] * w0[j]; gsum[4 + j] += gg[4 + j] * w1[j]; }
                            }
                            const float ic = 1.0f / (float)win;
                            u32x4 wp, wd;
                            wp.x = cvt_pk_bf16(acc[0] * ic - self[0], acc[1] * ic - self[1]); wp.y = cvt_pk_bf16(acc[2] * ic - self[2], acc[3] * ic - self[3]);
                            wp.z = cvt_pk_bf16(acc[4] * ic - self[4], acc[5] * ic - self[5]); wp.w = cvt_pk_bf16(acc[6] * ic - self[6], acc[7] * ic - self[7]);
                            wd.x = cvt_pk_bf16(gbv[0] * gsum[0], gbv[1] * gsum[1]); wd.y = cvt_pk_bf16(gbv[2] * gsum[2], gbv[3] * gsum[3]);
                            wd.z = cvt_pk_bf16(gbv[4] * gsum[4], gbv[5] * gsum[5]); wd.w = cvt_pk_bf16(gbv[6] * gsum[6], gbv[7] * gsum[7]);
                            *(u32x4*)(T3 + (size_t)row * 1024 + c) = wp;
                            *(u32x4*)(MIX + (size_t)row * DM + 1024 + c) = wd;
                        }
                    }
                }
                if (bx0 < NPAN * 4) {
                    asm volatile("s_waitcnt vmcnt(0)" ::: "memory"); __syncthreads();
                    pg8::Gemm g{WSP(bf16_t, WS_T3), WSP(bf16_t, WS_CWGT), 1024 * 2, 256 * 2, 256, 256 * 2};
                    pg8::StaticOrder S; S.init(NPAN, 4, G0, bx0, 0, 4); S.dpm = bx0 < 128 ? (bx0 & 31) : 32; S.dpn = bx0 < 128 ? (bx0 >> 5) : bx0 - 128;
                    pg8::EpiPool E{WSP(bf16_t, WS_MIX), INP(float, 22)};
                    pg8::gemm_phase<pg8::EpiPool>(L, g, S, E, wave0);
                } else CONV_TAIL(78848, 79840, (bx0 - NPAN * 4) * 8 + wave0, (G0 - NPAN * 4) * 8);
                xcd_barrier(bar);
                {
                    pg8::Gemm g{WSP(bf16_t, WS_MIX), WSP(bf16_t, WS_WOUTO), DM * 2, DM * 2, DM, 0};
                    pg8::StaticOrder S; S.init(32, 8, G0, bx0, 8, 32);
                    pg8::EpiRes E{WSP(float, WS_Y), WSP(float, WS_Y), WSP(bf16_t, WS_XN), WSP(float, WS_PART), 1.0f, WSP(float, WS_SLAB), WSP(unsigned char, WS_XNQ), sqx_of(3)};
                    pg8::gemm_phase<pg8::EpiRes>(L, g, S, E, wave0);
                    if (bx0 >= 64) CONV_TAIL(39424, 41924, (bx0 - 64) * 8 + wave0, (G0 - 64) * 8);
                }
                xcd_barrier(bar);
            }
        }
    }
}

extern "C" void kernel_launch(void* const* d_in, const int* in_sizes, int n_in, void* d_out, int out_size, void* d_ws, size_t ws_size, hipStream_t stream) {
    static int grid = 0;
    if (grid == 0) {
        if (n_in != 24 || ws_size < WS_END || out_size != (int)O_END) { fprintf(stderr, "kernel_launch: unexpected problem (n_in %d, out %d, ws %zu)\n", n_in, out_size, ws_size); grid = -1; return; }
        int dev = 0, cus = 0, per_cu = 0;
        if (hipGetDevice(&dev) != hipSuccess || hipDeviceGetAttribute(&cus, hipDeviceAttributeMultiprocessorCount, dev) != hipSuccess) { grid = -1; return; }
        if (hipFuncSetAttribute((const void*)mega_fwd, hipFuncAttributeMaxDynamicSharedMemorySize, LDS_BYTES) != hipSuccess) { fprintf(stderr, "kernel_launch: hipFuncSetAttribute failed\n"); grid = -1; return; }
        if (hipOccupancyMaxActiveBlocksPerMultiprocessor(&per_cu, (const void*)mega_fwd, 512, LDS_BYTES) != hipSuccess || per_cu < 1) { fprintf(stderr, "kernel_launch: occupancy query says %d\n", per_cu); }
        (void)hipGetLastError();
        grid = cus;
    }
    if (grid < 0) return;
    (void)hipMemsetAsync((char*)d_ws + WS_CTL, 0, CTL_BYTES, stream);
    Args a{};
    for (int i = 0; i < 24; ++i) a.in[i] = d_in[i];
    a.out = (float*)d_out; a.ws = (unsigned char*)d_ws;
    hipLaunchKernelGGL(mega_fwd, dim3(grid), dim3(512), LDS_BYTES, stream, a);
}
```

```cpp
#include <hip/hip_runtime.h>
#include <cstdio>
#include <cstdint>

#define GAS __attribute__((address_space(1)))
#define LAS __attribute__((address_space(3)))
typedef unsigned short bf16_t;
typedef short bf16x8 __attribute__((ext_vector_type(8)));
typedef short s16x4 __attribute__((ext_vector_type(4)));
typedef float f32x4 __attribute__((ext_vector_type(4)));
typedef float f32x2 __attribute__((ext_vector_type(2)));
typedef float f32x16 __attribute__((ext_vector_type(16)));
typedef unsigned u32x4 __attribute__((ext_vector_type(4)));
typedef unsigned u32x2 __attribute__((ext_vector_type(2)));

#ifndef FP8_DOWN_FROM
#define FP8_DOWN_FROM 3
#endif
constexpr int G_UP = 242, G_INE = 220;
#ifndef REP_PRO
#define REP_PRO 1
#endif
#ifndef REP_UP
#define REP_UP 1
#endif
#ifndef REP_MIX
#define REP_MIX 1
#endif
#ifndef REP_BAR
#define REP_BAR 1
#endif
#ifndef REP_ODD
#define REP_ODD 1
#endif
#ifndef REP_CMB
#define REP_CMB 1
#endif
constexpr int DM = 2048, FF = 5632, SEQ = 2048, NBATCH = 4, MP = 8192, MS = 32, MT = 8448, NPAN = 33;
constexpr int NH = 8, HD = 128, AW = 1024, NPAGES = 128, PAGE = 128, DECB = 8, DECS = 4;
constexpr float EPS = 1e-6f;
constexpr float LOG2E = 1.4426950408889634f;
constexpr float QSCALE = 0.08838834764831845f * LOG2E;
constexpr size_t O_YP = 0, O_YS = 16777216, O_KP = 16842752, O_VP = 25231360, O_KS = 33619968, O_VS = 33652736, O_AV = 33685504,
                 O_PP = 33718272, O_PS = 33779712, O_CP = 33902592, O_CS = 33910784, O_END = 33927168;

constexpr size_t al(size_t x) { return (x + 1048575) & ~(size_t)1048575; }
constexpr size_t WS_CTL = 0, CTL_BYTES = 1048576;
constexpr size_t SZ_WGU = (size_t)2 * FF * DM * 2, SZ_WD = (size_t)DM * FF * 2;
constexpr size_t WS_WGU = al(WS_CTL + CTL_BYTES);
constexpr size_t WS_WD = al(WS_WGU + 4 * SZ_WGU);
constexpr size_t WS_WINE = al(WS_WD + 4 * SZ_WD);
constexpr size_t WS_WOUTE = al(WS_WINE + (size_t)5120 * DM * 2);
constexpr size_t WS_WINO = al(WS_WOUTE + (size_t)DM * DM * 2);
constexpr size_t WS_WOUTO = al(WS_WINO + (size_t)4096 * DM * 2);
constexpr size_t WS_AWS = al(WS_WOUTO + (size_t)DM * DM * 2);
constexpr size_t WS_CWGT = al(WS_AWS + 8 * 128 * 128 * 2);
constexpr size_t WS_XN = al(WS_CWGT + 1024 * 256 * 2);
constexpr size_t WS_ACT = al(WS_XN + (size_t)MT * DM * 2);
constexpr size_t WS_Y = al(WS_ACT + (size_t)MT * FF * 2);
constexpr size_t SZ_T = (size_t)MT * 1024 * 2;
constexpr size_t WS_T0 = al(WS_Y + (size_t)MT * DM * 4);
constexpr size_t WS_T1 = al(WS_T0 + SZ_T);
constexpr size_t WS_T2 = al(WS_T1 + SZ_T);
constexpr size_t WS_T3 = al(WS_T2 + SZ_T);
constexpr size_t WS_T4 = al(WS_T3 + SZ_T);
constexpr size_t WS_MIX = al(WS_T4 + SZ_T);
constexpr size_t WS_PO = al(WS_MIX + (size_t)MT * DM * 2);
constexpr size_t WS_PP = al(WS_PO + (size_t)64 * 32 * 4 * 128 * 4);
constexpr size_t WS_SLAB = al(WS_PP + 64 * 32 * 4 * 4);
constexpr size_t WS_PART = al(WS_SLAB + (size_t)22 * 32 * 2048 * 4);
constexpr size_t WS_XNQ = al(WS_PART + (size_t)MP * 32 * 4);
constexpr size_t WS_END = al(WS_XNQ + (size_t)MT * DM);
constexpr int CW_BAR = 4096, CW_QCTR = 8192, CW_CONV = 9216, CW_GATE = 12288  , CW_SUMSQ = 16384, CW_AVSQ = 16384 + 6 * MT + 512;
static_assert((CW_AVSQ + MT) * 4 <= 1048576, "ctl");

constexpr int RING_BYTES = 131072, RED_OFF = RING_BYTES, RED_BYTES = 8192, MISC_OFF = RED_OFF + RED_BYTES, LDS_BYTES = 147456;

#define LDS_WAIT() asm volatile("s_waitcnt lgkmcnt(0)" ::: "memory")
#define VM_WAIT() asm volatile("s_waitcnt vmcnt(0)" ::: "memory")
__device__ __forceinline__ unsigned cvt_pk_bf16(float lo, float hi) { unsigned r; asm volatile("v_cvt_pk_bf16_f32 %0, %1, %2" : "=v"(r) : "v"(lo), "v"(hi)); return r; }
__device__ __forceinline__ unsigned pk_fp8x4(float a, float b, float c, float d) {
    a = fminf(fmaxf(a, -440.f), 440.f); b = fminf(fmaxf(b, -440.f), 440.f); c = fminf(fmaxf(c, -440.f), 440.f); d = fminf(fmaxf(d, -440.f), 440.f);
    int w = __builtin_amdgcn_cvt_pk_fp8_f32(a, b, 0, false); w = __builtin_amdgcn_cvt_pk_fp8_f32(c, d, w, true); return (unsigned)w;
}
constexpr float S8_W = 64.f, S8_ACT = 8.f;
constexpr float SQ_W = 127.f / 0.0884f;
__host__ __device__ constexpr float sqx_of(int lf) { return 127.f / (lf == 0 ? 4.5f : (lf == 1 ? 5.5f : (lf == 2 ? 6.5f : 7.0f))); }
__device__ __forceinline__ unsigned pk_i8x4(float a, float b, float c, float d) {
    const int ia = (int)__builtin_rintf(fminf(fmaxf(a, -127.f), 127.f)), ib = (int)__builtin_rintf(fminf(fmaxf(b, -127.f), 127.f)),
              ic = (int)__builtin_rintf(fminf(fmaxf(c, -127.f), 127.f)), id = (int)__builtin_rintf(fminf(fmaxf(d, -127.f), 127.f));
    return ((unsigned)ia & 0xffu) | (((unsigned)ib & 0xffu) << 8) | (((unsigned)ic & 0xffu) << 16) | ((unsigned)id << 24);
}
__device__ __forceinline__ float bf_lo(unsigned w) { return __uint_as_float(w << 16); }
__device__ __forceinline__ float bf_hi(unsigned w) { return __uint_as_float(w & 0xffff0000u); }
__device__ __forceinline__ float fast_rcp(float x) { return __builtin_amdgcn_rcpf(x); }
__device__ __forceinline__ float fast_exp2(float x) { return __builtin_amdgcn_exp2f(x); }
__device__ __forceinline__ float gelu_tanh(float x) {
    const float t = x * (1.0f + 0.044715f * x * x) * (-2.0f * 0.7978845608028654f * LOG2E);
    return x * fast_rcp(1.0f + fast_exp2(t));
}
__device__ __forceinline__ float xchg32(float x, int hi) {
    auto rr = __builtin_amdgcn_permlane32_swap(__float_as_uint(x), __float_as_uint(x), false, false);
    return __uint_as_float(hi ? rr[0] : rr[1]);
}

template <int CTRL> __device__ __forceinline__ float dppf(float x) { return __int_as_float(__builtin_amdgcn_update_dpp(0, __float_as_int(x), CTRL, 0xf, 0xf, true)); }
__device__ __forceinline__ float xchg16(float x, bool b4) { auto rr = __builtin_amdgcn_permlane16_swap(__float_as_uint(x), __float_as_uint(x), false, false); return __uint_as_float(b4 ? rr[0] : rr[1]); }
__device__ __forceinline__ float sum_x16(float x) { auto rr = __builtin_amdgcn_permlane16_swap(__float_as_uint(x), __float_as_uint(x), false, false); return __uint_as_float(rr[0]) + __uint_as_float(rr[1]); }
__device__ __forceinline__ float sum_x32(float x) { auto rr = __builtin_amdgcn_permlane32_swap(__float_as_uint(x), __float_as_uint(x), false, false); return __uint_as_float(rr[0]) + __uint_as_float(rr[1]); }
__device__ __forceinline__ float sum_row16(float x) { x += dppf<0xB1>(x); x += dppf<0x4E>(x); x += dppf<0x141>(x); x += dppf<0x140>(x); return x; }
__device__ __forceinline__ int fresh_tid(int wave0) { int l; asm volatile("v_mbcnt_lo_u32_b32 %0, -1, 0\n\tv_mbcnt_hi_u32_b32 %0, -1, %0" : "=v"(l)); return wave0 * 64 + l; }
#define XB_TMO      128
#define XB_XCNT(j)  (256  + 64 * (j))
#define XB_XSUB(j)  (1280 + 64 * (j))
#define XB_XGEN(j)  (2304 + 64 * (j))
#define XB_TOP      3328
#define XB_TOPGEN   3392
#define XCD_BAR_WORDS 3456
#define XB_SPIN_CAP (1u << 22)
__device__ __forceinline__ unsigned xb_ld(unsigned* p)              { return __hip_atomic_load(p, __ATOMIC_RELAXED, __HIP_MEMORY_SCOPE_AGENT); }
__device__ __forceinline__ unsigned xb_add(unsigned* p, unsigned v) { return __hip_atomic_fetch_add(p, v, __ATOMIC_RELAXED, __HIP_MEMORY_SCOPE_AGENT); }
__device__ __forceinline__ unsigned xb_xcc_id() { return (unsigned)__builtin_amdgcn_s_getreg((3 << 11) | 20) & 0xFu; }
#define XB_SPIN(cond, bar) do { unsigned _sp = 0; while (cond) { __builtin_amdgcn_s_sleep(1); \
    if ((++_sp & 255u) == 0u) { if (xb_ld(&(bar)[XB_TMO])) break; if (_sp > XB_SPIN_CAP) { atomicAdd(&(bar)[XB_TMO], 1u); break; } } } } while (0)
struct XcdBarrier { unsigned* bar; unsigned x; volatile LAS unsigned* st; };
__device__ __forceinline__ XcdBarrier xcd_barrier_post(unsigned* bar, volatile LAS unsigned* st, int wave0) {
    XcdBarrier b; b.bar = bar; b.x = (unsigned)wave0; b.st = st;
    if (fresh_tid(wave0) == 0) (void)xb_add(&bar[XB_XCNT(xb_xcc_id())], 1u);
    return b;
}
__device__ __forceinline__ void xcd_barrier_complete(unsigned* bar, unsigned x, unsigned& nloc, unsigned& nx) {
    const unsigned G = gridDim.x * gridDim.y * gridDim.z;
    unsigned sum, cnt, mine, sp = 0u;
    for (;;) {
        sum = 0u; cnt = 0u; mine = 0u;
#pragma unroll
        for (unsigned j = 0; j < 16; ++j) { const unsigned c = xb_ld(&bar[XB_XCNT(j)]); sum += c; cnt += (c > 0u) ? 1u : 0u; }
        mine = xb_ld(&bar[XB_XCNT(x)]);
        if (sum == G) break;
        __builtin_amdgcn_s_sleep(1);
        if ((++sp & 255u) == 0u) { if (xb_ld(&bar[XB_TMO])) break; if (sp > XB_SPIN_CAP) { atomicAdd(&bar[XB_TMO], 1u); break; } }
    }
    nloc = mine > 0u ? mine : 1u; nx = cnt > 0u ? cnt : 1u;
}
__device__ __forceinline__ void xcd_barrier1(const XcdBarrier& b) {
    asm volatile("s_waitcnt vmcnt(0)" ::: "memory");
    __syncthreads();
    if (fresh_tid((int)b.x) == 0) {
        unsigned* bar = b.bar; asm volatile("" : "+s"(bar));
        unsigned bx_; asm volatile("s_getreg_b32 %0, hwreg(20, 0, 4)" : "=s"(bx_));
        bx_ &= 0xFu;
        __builtin_amdgcn_s_waitcnt(0);
        unsigned nloc = b.st[0], nx = b.st[1];
        if (nloc == 0u) { xcd_barrier_complete(bar, bx_, nloc, nx); b.st[0] = nloc; b.st[1] = nx; }
        const unsigned old = xb_add(&bar[XB_XSUB(bx_)], 1u);
        const unsigned gen = old / nloc;
        if (old + 1u == (gen + 1u) * nloc) {
            __builtin_amdgcn_fence(__ATOMIC_RELEASE, "agent");
            asm volatile("s_waitcnt vmcnt(0)" ::: "memory");
            const unsigned og = xb_add(&bar[XB_TOP], 1u);
            const unsigned tg = og / nx;
            if (og + 1u == (tg + 1u) * nx) xb_add(&bar[XB_TOPGEN], 1u);
            else XB_SPIN(xb_ld(&bar[XB_TOPGEN]) == tg, bar);
            __builtin_amdgcn_fence(__ATOMIC_ACQUIRE, "agent");
            xb_add(&bar[XB_XGEN(bx_)], 1u);
            asm volatile("s_waitcnt vmcnt(0)" ::: "memory");
        } else {
            XB_SPIN(xb_ld(&bar[XB_XGEN(bx_)]) == gen, bar);
            __builtin_amdgcn_fence(__ATOMIC_ACQUIRE, "agent");
            asm volatile("s_waitcnt vmcnt(0)" ::: "memory");
        }
    }
    __syncthreads();
}

__device__ __forceinline__ void xcd_barrier(const XcdBarrier& b) { for (int r = 0; r < REP_BAR; ++r) xcd_barrier1(b); }
namespace pg8 {
constexpr int BM = 256, BK = 64, HALF = 128, HTB = HALF * BK * 2, NXCD = 8, WGM = 8;
__host__ __device__ __forceinline__ int lds_byte(int r, int c) { const int st = (r >> 4) * 2 + (c >> 5), rr = r & 15, cc = c & 31, ob = rr * 64 + cc * 2; return st * 1024 + (ob ^ (((ob >> 9) & 1) << 5)); }
__host__ __device__ __forceinline__ void stage_rc(int b, int& R, int& C) { const int st = b / 1024, sb = b % 1024, swz = sb ^ (((sb >> 9) & 1) << 5); R = (st >> 1) * 16 + swz / 64; C = (st & 1) * 32 + (swz % 64) / 2; }
__host__ __device__ __forceinline__ int perm32(int rho) { const int n = rho >> 4, i = rho & 15; return 8 * (i >> 2) + 4 * n + (i & 3); }
struct Unit { int pm, pn, kt0, nkt; };
struct Gemm { const void* A; const void* Bt; int lda, ldb, K, acs; };
struct StaticOrder {
    int nM, nN, nwg, G, c, S, ntk, i0 = 0, dpm = -1, dpn = 0; bool same = false;
    __device__ __forceinline__ void init(int nM_, int nN_, int G_, int c_, int S_ = 0, int ntk_ = 0) { asm volatile("" : "+s"(G_), "+s"(c_)); nM = nM_; nN = nN_; nwg = nM * nN; G = G_; c = c_; S = S_; ntk = ntk_; }
    __device__ __forceinline__ bool next(int i, Unit& u) const {
        if (dpm >= 0) { u.pm = dpm; u.pn = dpn; u.kt0 = 0; u.nkt = ntk; return i == 0; }
        const long L = (long)(i + i0) * G + c;
        const bool is_main = L < nwg;
        const int s = (int)(L - nwg), Sd = S > 0 ? S : 1;
        if (!is_main && s >= nN * S) return false;
        int wgid = is_main ? (int)L : 0; { const int q = nwg / NXCD, r = nwg % NXCD, xcd = wgid % NXCD, off = wgid / NXCD; wgid = (xcd < r ? xcd * (q + 1) : r * (q + 1) + (xcd - r) * q) + off; }
        const int nig = WGM * nN, gid = wgid / nig, fm = gid * WGM, gsz = (nM - fm) < WGM ? (nM - fm) : WGM;
        const int nks = ntk / Sd;
        u.pm = is_main ? fm + ((wgid % nig) % gsz) : 32; u.pn = is_main ? (wgid % nig) / gsz : s % nN;
        u.kt0 = is_main ? 0 : (s / nN) * nks; u.nkt = is_main ? ntk : nks; if (same) { u.pm = 0; u.pn = 0; } return true;
    }
};
template <class Epi, int MODE = 0  >
__device__ __forceinline__ void gemm_phase(LAS unsigned char* lds, const Gemm g, const StaticOrder& S, const Epi& E, int wave0, unsigned* gate = nullptr, unsigned need = 0u) {
    const int tid = fresh_tid(wave0);
    const int wid = __builtin_amdgcn_readfirstlane(tid >> 6), lane = tid & 63, wr = wid >> 2, wc = wid & 3, fr = lane & 15, fq = lane >> 4;
    int K = g.K, lda_ = g.lda, ldb_ = g.ldb; asm volatile("" : "+s"(K), "+s"(lda_), "+s"(ldb_));
    unsigned voffA[2], voffB[2];
#pragma unroll
    for (int i = 0; i < 2; ++i) { int R, C; stage_rc(tid * 16 + i * 8192, R, C); const int Rb = (R & ~31) + perm32(R & 31);
        voffA[i] = (unsigned)(R * lda_ + C * 2); voffB[i] = (unsigned)(Rb * ldb_ + C * 2); }
    const size_t kstep = (size_t)(BK * 2);
    const size_t hstepA = (size_t)HALF * lda_, hstepB = (size_t)HALF * ldb_;
    const size_t tstepA = 2 * hstepA, tstepB = 2 * hstepB;
    const unsigned ldsw = (unsigned)wid * 1024u;
    const int aoff = lds_byte(wr * 64 + fr, fq * 8), boff = lds_byte(wc * 32 + fr, fq * 8);
#define PG8_SA(b, h) (((b) * 2 + (h)) * HTB)
#define PG8_SB(b, h) ((4 + (b) * 2 + (h)) * HTB)
#define PG8_STAGE(bufoff, gbase, voff) do { _Pragma("unroll") for (int _i = 0; _i < 2; ++_i) \
        __builtin_amdgcn_global_load_lds((const GAS unsigned*)((gbase) + (voff)[_i]), (LAS unsigned*)(lds + (bufoff) + ldsw + _i * 8192), 16, 0, 0); } while (0)
#define PG8_LDA(dst, b, h) do { _Pragma("unroll") for (int m = 0; m < 4; ++m) _Pragma("unroll") for (int k = 0; k < 2; ++k) dst[m][k] = *(const LAS bf16x8*)(lds + PG8_SA(b, h) + aoff + m * 2048 + k * 1024); } while (0)
#define PG8_LDB(dst, b, h) do { _Pragma("unroll") for (int n = 0; n < 2; ++n) _Pragma("unroll") for (int k = 0; k < 2; ++k) dst[n][k] = *(const LAS bf16x8*)(lds + PG8_SB(b, h) + boff + n * 2048 + k * 1024); } while (0)
#define PG8_MMA(ai, bj, At, Bt) do { __builtin_amdgcn_s_setprio(1); _Pragma("unroll") for (int m = 0; m < 4; ++m) _Pragma("unroll") for (int n = 0; n < 2; ++n) { \
        if constexpr (MODE == 2) { typedef int v4i_ __attribute__((ext_vector_type(4))); \
            _Pragma("unroll") for (int k = 0; k < 2; ++k) acc[ai][bj][m][n] = __builtin_bit_cast(f32x4, __builtin_amdgcn_mfma_i32_16x16x64_i8(__builtin_bit_cast(v4i_, Bt[n][k]), __builtin_bit_cast(v4i_, At[m][k]), __builtin_bit_cast(v4i_, acc[ai][bj][m][n]), 0, 0, 0)); \
        } else if constexpr (MODE == 1) { typedef int v8i_ __attribute__((ext_vector_type(8))); typedef int v4i_ __attribute__((ext_vector_type(4))); \
            const v4i_ b0_ = __builtin_bit_cast(v4i_, Bt[n][0]), b1_ = __builtin_bit_cast(v4i_, Bt[n][1]), a0_ = __builtin_bit_cast(v4i_, At[m][0]), a1_ = __builtin_bit_cast(v4i_, At[m][1]); \
            const v8i_ bb_ = {b0_[0], b0_[1], b0_[2], b0_[3], b1_[0], b1_[1], b1_[2], b1_[3]}, aa_ = {a0_[0], a0_[1], a0_[2], a0_[3], a1_[0], a1_[1], a1_[2], a1_[3]}; \
            acc[ai][bj][m][n] = __builtin_amdgcn_mfma_scale_f32_16x16x128_f8f6f4(bb_, aa_, acc[ai][bj][m][n], 0, 0, 0, 0x7f7f7f7f, 0, 0x7f7f7f7f); \
        } else { _Pragma("unroll") for (int k = 0; k < 2; ++k) acc[ai][bj][m][n] = __builtin_amdgcn_mfma_f32_16x16x32_bf16(Bt[n][k], At[m][k], acc[ai][bj][m][n], 0, 0, 0); } } \
        __builtin_amdgcn_s_setprio(0); } while (0)
#define PG8_WAIT_V(n) asm volatile("s_waitcnt vmcnt(" #n ")" ::: "memory")
#define PG8_WAIT_L(n) asm volatile("s_waitcnt lgkmcnt(" #n ")" ::: "memory")
#define PG8_BAR __builtin_amdgcn_s_barrier()
#define PG8_SCHED __builtin_amdgcn_sched_barrier(0)
    Unit cur, nxt; int ui = 0;
    if (!S.next(0, cur)) return;
    f32x4 acc[2][2][4][2];
#pragma unroll
    for (int a = 0; a < 2; ++a)
#pragma unroll
        for (int b = 0; b < 2; ++b)
#pragma unroll
            for (int m = 0; m < 4; ++m)
#pragma unroll
                for (int n = 0; n < 2; ++n) acc[a][b][m][n] = (f32x4){0.f, 0.f, 0.f, 0.f};
    bf16x8 At[4][2], B0[2][2], B1[2][2];
    const GAS char* cA = (const GAS char*)g.A + (size_t)cur.pm * tstepA + (size_t)cur.pn * g.acs + (size_t)cur.kt0 * kstep; const GAS char* cB = (const GAS char*)g.Bt + (size_t)cur.pn * tstepB + (size_t)cur.kt0 * kstep;
    PG8_STAGE(PG8_SB(0, 0), cB, voffB); PG8_STAGE(PG8_SB(0, 1), cB + hstepB, voffB); PG8_STAGE(PG8_SA(0, 0), cA, voffA); PG8_STAGE(PG8_SA(0, 1), cA + hstepA, voffA);
    if (wr == 1) PG8_BAR;
    PG8_WAIT_V(2); PG8_BAR;
    PG8_STAGE(PG8_SB(1, 0), cB + kstep, voffB); PG8_STAGE(PG8_SA(1, 0), cA + kstep, voffA); PG8_STAGE(PG8_SB(1, 1), cB + hstepB + kstep, voffB);
    PG8_WAIT_V(6); PG8_BAR;
    for (;;) {
        const bool has_next = S.next(ui + 1, nxt);
        const GAS char* nA = has_next ? (const GAS char*)g.A + (size_t)nxt.pm * tstepA + (size_t)nxt.pn * g.acs + (size_t)nxt.kt0 * kstep : cA; const GAS char* nB = has_next ? (const GAS char*)g.Bt + (size_t)nxt.pn * tstepB + (size_t)nxt.kt0 * kstep : cB;
        const int nt = cur.nkt;
        for (int t = 0; t < nt; t += 2) {
            asm volatile("" : "+v"(voffA[0]), "+v"(voffA[1]), "+v"(voffB[0]), "+v"(voffB[1]));
            const bool last = (t == nt - 2);
            const GAS char* a1 = cA + (size_t)(t + 1) * kstep;
            const GAS char* a2 = last ? nA : cA + (size_t)(t + 2) * kstep; const GAS char* b2 = last ? nB : cB + (size_t)(t + 2) * kstep;
            const GAS char* a3 = a2 + kstep; const GAS char* b3 = b2 + kstep;
            PG8_LDB(B0, 0, 0); PG8_LDB(B1, 0, 1); PG8_SCHED; PG8_LDA(At, 0, 0); PG8_STAGE(PG8_SA(1, 1), a1 + hstepA, voffA);
            PG8_WAIT_V(8); PG8_WAIT_L(0); PG8_BAR; PG8_MMA(0, 0, At, B0); PG8_MMA(0, 1, At, B1); PG8_BAR; PG8_SCHED;
            PG8_LDA(At, 0, 1); PG8_STAGE(PG8_SB(0, 0), b2, voffB); PG8_STAGE(PG8_SB(0, 1), b2 + hstepB, voffB); PG8_STAGE(PG8_SA(0, 0), a2, voffA);
            PG8_WAIT_V(8); PG8_WAIT_L(0); PG8_BAR; PG8_MMA(1, 0, At, B0); PG8_MMA(1, 1, At, B1); PG8_BAR; PG8_SCHED;
            PG8_LDB(B0, 1, 0); PG8_LDB(B1, 1, 1); PG8_SCHED; PG8_LDA(At, 1, 0); PG8_STAGE(PG8_SA(0, 1), a2 + hstepA, voffA);
            PG8_WAIT_V(8); PG8_WAIT_L(0); PG8_BAR; PG8_MMA(0, 0, At, B0); PG8_MMA(0, 1, At, B1); PG8_BAR; PG8_SCHED;
            PG8_LDA(At, 1, 1); PG8_STAGE(PG8_SB(1, 0), b3, voffB); PG8_STAGE(PG8_SB(1, 1), b3 + hstepB, voffB); PG8_STAGE(PG8_SA(1, 0), a3, voffA);
            PG8_WAIT_V(8); PG8_WAIT_L(0); PG8_BAR; PG8_MMA(1, 0, At, B0); PG8_MMA(1, 1, At, B1); PG8_BAR; PG8_SCHED;
        }
        if (wr == 0) PG8_BAR;
        if (gate != nullptr && ui == 0) {
            if (wid == 0) {
                unsigned sp = 0u; while (xb_ld(gate) < need) { __builtin_amdgcn_s_sleep(2); if (++sp > XB_SPIN_CAP) break; }
                __builtin_amdgcn_fence(__ATOMIC_ACQUIRE, "agent"); asm volatile("s_waitcnt vmcnt(0)" ::: "memory");
            }
            asm volatile("" ::: "memory"); PG8_BAR; asm volatile("" ::: "memory");
        }
        { int fr2 = fr, fq2 = fq; asm volatile("" : "+v"(fr2), "+v"(fq2));
          E(acc, cur, wr, wc, fr2, fq2); }
        if (!has_next) break;
#pragma unroll
        for (int a = 0; a < 2; ++a)
#pragma unroll
            for (int b = 0; b < 2; ++b)
#pragma unroll
                for (int m = 0; m < 4; ++m)
#pragma unroll
                    for (int n = 0; n < 2; ++n) acc[a][b][m][n] = (f32x4){0.f, 0.f, 0.f, 0.f};
        cur = nxt; cA = nA; cB = nB; ++ui;
        if (wr == 1) PG8_BAR;
    }
    PG8_WAIT_V(0);
    PG8_BAR;
#undef PG8_SA
#undef PG8_SB
#undef PG8_STAGE
#undef PG8_LDA
#undef PG8_LDB
#undef PG8_MMA
#undef PG8_WAIT_V
#undef PG8_WAIT_L
#undef PG8_BAR
#undef PG8_SCHED
}

template <int IN  , bool OUT8> struct EpiUpT {
    void* ACT; const float* sumsq; float inq;
    __device__ __forceinline__ void operator()(const f32x4 (&acc)[2][2][4][2], const Unit& u, int wr, int wc, int fr, int fq) const {
        const int row0 = u.pm * BM + wr * 64 + fr, col0 = u.pn * 128 + wc * 32 + 8 * fq;
        float rs[2][4];
#pragma unroll
        for (int ai = 0; ai < 2; ++ai)
#pragma unroll
            for (int m = 0; m < 4; ++m) rs[ai][m] = sumsq[row0 + ai * HALF + m * 16];
#pragma unroll
        for (int ai = 0; ai < 2; ++ai)
#pragma unroll
            for (int m = 0; m < 4; ++m) {
                const int row = row0 + ai * HALF + m * 16;
                const float r = __builtin_amdgcn_rsqf(rs[ai][m] * (1.0f / DM) + EPS) * (IN == 2 ? inq : 1.0f);
                const float rg = r * -LOG2E, ru = r * ((OUT8 ? S8_ACT : 1.0f) * (-1.0f / LOG2E));
                float o[8];
#pragma unroll
                for (int n = 0; n < 2; ++n)
#pragma unroll
                    for (int j = 0; j < 4; j += 2) {
                        f32x2 gi, ui;
                        gi[0] = (IN == 2 ? (float)__float_as_int(acc[ai][0][m][n][j]) : acc[ai][0][m][n][j]); gi[1] = (IN == 2 ? (float)__float_as_int(acc[ai][0][m][n][j + 1]) : acc[ai][0][m][n][j + 1]);
                        ui[0] = (IN == 2 ? (float)__float_as_int(acc[ai][1][m][n][j]) : acc[ai][1][m][n][j]); ui[1] = (IN == 2 ? (float)__float_as_int(acc[ai][1][m][n][j + 1]) : acc[ai][1][m][n][j + 1]);
                        const f32x2 t = gi * rg, us = ui * ru, p = t * us;
                        f32x2 e; e[0] = fast_exp2(t[0]); e[1] = fast_exp2(t[1]);
                        const f32x2 d = e + 1.0f;
                        f32x2 rc; rc[0] = fast_rcp(d[0]); rc[1] = fast_rcp(d[1]);
                        const f32x2 o2 = p * rc;
                        o[n * 4 + j] = o2[0]; o[n * 4 + j + 1] = o2[1];
                    }
                if constexpr (OUT8) { u32x2 w; w.x = pk_fp8x4(o[0], o[1], o[2], o[3]); w.y = pk_fp8x4(o[4], o[5], o[6], o[7]);
                    __builtin_nontemporal_store(w, (u32x2*)((unsigned char*)ACT + (size_t)row * FF + col0)); }
                else { u32x4 w; w.x = cvt_pk_bf16(o[0], o[1]); w.y = cvt_pk_bf16(o[2], o[3]); w.z = cvt_pk_bf16(o[4], o[5]); w.w = cvt_pk_bf16(o[6], o[7]);
                    __builtin_nontemporal_store(w, (u32x4*)((bf16_t*)ACT + (size_t)row * FF + col0)); }
            }
    }
};
struct EpiRes {
    const float* base; float* out; bf16_t* XN; float* PART; float alpha_; float* SLAB; unsigned char* XN8 = nullptr; float sqx = 1.f;
    __device__ __forceinline__ void operator()(const f32x4 (&acc)[2][2][4][2], const Unit& u, int wr, int wc, int fr, int fq) const {
        const int col0 = u.pn * BM + wc * 32 + 8 * fq;
        const float alpha = alpha_;
        if (u.pm == 32) {
            if (wr == 0) {
                float* sl = SLAB + (size_t)(u.kt0 / u.nkt) * (MS * DM);
#pragma unroll
                for (int m = 0; m < 2; ++m)
#pragma unroll
                    for (int bj = 0; bj < 2; ++bj)
#pragma unroll
                        for (int n = 0; n < 2; ++n) *(f32x4*)(sl + (size_t)(m * 16 + fr) * DM + col0 + bj * HALF + n * 4) = acc[0][bj][m][n];
            }
            return;
        }
        const int row0 = u.pm * BM + wr * 64 + fr;
#pragma unroll
        for (int ai = 0; ai < 2; ++ai) {
            f32x4 bv[4][2][2];
#pragma unroll
            for (int m = 0; m < 4; ++m)
#pragma unroll
                for (int bj = 0; bj < 2; ++bj) { const float* bp = base + (size_t)(row0 + ai * HALF + m * 16) * DM + col0 + bj * HALF; bv[m][bj][0] = *(const f32x4*)bp; bv[m][bj][1] = *(const f32x4*)(bp + 4); }
#pragma unroll
            for (int m = 0; m < 4; ++m) {
                const int row = row0 + ai * HALF + m * 16; const size_t off = (size_t)row * DM + col0;
                float ss = 0.f;
#pragma unroll
                for (int bj = 0; bj < 2; ++bj) {
                    const f32x4 v0 = bv[m][bj][0] + acc[ai][bj][m][0] * alpha, v1 = bv[m][bj][1] + acc[ai][bj][m][1] * alpha;
                    *(f32x4*)(out + off + bj * HALF) = v0; *(f32x4*)(out + off + bj * HALF + 4) = v1;
                    if (XN8) { u32x2 w8; w8.x = pk_i8x4(v0[0] * sqx, v0[1] * sqx, v0[2] * sqx, v0[3] * sqx); w8.y = pk_i8x4(v1[0] * sqx, v1[1] * sqx, v1[2] * sqx, v1[3] * sqx);
                        *(u32x2*)(XN8 + off + bj * HALF) = w8; }
                    else { u32x4 w; w.x = cvt_pk_bf16(v0[0], v0[1]); w.y = cvt_pk_bf16(v0[2], v0[3]); w.z = cvt_pk_bf16(v1[0], v1[1]); w.w = cvt_pk_bf16(v1[2], v1[3]);
                        *(u32x4*)(XN + off + bj * HALF) = w; }
                    ss += (v0[0] * v0[0] + v0[1] * v0[1]) + (v0[2] * v0[2] + v0[3] * v0[3]) + (v1[0] * v1[0] + v1[1] * v1[1]) + (v1[2] * v1[2] + v1[3] * v1[3]);
                }
                ss = sum_x32(sum_x16(ss));
                if (fq == 0) PART[(size_t)row * 32 + u.pn * 4 + wc] = ss;
            }
            asm volatile("" ::: "memory");
        }
    }
};
struct EpiInEven {
    const float* sumsq; bf16_t *Q, *Kb, *V, *AU, *AV; float* dout; const float *qg, *kg; float* avsq; LAS float* red;
    __device__ __forceinline__ void operator()(const f32x4 (&acc)[2][2][4][2], const Unit& u, int wr, int wc, int fr, int fq) const {
        const int seg = u.pn >> 2, ct = (u.pn & 3) * BM;
        const int row0 = u.pm * BM + wr * 64 + fr, cw = wc * 32 + 8 * fq;
        float rs[2][4];
#pragma unroll
        for (int ai = 0; ai < 2; ++ai)
#pragma unroll
            for (int m = 0; m < 4; ++m) rs[ai][m] = __builtin_amdgcn_rsqf(sumsq[row0 + ai * HALF + m * 16] * (1.0f / DM) + EPS);
        if (seg < 2) {
#pragma unroll
            for (int ai = 0; ai < 2; ++ai)
#pragma unroll
                for (int m = 0; m < 4; ++m)
#pragma unroll
                    for (int bj = 0; bj < 2; ++bj) {
                        const f32x4 a = acc[ai][bj][m][0], b = acc[ai][bj][m][1];
                        float s = (a[0] * a[0] + a[1] * a[1]) + (a[2] * a[2] + a[3] * a[3]) + (b[0] * b[0] + b[1] * b[1]) + (b[2] * b[2] + b[3] * b[3]);
                        s = sum_x32(sum_x16(s));
                        if (fq == 0) red[((ai * HALF + wr * 64 + m * 16 + fr) * 2 + bj) * 4 + wc] = s;
                    }
            LDS_WAIT(); __builtin_amdgcn_s_barrier(); asm volatile("" ::: "memory");
            const float* gn = seg == 0 ? qg : kg;
            f32x4 g0 = *(const f32x4*)(gn + cw), g1 = *(const f32x4*)(gn + cw + 4);
            if (seg == 0) { g0 = g0 * QSCALE; g1 = g1 * QSCALE; }
            bf16_t* dst = seg == 0 ? Q : Kb;
#pragma unroll
            for (int ai = 0; ai < 2; ++ai)
#pragma unroll
                for (int m = 0; m < 4; ++m) {
                    const int row = row0 + ai * HALF + m * 16; const float r = rs[ai][m];
#pragma unroll
                    for (int bj = 0; bj < 2; ++bj) {
                        const f32x4 p = *(const LAS f32x4*)(red + ((ai * HALF + wr * 64 + m * 16 + fr) * 2 + bj) * 4);
                        const float ms = ((p[0] + p[1]) + (p[2] + p[3])) * r * r * (1.0f / HD);
                        const float sc = r * __builtin_amdgcn_rsqf(ms + EPS);
                        const f32x4 v0 = acc[ai][bj][m][0] * sc * g0, v1 = acc[ai][bj][m][1] * sc * g1;
                        const int col = ct + bj * HALF + cw;
                        u32x4 w; w.x = cvt_pk_bf16(v0[0], v0[1]); w.y = cvt_pk_bf16(v0[2], v0[3]); w.z = cvt_pk_bf16(v1[0], v1[1]); w.w = cvt_pk_bf16(v1[2], v1[3]);
                        *(u32x4*)(dst + (size_t)row * 1024 + col) = w;
                        if (seg == 1 && row < MP + MS) {
                            float* o = dout + (row < MP ? O_KP + (size_t)row * 1024 : O_KS + (size_t)(row - MP) * 1024) + col;
                            __builtin_nontemporal_store(v0, (f32x4*)o); __builtin_nontemporal_store(v1, (f32x4*)(o + 4));
                        }
                    }
                }
        } else if (seg == 2) {
#pragma unroll
            for (int ai = 0; ai < 2; ++ai)
#pragma unroll
                for (int m = 0; m < 4; ++m) {
                    const int row = row0 + ai * HALF + m * 16; const float r = rs[ai][m];
#pragma unroll
                    for (int bj = 0; bj < 2; ++bj) {
                        const f32x4 v0 = acc[ai][bj][m][0] * r, v1 = acc[ai][bj][m][1] * r;
                        const int col = ct + bj * HALF + cw;
                        u32x4 w; w.x = cvt_pk_bf16(v0[0], v0[1]); w.y = cvt_pk_bf16(v0[2], v0[3]); w.z = cvt_pk_bf16(v1[0], v1[1]); w.w = cvt_pk_bf16(v1[2], v1[3]);
                        *(u32x4*)(V + (size_t)row * 1024 + col) = w;
                        if (row < MP + MS) {
                            float* o = dout + (row < MP ? O_VP + (size_t)row * 1024 : O_VS + (size_t)(row - MP) * 1024) + col;
                            __builtin_nontemporal_store(v0, (f32x4*)o); __builtin_nontemporal_store(v1, (f32x4*)(o + 4));
                        }
                    }
                }
        } else {
            bf16_t* dst = seg == 3 ? AU : AV;
#pragma unroll
            for (int ai = 0; ai < 2; ++ai)
#pragma unroll
                for (int m = 0; m < 4; ++m) {
                    const int row = row0 + ai * HALF + m * 16; const float r = rs[ai][m];
                    float ss = 0.f;
#pragma unroll
                    for (int bj = 0; bj < 2; ++bj) {
                        float o[8];
#pragma unroll
                        for (int n = 0; n < 2; ++n)
#pragma unroll
                            for (int j = 0; j < 4; ++j) { o[n * 4 + j] = gelu_tanh(acc[ai][bj][m][n][j] * r); ss += o[n * 4 + j] * o[n * 4 + j]; }
                        const int col = ct + bj * HALF + cw;
                        u32x4 w; w.x = cvt_pk_bf16(o[0], o[1]); w.y = cvt_pk_bf16(o[2], o[3]); w.z = cvt_pk_bf16(o[4], o[5]); w.w = cvt_pk_bf16(o[6], o[7]);
                        *(u32x4*)(dst + (size_t)row * 1024 + col) = w;
                    }
                    if (seg == 4) { ss = sum_x32(sum_x16(ss)); if (fq == 0) atomicAdd(avsq + row, ss); }
                }
        }
    }
};
struct EpiInOdd {
    const float* sumsq; bf16_t *XC, *GB, *G; float* dout; float* SP;
    __device__ __forceinline__ void operator()(const f32x4 (&acc)[2][2][4][2], const Unit& u, int wr, int wc, int fr, int fq) const {
        const int row0 = u.pm * BM + wr * 64 + fr, cw = wc * 32 + 8 * fq;
        if (u.pm == 32) {
            if (wr == 0) {
                float* sl = SP + (size_t)(u.kt0 / u.nkt) * (MS * 4096);
#pragma unroll
                for (int m = 0; m < 2; ++m)
#pragma unroll
                    for (int bj = 0; bj < 2; ++bj)
#pragma unroll
                        for (int n = 0; n < 2; ++n) *(f32x4*)(sl + (size_t)(m * 16 + fr) * 4096 + u.pn * BM + bj * HALF + cw + n * 4) = acc[0][bj][m][n];
            }
            return;
        }
        if (u.pn < 8) {
            const int ct = (u.pn & 3) * BM; bf16_t* dst = u.pn < 4 ? XC : GB;
#pragma unroll
            for (int ai = 0; ai < 2; ++ai)
#pragma unroll
                for (int m = 0; m < 4; ++m) {
                    const int row = row0 + ai * HALF + m * 16; const float r = __builtin_amdgcn_rsqf(sumsq[row] * (1.0f / DM) + EPS);
#pragma unroll
                    for (int bj = 0; bj < 2; ++bj) {
                        const f32x4 v0 = acc[ai][bj][m][0] * r, v1 = acc[ai][bj][m][1] * r;
                        const int col = ct + bj * HALF + cw;
                        u32x4 w; w.x = cvt_pk_bf16(v0[0], v0[1]); w.y = cvt_pk_bf16(v0[2], v0[3]); w.z = cvt_pk_bf16(v1[0], v1[1]); w.w = cvt_pk_bf16(v1[2], v1[3]);
                        *(u32x4*)(dst + (size_t)row * 1024 + col) = w;
                        if (u.pn < 4) {
                            float* o = nullptr;
                            if (row < MP) { const int t = row & (SEQ - 1); if (t >= SEQ - 15) o = dout + O_PP + ((size_t)(row >> 11) * 15 + (t - (SEQ - 15))) * 1024 + col; }
                            else if (row < MP + MS) { const int sr = row - MP; o = dout + O_PS + ((size_t)(sr >> 2) * 15 + 11 + (sr & 3)) * 1024 + col; }
                            if (o) { *(f32x4*)o = v0; *(f32x4*)(o + 4) = v1; }
                        }
                    }
                }
        } else {
            const int col = (u.pn - 8) * 128 + cw;
#pragma unroll
            for (int ai = 0; ai < 2; ++ai)
#pragma unroll
                for (int m = 0; m < 4; ++m) {
                    const int row = row0 + ai * HALF + m * 16; const float r = __builtin_amdgcn_rsqf(sumsq[row] * (1.0f / DM) + EPS); const float r2 = r * r;
                    const f32x4 v0 = acc[ai][0][m][0] * acc[ai][1][m][0] * r2, v1 = acc[ai][0][m][1] * acc[ai][1][m][1] * r2;
                    u32x4 w; w.x = cvt_pk_bf16(v0[0], v0[1]); w.y = cvt_pk_bf16(v0[2], v0[3]); w.z = cvt_pk_bf16(v1[0], v1[1]); w.w = cvt_pk_bf16(v1[2], v1[3]);
                    *(u32x4*)(G + (size_t)row * 1024 + col) = w;
                    float* o = nullptr;
                    if (row < MP) { const int t = row & (SEQ - 1); if (t >= SEQ - 2) o = dout + O_CP + ((size_t)(row >> 11) * 2 + (t - (SEQ - 2))) * 1024 + col; }
                    else if (row < MP + MS) { const int sr = row - MP; if ((sr & 3) >= 2) o = dout + O_CS + ((size_t)(sr >> 2) * 2 + ((sr & 3) - 2)) * 1024 + col; }
                    if (o) { *(f32x4*)o = v0; *(f32x4*)(o + 4) = v1; }
                }
        }
    }
};
struct EpiPool {
    bf16_t* MIX; const float* cscale;
    __device__ __forceinline__ void operator()(const f32x4 (&acc)[2][2][4][2], const Unit& u, int wr, int wc, int fr, int fq) const {
        const int row0 = u.pm * BM + wr * 64 + fr, col0 = u.pn * BM + wc * 32 + 8 * fq;
#pragma unroll
        for (int bj = 0; bj < 2; ++bj) {
            const f32x4 s0 = *(const f32x4*)(cscale + col0 + bj * HALF), s1 = *(const f32x4*)(cscale + col0 + bj * HALF + 4);
#pragma unroll
            for (int ai = 0; ai < 2; ++ai)
#pragma unroll
                for (int m = 0; m < 4; ++m) {
                    const int row = row0 + ai * HALF + m * 16;
                    const f32x4 v0 = acc[ai][bj][m][0] * s0, v1 = acc[ai][bj][m][1] * s1;
                    u32x4 w; w.x = cvt_pk_bf16(v0[0], v0[1]); w.y = cvt_pk_bf16(v0[2], v0[3]); w.z = cvt_pk_bf16(v1[0], v1[1]); w.w = cvt_pk_bf16(v1[2], v1[3]);
                    *(u32x4*)(MIX + (size_t)row * DM + col0 + bj * HALF) = w;
                }
        }
    }
};
}

namespace sba {
constexpr int SHM_K = 64 * 128 * 2, SHM_V = SHM_K;
#define KSWZ(row, colB) ((row) * 256 + ((colB) ^ (((row) & 7) << 4)))
#define SBAR() __builtin_amdgcn_sched_barrier(0)
__device__ __forceinline__ int crow(int r, int hi) { return (r & 3) + 8 * (r >> 2) + 4 * hi; }
__device__ __forceinline__ int v_st(int k, int c) { const int kk = (k & ~0xC) | ((k & 4) << 1) | ((k & 8) >> 1); return ((kk >> 3) * 4 + (c >> 5)) * 512 + ((kk & 7) * 32 + (c & 31)) * 2; }
__device__ __forceinline__ int v_rd_base(int lane) { return ((lane & 3) << 3) | (((lane >> 2) & 3) << 6) | (((lane >> 4) & 1) << 5) | (((lane >> 5) & 1) << 8); }
constexpr int v_rd_off(int d0, int ks, int half) { return d0 * 512 + ks * 4096 + half * 2048; }
template <int OFF> __device__ __forceinline__ s16x4 tr_read(int vb) {
    s16x4 r; asm volatile("ds_read_b64_tr_b16 %0, %1 offset:%2" : "=&v"(r) : "v"(vb), "i"(OFF) : "memory"); return r;
}
template <int D0> __device__ __forceinline__ void pv_one(f32x16& od, int vb, bf16x8 pa0, bf16x8 pa1, bf16x8 pa2, bf16x8 pa3) {
    const s16x4 l0 = tr_read<v_rd_off(D0, 0, 0)>(vb), h0 = tr_read<v_rd_off(D0, 0, 1)>(vb), l1 = tr_read<v_rd_off(D0, 1, 0)>(vb), h1 = tr_read<v_rd_off(D0, 1, 1)>(vb);
    const s16x4 l2 = tr_read<v_rd_off(D0, 2, 0)>(vb), h2 = tr_read<v_rd_off(D0, 2, 1)>(vb), l3 = tr_read<v_rd_off(D0, 3, 0)>(vb), h3 = tr_read<v_rd_off(D0, 3, 1)>(vb);
    asm volatile("s_waitcnt lgkmcnt(0)" ::: "memory"); SBAR();
#define PK(L, H) (bf16x8){L[0], L[1], L[2], L[3], H[0], H[1], H[2], H[3]}
    od = __builtin_amdgcn_mfma_f32_32x32x16_bf16(pa0, PK(l0, h0), od, 0, 0, 0);
    od = __builtin_amdgcn_mfma_f32_32x32x16_bf16(pa1, PK(l1, h1), od, 0, 0, 0);
    od = __builtin_amdgcn_mfma_f32_32x32x16_bf16(pa2, PK(l2, h2), od, 0, 0, 0);
    od = __builtin_amdgcn_mfma_f32_32x32x16_bf16(pa3, PK(l3, h3), od, 0, 0, 0);
#undef PK
}
__device__ __forceinline__ void qkt(f32x16& p0, f32x16& p1, const char* Ks, const bf16x8 (&qr)[8], int r32, int hi) {
    p0 = f32x16{}; p1 = f32x16{};
#pragma unroll
    for (int d0 = 0; d0 < 8; ++d0) { const int cb = (d0 * 16 + hi * 8) * 2;
        const bf16x8 b0 = *reinterpret_cast<const bf16x8*>(Ks + KSWZ(r32, cb));
        const bf16x8 b1 = *reinterpret_cast<const bf16x8*>(Ks + KSWZ(32 + r32, cb));
        p0 = __builtin_amdgcn_mfma_f32_32x32x16_bf16(b0, qr[d0], p0, 0, 0, 0);
        p1 = __builtin_amdgcn_mfma_f32_32x32x16_bf16(b1, qr[d0], p1, 0, 0, 0); }
}
__device__ __forceinline__ void sb_tile(f32x16& p0, f32x16& p1, float& C, float bias2, bool masked, int t, int k0, int hi) {
#pragma unroll
    for (int r = 0; r < 16; ++r) {
        float e0 = fast_exp2(p0[r] + bias2), e1 = fast_exp2(p1[r] + bias2);
        if (masked) { const int key = k0 + crow(r, hi); e0 = key < t ? e0 : 0.f; e1 = (key + 32) < t ? e1 : 0.f; }
        p0[r] = e0; p1[r] = e1;
    }
    float a[8], SA[9], PB[9];
#pragma unroll
    for (int j = 0; j < 4; ++j) {
        a[j] = ((1.f + p0[4 * j]) * (1.f + p0[4 * j + 1])) * ((1.f + p0[4 * j + 2]) * (1.f + p0[4 * j + 3]));
        a[4 + j] = ((1.f + p1[4 * j]) * (1.f + p1[4 * j + 1])) * ((1.f + p1[4 * j + 2]) * (1.f + p1[4 * j + 3]));
    }
    SA[8] = 1.f; PB[8] = 1.f;
#pragma unroll
    for (int j = 7; j >= 0; --j) SA[j] = SA[j + 1] * a[j];
#pragma unroll
    for (int j = 0; j < 8; ++j) PB[j] = xchg32(SA[j], hi);
#pragma unroll
    for (int j = 0; j < 8; ++j) {
        const float suf = C * SA[j + 1] * (hi ? PB[j + 1] : PB[j]);
        float inv = fast_rcp(suf * a[j]);
        if (j < 4) {
            const float e0 = p0[4 * j], e1 = p0[4 * j + 1], e2 = p0[4 * j + 2], e3 = p0[4 * j + 3];
            p0[4 * j] = e0 * inv; inv *= (1.f + e0); p0[4 * j + 1] = e1 * inv; inv *= (1.f + e1); p0[4 * j + 2] = e2 * inv; inv *= (1.f + e2); p0[4 * j + 3] = e3 * inv;
        } else {
            const int q = 4 * (j - 4);
            const float e0 = p1[q], e1 = p1[q + 1], e2 = p1[q + 2], e3 = p1[q + 3];
            p1[q] = e0 * inv; inv *= (1.f + e0); p1[q + 1] = e1 * inv; inv *= (1.f + e1); p1[q + 2] = e2 * inv; inv *= (1.f + e2); p1[q + 3] = e3 * inv;
        }
    }
    C = C * SA[0] * PB[0];
}
__device__ __forceinline__ void pack_p(const f32x16& p0, const f32x16& p1, bf16x8& pa0, bf16x8& pa1, bf16x8& pa2, bf16x8& pa3) {
#define PK4(P, BASE, OUT) do { unsigned a0 = cvt_pk_bf16(P[BASE + 0], P[BASE + 1]), a1 = cvt_pk_bf16(P[BASE + 2], P[BASE + 3]);   \
    unsigned b0 = cvt_pk_bf16(P[BASE + 4], P[BASE + 5]), b1 = cvt_pk_bf16(P[BASE + 6], P[BASE + 7]);                              \
    auto r0 = __builtin_amdgcn_permlane32_swap(a0, b0, false, false); auto r1 = __builtin_amdgcn_permlane32_swap(a1, b1, false, false); \
    u32x4 w = {r0[0], r1[0], r0[1], r1[1]}; OUT = *reinterpret_cast<bf16x8*>(&w); } while (0)
    PK4(p0, 0, pa0); PK4(p0, 8, pa1); PK4(p1, 0, pa2); PK4(p1, 8, pa3);
#undef PK4
}
__device__ __forceinline__ void attn_unit(const bf16_t* __restrict__ Qb, const bf16_t* __restrict__ Kh, const bf16_t* __restrict__ Vh, bf16_t* __restrict__ Ob, int q0, float bias2, char* lds, int wave0) {
    const int tid = fresh_tid(wave0);
    const int wid = tid >> 6, lane = tid & 63, r32 = lane & 31, hi = lane >> 5;
    char* V_lds = lds; char* K_lds = lds + 2 * SHM_V;
    f32x16 o[4] = {}; bf16x8 qr[8];
    const bf16_t* Qw = Qb + (size_t)(wid * 32 + r32) * 1024 + hi * 8;
#pragma unroll
    for (int d0 = 0; d0 < 8; ++d0) qr[d0] = *reinterpret_cast<const bf16x8*>(Qw + d0 * 16);
    const int sr = tid >> 4, sc = (tid & 15) * 8, vst0 = v_st(sr, sc), vst1 = v_st(32 + sr, sc);
    const int vb0 = (int)(uintptr_t)V_lds + v_rd_base(lane);
    const int NT = (q0 + 256) >> 6, kmax = q0 + 192, tw = q0 + wid * 32, t = tw + r32;
    float C = 1.f;
    bf16x8 vs0, vs1, ks0, ks1;
#define SLOAD(k0) do { vs0 = *reinterpret_cast<const bf16x8*>(Vh + (size_t)((k0) + sr) * 1024 + sc); vs1 = *reinterpret_cast<const bf16x8*>(Vh + (size_t)((k0) + 32 + sr) * 1024 + sc); \
    ks0 = *reinterpret_cast<const bf16x8*>(Kh + (size_t)((k0) + sr) * 1024 + sc); ks1 = *reinterpret_cast<const bf16x8*>(Kh + (size_t)((k0) + 32 + sr) * 1024 + sc); } while (0)
#define SWRITE(b) do { *(bf16x8*)(V_lds + (b) * SHM_V + vst0) = vs0; *(bf16x8*)(V_lds + (b) * SHM_V + vst1) = vs1; const int kc = sc * 2; \
    *(bf16x8*)(K_lds + (b) * SHM_K + KSWZ(sr, kc)) = ks0; *(bf16x8*)(K_lds + (b) * SHM_K + KSWZ(32 + sr, kc)) = ks1; } while (0)
    __syncthreads();
    SLOAD(kmax); SWRITE(0);
    for (int j = 0; j < NT; ++j) {
        __syncthreads();
        const int k0 = kmax - 64 * j, b = j & 1;
        if (j + 1 < NT) SLOAD(k0 - 64);
        if (k0 <= tw + 30) {
            f32x16 p0, p1; bf16x8 pa0, pa1, pa2, pa3;
            qkt(p0, p1, K_lds + b * SHM_K, qr, r32, hi);
            sb_tile(p0, p1, C, bias2, k0 + 63 >= tw, t, k0, hi);
            pack_p(p0, p1, pa0, pa1, pa2, pa3);
            const int vb = vb0 + b * SHM_V;
            pv_one<0>(o[0], vb, pa0, pa1, pa2, pa3); pv_one<1>(o[1], vb, pa0, pa1, pa2, pa3); pv_one<2>(o[2], vb, pa0, pa1, pa2, pa3); pv_one<3>(o[3], vb, pa0, pa1, pa2, pa3);
        }
        if (j + 1 < NT) SWRITE(b ^ 1);
    }
#undef SLOAD
#undef SWRITE
    bf16_t* Ow = Ob + (size_t)(wid * 32) * DM;
#pragma unroll
    for (int r = 0; r < 16; ++r) { const int orow = crow(r, hi);
#pragma unroll
        for (int d0 = 0; d0 < 4; ++d0) Ow[(size_t)orow * DM + d0 * 32 + r32] = (bf16_t)(cvt_pk_bf16(o[d0][r], 0.f) & 0xffffu); }
}
__device__ __forceinline__ void gate_unit(const bf16_t* __restrict__ AVb, const bf16_t* __restrict__ AUb, const bf16_t* __restrict__ AWS, const float* __restrict__ avsq,
                                          const float* __restrict__ avg, const float* __restrict__ abs_, bf16_t* __restrict__ MIX, int R0, int g, char* lds, int wave0) {
    const int tid = fresh_tid(wave0);
    const int wid = tid >> 6, lane = tid & 63, r32 = lane & 31, hi = lane >> 5, wp = wid & 3, wd = wid >> 2;
    char* V_lds = lds;
    const int sr = tid >> 4, sc = (tid & 15) * 8;
    __syncthreads();
#pragma unroll
    for (int q4 = 0; q4 < 4; ++q4) {
        const int row = q4 * 32 + sr;
        const u32x4 x = *reinterpret_cast<const u32x4*>(AVb + (size_t)(R0 + row) * 1024 + g * 128 + sc);
        const float rs = __builtin_amdgcn_rsqf(avsq[R0 + row] * (1.0f / AW) + EPS);
        u32x4 w; w.x = cvt_pk_bf16(bf_lo(x.x) * rs, bf_hi(x.x) * rs); w.y = cvt_pk_bf16(bf_lo(x.y) * rs, bf_hi(x.y) * rs);
        w.z = cvt_pk_bf16(bf_lo(x.z) * rs, bf_hi(x.z) * rs); w.w = cvt_pk_bf16(bf_lo(x.w) * rs, bf_hi(x.w) * rs);
        *(u32x4*)(V_lds + (row >> 6) * SHM_V + v_st(row & 63, sc)) = w;
    }
    __syncthreads();
    f32x16 o0 = {}, o1 = {};
    const int vb0 = (int)(uintptr_t)V_lds + v_rd_base(lane);
    const bf16_t* Wrow = AWS + (size_t)(g * 128 + wp * 32 + r32) * 128 + hi * 8;
#pragma unroll
    for (int tile = 0; tile < 2; ++tile) {
        if (tile == 1 && wp < 2) break;
        const bf16x8 pa0 = *reinterpret_cast<const bf16x8*>(Wrow + tile * 64), pa1 = *reinterpret_cast<const bf16x8*>(Wrow + tile * 64 + 16),
                     pa2 = *reinterpret_cast<const bf16x8*>(Wrow + tile * 64 + 32), pa3 = *reinterpret_cast<const bf16x8*>(Wrow + tile * 64 + 48);
        const int vb = vb0 + tile * SHM_V;
        if (wd == 0) { pv_one<0>(o0, vb, pa0, pa1, pa2, pa3); pv_one<1>(o1, vb, pa0, pa1, pa2, pa3); }
        else         { pv_one<2>(o0, vb, pa0, pa1, pa2, pa3); pv_one<3>(o1, vb, pa0, pa1, pa2, pa3); }
    }
#pragma unroll
    for (int r = 0; r < 16; ++r) {
        const int p = wp * 32 + crow(r, hi); const float bsv = abs_[g * 128 + p];
#pragma unroll
        for (int dd = 0; dd < 2; ++dd) {
            const int col = g * 128 + (wd * 2 + dd) * 32 + r32;
            const float acc = dd == 0 ? o0[r] : o1[r];
            const float mixv = acc * avg[col] + bsv;
            const float au = __uint_as_float((unsigned)AUb[(size_t)(R0 + p) * 1024 + col] << 16);
            MIX[(size_t)(R0 + p) * DM + col] = (bf16_t)(cvt_pk_bf16(au * mixv, 0.f) & 0xffffu);
        }
    }
}
}

constexpr int PTAB_OFF = MISC_OFF + 256;
__device__ __forceinline__ unsigned char* opaque_ptr(unsigned char* p) { asm volatile("" : "+s"(p)); return p; }
__device__ __forceinline__ const void* lds_ptr(volatile LAS unsigned* tab, int i) {
    const unsigned lo = __builtin_amdgcn_readfirstlane(tab[2 * i]), hi = __builtin_amdgcn_readfirstlane(tab[2 * i + 1]);
    return (const void*)(((unsigned long long)hi << 32) | lo);
}
struct Args { const void* in[24]; float* out; unsigned char* ws; };

__device__ __forceinline__ void ld8(const bf16_t* p, float (&o)[8]) { const u32x4 x = *(const u32x4*)p; o[0] = bf_lo(x.x); o[1] = bf_hi(x.x); o[2] = bf_lo(x.y); o[3] = bf_hi(x.y); o[4] = bf_lo(x.z); o[5] = bf_hi(x.z); o[6] = bf_lo(x.w); o[7] = bf_hi(x.w); }
__device__ __forceinline__ void sp_sum8(const float* __restrict__ SP, int r, int col, float (&o)[8]) {
    f32x4 a = {0.f, 0.f, 0.f, 0.f}, b = {0.f, 0.f, 0.f, 0.f};
#pragma unroll
    for (int s = 0; s < 8; ++s) { const float* p = SP + ((size_t)s * MS + r) * 4096 + col; a += *(const f32x4*)p; b += *(const f32x4*)(p + 4); }
    o[0] = a[0]; o[1] = a[1]; o[2] = a[2]; o[3] = a[3]; o[4] = b[0]; o[5] = b[1]; o[6] = b[2]; o[7] = b[3];
}
__device__ __forceinline__ float wave_sum(float v) {
    v = sum_x32(sum_x16(sum_row16(v)));
    return v;
}
__device__ __forceinline__ void tr_item(const float* __restrict__ W, int K, int N, const float* __restrict__ gain, bf16_t* __restrict__ WT, int kind, LAS float* scr, int item, int lane) {
    const int nblk = N / 32, kb = item / nblk, nb = item % nblk, k0 = 64 * kb, n0 = 32 * nb;
    int drow0 = n0;
    if (kind == 1) drow0 = 256 * (n0 >> 7) + (n0 & 127);
    else if (kind == 2) drow0 = 256 * (n0 >> 7) + 128 + (n0 & 127);
    else if (kind == 3) { if (n0 >= 3072) { const int j = n0 - 3072; drow0 = 2048 + 256 * (j >> 7) + 128 + (j & 127); } else if (n0 >= 2048) { const int j = n0 - 2048; drow0 = 2048 + 256 * (j >> 7) + (j & 127); } }
    {
        const int kr = lane >> 3, nc = (lane & 7) * 4;
        f32x4 v[8];
#pragma unroll
        for (int i = 0; i < 8; ++i) v[i] = __builtin_nontemporal_load((const f32x4*)(W + (size_t)(k0 + 8 * i + kr) * N + n0 + nc));
#pragma unroll
        for (int i = 0; i < 8; ++i) { const int kk = 8 * i + kr; f32x4 x = v[i]; if (gain) x = x * gain[k0 + kk];
            scr[kk * 33 + nc] = x[0]; scr[kk * 33 + nc + 1] = x[1]; scr[kk * 33 + nc + 2] = x[2]; scr[kk * 33 + nc + 3] = x[3]; }
    }
    LDS_WAIT(); asm volatile("" ::: "memory");
    const int c = lane & 7;
#pragma unroll
    for (int j = 0; j < 4; ++j) { const int n = (lane >> 3) + 8 * j; const LAS float* s = scr + (8 * c) * 33 + n;
        u32x4 o; o.x = cvt_pk_bf16(s[0 * 33], s[1 * 33]); o.y = cvt_pk_bf16(s[2 * 33], s[3 * 33]); o.z = cvt_pk_bf16(s[4 * 33], s[5 * 33]); o.w = cvt_pk_bf16(s[6 * 33], s[7 * 33]);
        *(u32x4*)(WT + (size_t)(drow0 + n) * K + k0 + 8 * c) = o; }
    LDS_WAIT(); asm volatile("" ::: "memory");
}

__device__ __forceinline__ void tr_item8(const float* __restrict__ W, int K, int N, const float* __restrict__ gain, unsigned char* __restrict__ WT8, int kind, LAS float* scr, int item, int lane, float scale, bool i8) {
    const int nblk = N / 32, kb = item / nblk, nb = item % nblk, k0 = 64 * kb, n0 = 32 * nb;
    int drow0 = n0;
    if (kind == 1) drow0 = 256 * (n0 >> 7) + (n0 & 127);
    else if (kind == 2) drow0 = 256 * (n0 >> 7) + 128 + (n0 & 127);
    {
        const int kr = lane >> 3, nc = (lane & 7) * 4;
        f32x4 v[8];
#pragma unroll
        for (int i = 0; i < 8; ++i) v[i] = __builtin_nontemporal_load((const f32x4*)(W + (size_t)(k0 + 8 * i + kr) * N + n0 + nc));
#pragma unroll
        for (int i = 0; i < 8; ++i) { const int kk = 8 * i + kr; const f32x4 x = v[i] * (gain ? gain[k0 + kk] * scale : scale);
            scr[kk * 33 + nc] = x[0]; scr[kk * 33 + nc + 1] = x[1]; scr[kk * 33 + nc + 2] = x[2]; scr[kk * 33 + nc + 3] = x[3]; }
    }
    LDS_WAIT(); asm volatile("" ::: "memory");
    const int c = lane & 7;
#pragma unroll
    for (int j = 0; j < 4; ++j) { const int n = (lane >> 3) + 8 * j; const LAS float* s = scr + (8 * c) * 33 + n;
        u32x2 o;
        if (i8) { o.x = pk_i8x4(s[0 * 33], s[1 * 33], s[2 * 33], s[3 * 33]); o.y = pk_i8x4(s[4 * 33], s[5 * 33], s[6 * 33], s[7 * 33]); }
        else    { o.x = pk_fp8x4(s[0 * 33], s[1 * 33], s[2 * 33], s[3 * 33]); o.y = pk_fp8x4(s[4 * 33], s[5 * 33], s[6 * 33], s[7 * 33]); }
        *(u32x2*)(WT8 + (size_t)(drow0 + n) * K + k0 + 8 * c) = o; }
    LDS_WAIT(); asm volatile("" ::: "memory");
}
__device__ __forceinline__ void unpack8(const u32x4& x, float (&o)[8]) { o[0] = bf_lo(x.x); o[1] = bf_hi(x.x); o[2] = bf_lo(x.y); o[3] = bf_hi(x.y); o[4] = bf_lo(x.z); o[5] = bf_hi(x.z); o[6] = bf_lo(x.w); o[7] = bf_hi(x.w); }
template <int WIN> __device__ __forceinline__ void pool_run(const bf16_t* __restrict__ XC, bf16_t* __restrict__ PO_, int R0, int t0, int c) {
    u32x4 x[15 + WIN];
#pragma unroll
    for (int i = 0; i < 15 + WIN; ++i) { const int dt = i - (WIN - 1); const bool ok = t0 + dt >= 0;
        x[i] = *(const u32x4*)(XC + (size_t)(R0 + (ok ? dt : 0)) * 1024 + c); if (!ok) x[i] = (u32x4){0u, 0u, 0u, 0u}; }
    float S[8] = {0.f, 0.f, 0.f, 0.f, 0.f, 0.f, 0.f, 0.f};
#pragma unroll
    for (int i = 0; i < WIN - 1; ++i) { float v[8]; unpack8(x[i], v);
#pragma unroll
        for (int j = 0; j < 8; ++j) S[j] += v[j]; }
#pragma unroll
    for (int j = 0; j < 16; ++j) {
        float v[8]; unpack8(x[j + WIN - 1], v);
#pragma unroll
        for (int e = 0; e < 8; ++e) S[e] += v[e];
        const int n = t0 + j + 1 < WIN ? t0 + j + 1 : WIN; const float ic = 1.0f / (float)n;
        u32x4 w; w.x = cvt_pk_bf16(S[0] * ic - v[0], S[1] * ic - v[1]); w.y = cvt_pk_bf16(S[2] * ic - v[2], S[3] * ic - v[3]);
        w.z = cvt_pk_bf16(S[4] * ic - v[4], S[5] * ic - v[5]); w.w = cvt_pk_bf16(S[6] * ic - v[6], S[7] * ic - v[7]);
        *(u32x4*)(PO_ + (size_t)(R0 + j) * 1024 + c) = w;
        float u[8]; unpack8(x[j], u);
#pragma unroll
        for (int e = 0; e < 8; ++e) S[e] -= u[e];
    }
}
__device__ __forceinline__ void conv_run8(const bf16_t* __restrict__ GBp, const bf16_t* __restrict__ Gp, const float* __restrict__ cwp, bf16_t* __restrict__ MIX, int R0, int t0, int c) {
    u32x4 g[10], gb[8];
#pragma unroll
    for (int i = 0; i < 10; ++i) { const int dt = i - 2; const bool ok = t0 + dt >= 0; g[i] = *(const u32x4*)(Gp + (size_t)(R0 + (ok ? dt : 0)) * 1024 + c); if (!ok) g[i] = (u32x4){0u, 0u, 0u, 0u}; }
#pragma unroll
    for (int i = 0; i < 8; ++i) gb[i] = *(const u32x4*)(GBp + (size_t)(R0 + i) * 1024 + c);
    float cw[3][8];
#pragma unroll
    for (int k = 0; k < 3; ++k) { const f32x4 a = *(const f32x4*)(cwp + k * 1024 + c), b2 = *(const f32x4*)(cwp + k * 1024 + c + 4);
        cw[k][0] = a[0]; cw[k][1] = a[1]; cw[k][2] = a[2]; cw[k][3] = a[3]; cw[k][4] = b2[0]; cw[k][5] = b2[1]; cw[k][6] = b2[2]; cw[k][7] = b2[3]; }
#pragma unroll
    for (int j = 0; j < 8; ++j) {
        float a0[8], a1[8], a2[8], b[8], o[8]; unpack8(g[j], a0); unpack8(g[j + 1], a1); unpack8(g[j + 2], a2); unpack8(gb[j], b);
#pragma unroll
        for (int e = 0; e < 8; ++e) o[e] = b[e] * (a0[e] * cw[0][e] + a1[e] * cw[1][e] + a2[e] * cw[2][e]);
        u32x4 w; w.x = cvt_pk_bf16(o[0], o[1]); w.y = cvt_pk_bf16(o[2], o[3]); w.z = cvt_pk_bf16(o[4], o[5]); w.w = cvt_pk_bf16(o[6], o[7]);
        *(u32x4*)(MIX + (size_t)(R0 + j) * DM + 1024 + c) = w;
    }
}
__device__ __forceinline__ void residual_fixup(const float* __restrict__ PART, const float* __restrict__ SLAB, int mode, const float* __restrict__ Y, float* __restrict__ out, bf16_t* __restrict__ XN,
                                               float* __restrict__ sumsq, int gw, int NGW, int lane, unsigned char* __restrict__ XN8 = nullptr, float sqx = 1.f) {
    const int S = mode == 0 ? 22 : (mode == 1 ? 11 : 8); const float alpha = mode == 0 ? 0.5f : (mode == 1 ? 0.5f / (S8_ACT * S8_W) : 1.0f);
    for (int it = gw; it < MS * 8; it += NGW) {
        const int r = it >> 3, c = (it & 7) * 256 + 4 * lane; const size_t ro = (size_t)(MP + r) * DM + c;
        f32x4 a = {0.f, 0.f, 0.f, 0.f};
        {
            f32x4 sv[22];
#pragma unroll
            for (int s = 0; s < 22; ++s) sv[s] = *(const f32x4*)(SLAB + ((size_t)(s < S ? s : 0) * MS + r) * DM + c);
#pragma unroll
            for (int s = 0; s < 22; ++s) a += sv[s] * (s < S ? 1.f : 0.f);
        }
        const f32x4 v = *(const f32x4*)(Y + ro) + a * alpha;
        *(f32x4*)(out + ro) = v;
        if (XN8) *(unsigned*)(XN8 + ro) = pk_i8x4(v[0] * sqx, v[1] * sqx, v[2] * sqx, v[3] * sqx);
        else { u32x2 w; w.x = cvt_pk_bf16(v[0], v[1]); w.y = cvt_pk_bf16(v[2], v[3]); *(u32x2*)(XN + ro) = w; }
        const float ss = wave_sum((v[0] * v[0] + v[1] * v[1]) + (v[2] * v[2] + v[3] * v[3]));
        if (lane == 0) atomicAdd(sumsq + MP + r, ss);
    }
}

__device__ __forceinline__ void fixup_tasks(const float* __restrict__ PART, const float* __restrict__ SLAB, int mode, const float* __restrict__ Y, float* __restrict__ out, bf16_t* __restrict__ XN,
                                            float* __restrict__ sumsq, int w, int NW, int lane, unsigned char* __restrict__ XN8 = nullptr, float sqx = 1.f) {
    const int S = mode == 0 ? 22 : (mode == 1 ? 11 : 8); const float alpha = mode == 0 ? 0.5f : (mode == 1 ? 0.5f / (S8_ACT * S8_W) : 1.0f);
    for (int b = w * 4; b < MP / 8; b += NW * 4) {
        f32x4 p[4];
#pragma unroll
        for (int j = 0; j < 4; ++j) p[j] = *(const f32x4*)(PART + ((size_t)(b + j) * 8 + (lane >> 3)) * 32 + (lane & 7) * 4);
#pragma unroll
        for (int j = 0; j < 4; ++j) {
            float v = (p[j][0] + p[j][1]) + (p[j][2] + p[j][3]);
            v += dppf<0xB1>(v); v += dppf<0x4E>(v); v += dppf<0x141>(v);
            if ((lane & 7) == 0) sumsq[(b + j) * 8 + (lane >> 3)] = v;
        }
    }
    for (int it = w; it < MS * 8; it += NW) {
        const int r = it >> 3, c = (it & 7) * 256 + 4 * lane; const size_t ro = (size_t)(MP + r) * DM + c;
        f32x4 a = {0.f, 0.f, 0.f, 0.f};
        {
            f32x4 sv[22];
#pragma unroll
            for (int s = 0; s < 22; ++s) sv[s] = *(const f32x4*)(SLAB + ((size_t)(s < S ? s : 0) * MS + r) * DM + c);
#pragma unroll
            for (int s = 0; s < 22; ++s) a += sv[s] * (s < S ? 1.f : 0.f);
        }
        const f32x4 v = *(const f32x4*)(Y + ro) + a * alpha;
        *(f32x4*)(out + ro) = v;
        if (XN8) *(unsigned*)(XN8 + ro) = pk_i8x4(v[0] * sqx, v[1] * sqx, v[2] * sqx, v[3] * sqx);
        else { u32x2 w2; w2.x = cvt_pk_bf16(v[0], v[1]); w2.y = cvt_pk_bf16(v[2], v[3]); *(u32x2*)(XN + ro) = w2; }
        const float ss = wave_sum((v[0] * v[0] + v[1] * v[1]) + (v[2] * v[2] + v[3] * v[3]));
        if (lane == 0) atomicAdd(sumsq + MP + r, ss);
    }
}

__global__ void __launch_bounds__(512, 2) mega_fwd(Args args) {
    extern __shared__ __attribute__((aligned(16))) unsigned char lds[];
    LAS unsigned char* L = (LAS unsigned char*)lds;
#define FRESH_IDS() const int tid = fresh_tid(wave0); int G = G0, bx = bx0; asm volatile("" : "+s"(G), "+s"(bx)); const int lane = tid & 63, wave = wave0; const int gw = bx * 8 + wave, NGW = G * 8; (void)lane; (void)gw; (void)NGW
    const int G0 = gridDim.x, bx0 = blockIdx.x;
#define WSP(T, off) ((T*)(opaque_ptr(args.ws) + (off)))
#define INP(T, i) ((const T*)lds_ptr((volatile LAS unsigned*)(L + PTAB_OFF), (i)))
#define CTLP ((unsigned*)(opaque_ptr(args.ws) + WS_CTL))
#define SUMSQP(k) ((float*)(opaque_ptr(args.ws) + WS_CTL) + CW_SUMSQ + (k) * MT)
#define AVSQP ((float*)(opaque_ptr(args.ws) + WS_CTL) + CW_AVSQ)
#define DOUT ((float*)opaque_ptr((unsigned char*)args.out))
    const int wave0 = __builtin_amdgcn_readfirstlane(threadIdx.x >> 6);
    { const int tid = fresh_tid(wave0);
    for (int u = tid; u < (LDS_BYTES - MISC_OFF) / 4; u += 512) ((LAS unsigned*)(L + MISC_OFF))[u] = 0u;
    __syncthreads();
    if (tid < 24) { const unsigned long long p = (unsigned long long)args.in[tid]; ((LAS unsigned*)(L + PTAB_OFF))[2 * tid] = (unsigned)p; ((LAS unsigned*)(L + PTAB_OFF))[2 * tid + 1] = (unsigned)(p >> 32); }
    __syncthreads(); }
    XcdBarrier bar = xcd_barrier_post(CTLP + CW_BAR, (volatile LAS unsigned*)(L + MISC_OFF + 32), wave0);

    constexpr int IT_G = 32 * 176, IT_INE = 32 * 160, IT_O = 32 * 64, IT_INO = 32 * 128, IT_CW = 4 * 32;
    constexpr int NIT = 12 * IT_G + IT_INE + IT_O + IT_INO + IT_O + IT_CW;
#define CONV_IT(it_) do { \
            int r = (it_); \
            if (r < 12 * IT_G) { \
                const int seg = r / IT_G, which = seg >> 2, lf = seg & 3, l = lf >> 1, f = lf & 1; r -= seg * IT_G; \
                  \
                if (which == 0) tr_item8(INP(float, 8) + (size_t)lf * DM * FF, DM, FF, norm_g + (l * 3 + f * 2) * DM, (unsigned char*)(WSP(bf16_t, WS_WGU) + (size_t)lf * 2 * FF * DM), 1, scr, r, lane, SQ_W, true); \
                else if (which == 1) tr_item8(INP(float, 9) + (size_t)lf * DM * FF, DM, FF, norm_g + (l * 3 + f * 2) * DM, (unsigned char*)(WSP(bf16_t, WS_WGU) + (size_t)lf * 2 * FF * DM), 2, scr, r, lane, SQ_W, true); \
                else if (lf >= FP8_DOWN_FROM) tr_item8(INP(float, 10) + (size_t)lf * FF * DM, FF, DM, nullptr, (unsigned char*)(WSP(bf16_t, WS_WD) + (size_t)lf * DM * FF), 0, scr, r, lane, S8_W, false); \
                else tr_item(INP(float, 10) + (size_t)lf * FF * DM, FF, DM, nullptr, WSP(bf16_t, WS_WD) + (size_t)lf * DM * FF, 0, scr, r, lane); \
                break; \
            } \
            r -= 12 * IT_G; \
            if (r < IT_INE) { tr_item(INP(float, 11), DM, 5120, norm_g + 1 * DM, WSP(bf16_t, WS_WINE), 0, scr, r, lane); break; } r -= IT_INE; \
            if (r < IT_O) { tr_item(INP(float, 12), DM, DM, nullptr, WSP(bf16_t, WS_WOUTE), 0, scr, r, lane); break; } r -= IT_O; \
            if (r < IT_INO) { tr_item(INP(float, 19), DM, 4096, norm_g + 4 * DM, WSP(bf16_t, WS_WINO), 3, scr, r, lane); break; } r -= IT_INO; \
            if (r < IT_O) { tr_item(INP(float, 20), DM, DM, nullptr, WSP(bf16_t, WS_WOUTO), 0, scr, r, lane); break; } r -= IT_O; \
            { const int gi = r / 32; tr_item(INP(float, 21) + (size_t)gi * 65536, 256, 256, nullptr, WSP(bf16_t, WS_CWGT) + (size_t)gi * 65536, 0, scr, r % 32, lane); } \
        } while (0)

#define CONV_WIN2(lo1_, hi1_, lo2_, hi2_, k_) do { FRESH_IDS(); LAS float* scr = (LAS float*)(L + wave * 16384); const float* norm_g = INP(float, 7); unsigned* ctr_ = CTLP + CW_CONV + 64 * (k_); \
        const int n1_ = (hi1_) - (lo1_), nt_ = n1_ + (hi2_) - (lo2_); \
        for (;;) { int base_ = 0; if (lane == 0) base_ = (int)atomicAdd(ctr_, 4u); base_ = __builtin_amdgcn_readfirstlane(base_); if (base_ >= nt_) break; \
            for (int j_ = 0; j_ < 4; ++j_) { const int w_ = base_ + j_; if (w_ < nt_) CONV_IT(w_ < n1_ ? (lo1_) + w_ : (lo2_) + (w_ - n1_)); } } } while (0)
#define CONV_TAIL(lo_, hi_, w_, nw_) do { FRESH_IDS(); LAS float* scr = (LAS float*)(L + wave * 16384); const float* norm_g = INP(float, 7); \
        for (int q_ = (lo_) + (w_); q_ < (hi_); q_ += (nw_)) CONV_IT(q_); } while (0)
#define GATE_ARRIVE(k_) do { asm volatile("s_waitcnt vmcnt(0)" ::: "memory"); __syncthreads(); \
        if (fresh_tid(wave0) == 0) { __builtin_amdgcn_fence(__ATOMIC_RELEASE, "agent"); asm volatile("s_waitcnt vmcnt(0)" ::: "memory"); (void)xb_add(CTLP + CW_GATE + 64 * (k_), 1u); } } while (0)
#define GATE_WAIT(k_, need_) do { if (wave0 == 0) { unsigned sp_ = 0u; while (xb_ld(CTLP + CW_GATE + 64 * (k_)) < (unsigned)(need_)) { __builtin_amdgcn_s_sleep(2); if (++sp_ > XB_SPIN_CAP) break; } \
            __builtin_amdgcn_fence(__ATOMIC_ACQUIRE, "agent"); asm volatile("s_waitcnt vmcnt(0)" ::: "memory"); } __syncthreads(); } while (0)
    for (int rep = 0; rep < REP_PRO; ++rep) {
        if (rep) xcd_barrier(bar);
        FRESH_IDS();
        LAS float* scr = (LAS float*)(L + wave * 16384);
        const float* norm_g = INP(float, 7);
        constexpr int NDEF = 9632 + 4000 + 2820 + 2500 + 3000 + 4000 + 3048 + 992 + 896;
        for (int k = gw; k < NIT - NDEF; k += NGW) {
            int it = k;
            if (it >= 5632) it += 15264 - 5632;
            if (it >= 16896) it += 20896 - 16896;
            if (it >= 28160) it += 30980 - 28160;
            if (it >= 39424) it += 41924 - 39424;
            if (it >= 50688) it += 53688 - 50688;
            if (it >= 61952) it += 65952 - 61952;
            if (it >= 71704) it += 74752 - 71704;
            if (it >= 78848) it += 80736 - 78848;
            CONV_IT(it);
        }
        {
            const float* x_prompt = INP(float, 0); const float* x_sample = INP(float, 1);
            unsigned char* XNQ = WSP(unsigned char, WS_XNQ); float* SQ = SUMSQP(0);
            for (int m = NGW - 1 - gw; m < MT; m += NGW) {
                const float* src = m < MP ? x_prompt + (size_t)m * DM : (m < MP + MS ? x_sample + (size_t)(m - MP) * DM : nullptr);
                float ss = 0.f;
#pragma unroll
                for (int j = 0; j < 8; ++j) {
                    const int c = 4 * lane + 256 * j;
                    f32x4 v = src ? __builtin_nontemporal_load((const f32x4*)(src + c)) : (f32x4){0.f, 0.f, 0.f, 0.f};
                    *(unsigned*)(XNQ + (size_t)m * DM + c) = pk_i8x4(v[0] * sqx_of(0), v[1] * sqx_of(0), v[2] * sqx_of(0), v[3] * sqx_of(0));
                    ss += (v[0] * v[0] + v[1] * v[1]) + (v[2] * v[2] + v[3] * v[3]);
                }
                ss = wave_sum(ss);
                if (lane == 0) SQ[m] = ss;
            }
        }
        {
            const float* a_ws = INP(float, 17); bf16_t* AWS = WSP(bf16_t, WS_AWS);
            for (int i = bx * 512 + tid; i < 8 * 128 * 128; i += G * 512) { const int p = (i >> 7) & 127, q = i & 127; AWS[i] = q <= p ? (bf16_t)(cvt_pk_bf16(a_ws[i], 0.f) & 0xffffu) : (bf16_t)0; }
            const float* state_pool = INP(float, 4); float* dout = DOUT;
            for (int i = bx * 512 + tid; i < DECB * 11 * 1024; i += G * 512) { const int b = i / (11 * 1024), rem = i % (11 * 1024); dout[O_PS + (size_t)b * 15 * 1024 + rem] = state_pool[(size_t)b * 15 * 1024 + 4 * 1024 + rem]; }
        }
    }
    xcd_barrier(bar);

    for (int layer = 0; layer < 2; ++layer) {
        for (int hs = 0; hs < 2; ++hs) {
            const int lf = layer * 2 + hs;
            const bool dn8 = (lf >= FP8_DOWN_FROM);
            for (int rep = 0; rep < REP_UP; ++rep) {
                if (rep) xcd_barrier(bar);
                if (bx0 >= G_UP) {
                    if (rep == 0 && lf > 0) {
                        const int w_ = (bx0 - G_UP) * 8 + wave0, nw_ = (G0 - G_UP) * 8; const int lane_ = fresh_tid(wave0) & 63;
                        if (lf == 1)      fixup_tasks(WSP(float, WS_PART), WSP(float, WS_SLAB), 2, WSP(float, WS_Y), WSP(float, WS_Y), WSP(bf16_t, WS_XN), SUMSQP(2), w_, nw_, lane_, WSP(unsigned char, WS_XNQ), sqx_of(1));
                        else if (lf == 2) fixup_tasks(WSP(float, WS_PART), WSP(float, WS_SLAB), 0, WSP(float, WS_Y), WSP(float, WS_Y), WSP(bf16_t, WS_XN), SUMSQP(3), w_, nw_, lane_, WSP(unsigned char, WS_XNQ), sqx_of(2));
                        else              fixup_tasks(WSP(float, WS_PART), WSP(float, WS_SLAB), 2, WSP(float, WS_Y), WSP(float, WS_Y), WSP(bf16_t, WS_XN), SUMSQP(5), w_, nw_, lane_, WSP(unsigned char, WS_XNQ), sqx_of(3));
                        GATE_ARRIVE(lf);
                    }
                    if (rep == 0) { if (lf == 0) CONV_WIN2(71704, 74752, 5632, 6584, 1); else if (lf == 1) CONV_WIN2(11264, 15264, 0, 0, 3); else if (lf == 2) CONV_WIN2(16896, 20896, 0, 0, 4); else CONV_WIN2(61952, 65952, 0, 0, 5); }
                } else if (dn8) {
                    pg8::Gemm g{WSP(unsigned char, WS_XNQ), (const unsigned char*)(WSP(bf16_t, WS_WGU) + (size_t)lf * 2 * FF * DM), DM, DM, DM, 0};
                    pg8::StaticOrder S; S.init(NPAN, 44, G_UP, bx0, 0, 16);
                    pg8::EpiUpT<2, true> E{WSP(unsigned char, WS_ACT), SUMSQP(layer * 3 + hs * 2), 1.0f / (sqx_of(3) * SQ_W)};
                    pg8::gemm_phase<pg8::EpiUpT<2, true>, 2>(L, g, S, E, wave0, lf > 0 ? CTLP + CW_GATE + 64 * lf : nullptr, (unsigned)(G0 - G_UP));
                } else {
                    pg8::Gemm g{WSP(unsigned char, WS_XNQ), (const unsigned char*)(WSP(bf16_t, WS_WGU) + (size_t)lf * 2 * FF * DM), DM, DM, DM, 0};
                    pg8::StaticOrder S; S.init(NPAN, 44, G_UP, bx0, 0, 16);
                    pg8::EpiUpT<2, false> E{WSP(bf16_t, WS_ACT), SUMSQP(layer * 3 + hs * 2), 1.0f / ((lf == 0 ? sqx_of(0) : (lf == 1 ? sqx_of(1) : sqx_of(2))) * SQ_W)};
                    pg8::gemm_phase<pg8::EpiUpT<2, false>, 2>(L, g, S, E, wave0, lf > 0 ? CTLP + CW_GATE + 64 * lf : nullptr, (unsigned)(G0 - G_UP));
                }
            }
            xcd_barrier(bar);
            const bool fin = (layer == 1 && hs == 1);
            const int ni = hs == 0 ? layer * 3 + 1 : (layer + 1) * 3;
            if (dn8) {
                pg8::Gemm g{WSP(unsigned char, WS_ACT), (const unsigned char*)(WSP(bf16_t, WS_WD) + (size_t)lf * DM * FF), FF, FF, FF, 0};
                pg8::StaticOrder S; S.init(32, 8, G0, bx0, 11, 44);
                pg8::EpiRes E{WSP(float, WS_Y), fin ? DOUT : WSP(float, WS_Y), WSP(bf16_t, WS_XN), WSP(float, WS_PART), 0.5f / (S8_ACT * S8_W), WSP(float, WS_SLAB)};
                pg8::gemm_phase<pg8::EpiRes, 1>(L, g, S, E, wave0);
            } else {
                pg8::Gemm g{WSP(bf16_t, WS_ACT), WSP(bf16_t, WS_WD) + (size_t)lf * DM * FF, FF * 2, FF * 2, FF, 0};
                pg8::StaticOrder S; S.init(32, 8, G0, bx0, 22, 88);
                pg8::EpiRes E{lf == 0 ? INP(float, 0) : WSP(float, WS_Y), fin ? DOUT : WSP(float, WS_Y), WSP(bf16_t, WS_XN), WSP(float, WS_PART), 0.5f, WSP(float, WS_SLAB), hs == 1 ? WSP(unsigned char, WS_XNQ) : nullptr, sqx_of(2)};
                pg8::gemm_phase<pg8::EpiRes>(L, g, S, E, wave0);
            }
            xcd_barrier(bar);
            if (fin) {
                if (dn8) { FRESH_IDS(); residual_fixup(WSP(float, WS_PART), WSP(float, WS_SLAB), 1, WSP(float, WS_Y), DOUT, WSP(bf16_t, WS_XN), AVSQP, gw, NGW, lane); }
                else     { FRESH_IDS(); residual_fixup(WSP(float, WS_PART), WSP(float, WS_SLAB), 0, WSP(float, WS_Y), DOUT, WSP(bf16_t, WS_XN), AVSQP, gw, NGW, lane); }
                break;
            }
            if (hs == 1) continue;
            if (layer == 0) {
                {
                    pg8::Gemm g{WSP(bf16_t, WS_XN), WSP(bf16_t, WS_WINE), DM * 2, DM * 2, DM, 0};
                    pg8::StaticOrder S; S.init(NPAN, 20, G_INE, bx0, 0, 32);
                    pg8::EpiInEven E{SUMSQP(1), WSP(bf16_t, WS_T0), WSP(bf16_t, WS_T1), WSP(bf16_t, WS_T2), WSP(bf16_t, WS_T3), WSP(bf16_t, WS_T4), DOUT, INP(float, 13), INP(float, 14), AVSQP, (LAS float*)(L + RED_OFF)};
                    if (bx0 < G_INE) pg8::gemm_phase<pg8::EpiInEven>(L, g, S, E, wave0, CTLP + CW_GATE + 64 * 4, (unsigned)(G0 - G_INE));
                    else {
                        { const int w_ = (bx0 - G_INE) * 8 + wave0, nw_ = (G0 - G_INE) * 8; const int lane_ = fresh_tid(wave0) & 63;
                          fixup_tasks(WSP(float, WS_PART), WSP(float, WS_SLAB), 0, INP(float, 1) - (size_t)MP * DM, WSP(float, WS_Y), WSP(bf16_t, WS_XN), SUMSQP(1), w_, nw_, lane_);
                          GATE_ARRIVE(4); }
                        CONV_WIN2(6584, 11264, 28160, 30980, 2);
                    }
                }
                xcd_barrier(bar);
                for (int rep = 0; rep < REP_MIX; ++rep) {
                    if (rep) xcd_barrier(bar);
                    FRESH_IDS();
                    if (rep == 0 && (bx < G / 2 || G < 2)) {
                        const int nb = G < 2 ? 1 : G / 2, b0 = bx;
                        for (int gu = b0; gu < 512; gu += nb)
                            sba::gate_unit(WSP(bf16_t, WS_T4), WSP(bf16_t, WS_T3), WSP(bf16_t, WS_AWS), AVSQP, INP(float, 16), INP(float, 18), WSP(bf16_t, WS_MIX), (gu >> 3) * 128, gu & 7, (char*)lds, wave0);
                    }
                    if (rep == 0 && (bx < G / 2 || G < 2)) {
                        const int na = G < 2 ? 1 : G / 2;
                        for (int pu = bx; pu < 128; pu += na) {
#pragma unroll 1
                            for (int half = 0; half < 2; ++half) {
                                const int j = pu >> 5, qb = half == 0 ? 7 - j : j, bh = pu & 31, b = bh >> 3, h = bh & 7;
                                const size_t rb = (size_t)b * SEQ;
                                sba::attn_unit(WSP(bf16_t, WS_T0) + (rb + qb * 256) * 1024 + h * HD, WSP(bf16_t, WS_T1) + rb * 1024 + h * HD, WSP(bf16_t, WS_T2) + rb * 1024 + h * HD,
                                               WSP(bf16_t, WS_MIX) + (rb + qb * 256) * DM + 1024 + h * HD, qb * 256, INP(float, 15)[h] * LOG2E, (char*)lds, wave0);
                            }
                        }
                    }
                    if (bx < MS) {
                        const int row = MP + bx, b = bx >> 2, p = bx & 3;
                        const bf16_t* T3 = WSP(bf16_t, WS_T3); const bf16_t* T4 = WSP(bf16_t, WS_T4); bf16_t* MIX = WSP(bf16_t, WS_MIX);
                        const float* AVSQ = AVSQP; const float* a_v_norm_g = INP(float, 16); const float* a_ws = INP(float, 17); const float* a_bs = INP(float, 18); float* dout = DOUT;
                        for (int c = tid; c < AW; c += 512) {
                            const int gi = c >> 7; float mixv = a_bs[gi * 128 + p];
                            for (int q = 0; q <= p; ++q) {
                                const int rq = MP + b * 4 + q;
                                const float avn = __uint_as_float((unsigned)T4[(size_t)rq * 1024 + c] << 16) * __builtin_amdgcn_rsqf(AVSQ[rq] * (1.0f / AW) + EPS) * a_v_norm_g[c];
                                mixv += a_ws[(size_t)gi * 16384 + p * 128 + q] * avn;
                                if (q == p) dout[O_AV + (size_t)bx * 1024 + c] = avn;
                            }
                            const float au = __uint_as_float((unsigned)T3[(size_t)row * 1024 + c] << 16);
                            MIX[(size_t)row * DM + c] = (bf16_t)(cvt_pk_bf16(au * mixv, 0.f) & 0xffffu);
                        }
                    }
                    {
                        const bf16_t* T0 = WSP(bf16_t, WS_T0); const float* cache_k = INP(float, 2); const float* cache_v = INP(float, 3); const int* page_table = INP(int, 6);
                        const float* sb_bias = INP(float, 15); float* PO = WSP(float, WS_PO); float* PP = WSP(float, WS_PP); unsigned* qctr = CTLP + CW_QCTR + 64 * rep;
                        for (;;) {
                            int item = 0;
                            if (lane == 0) item = (int)atomicAdd(qctr, 1u);
                            item = __builtin_amdgcn_readfirstlane(item);
                            if (item >= 64 * 32) break;
                            const int h = item & 7, run = (item >> 3) & 31, b = item >> 8, bh = b * 8 + h, pidx = bh * 32 + run, hi = lane >> 5, l32 = lane & 31;
                            f32x4 qv[4];
#pragma unroll
                            for (int qi = 0; qi < 4; ++qi) { const u32x2 w = *(const u32x2*)(T0 + (size_t)(MP + b * 4 + qi) * 1024 + h * HD + 4 * l32);
                                qv[qi] = (f32x4){bf_lo(w.x), bf_hi(w.x), bf_lo(w.y), bf_hi(w.y)}; }
                            const float bias2 = sb_bias[h] * LOG2E;
                            f32x4 o[4] = {};
                            float C = 1.f;
                            const int qsel = (lane >> 3) & 3;
                            int phys[4];
#pragma unroll
                            for (int p4 = 0; p4 < 4; ++p4) phys[p4] = page_table[b * NPAGES + run * 4 + p4];
                            const size_t lane_off = (size_t)h * HD + 4 * l32;
#define SA_LOAD(KK, VV, ci) do { const int _pg = (ci) >> 4, _c8 = (ci) & 15; const int _ph = _pg == 0 ? phys[0] : (_pg == 1 ? phys[1] : (_pg == 2 ? phys[2] : phys[3])); \
    const size_t _base = ((size_t)_ph * PAGE) * (NH * HD) + lane_off; _Pragma("unroll") for (int s_ = 0; s_ < 4; ++s_) { const int tok = _c8 * 8 + 7 - 2 * s_ - hi; \
        KK[s_] = __builtin_nontemporal_load((const f32x4*)(cache_k + _base + (size_t)tok * (NH * HD))); VV[s_] = __builtin_nontemporal_load((const f32x4*)(cache_v + _base + (size_t)tok * (NH * HD))); } } while (0)
#define SA_COMPUTE(KK, VV) do { _Pragma("unroll") for (int s_ = 0; s_ < 4; ++s_) { \
        float d0 = (KK[s_][0] * qv[0][0] + KK[s_][1] * qv[0][1]) + (KK[s_][2] * qv[0][2] + KK[s_][3] * qv[0][3]); \
        float d1 = (KK[s_][0] * qv[1][0] + KK[s_][1] * qv[1][1]) + (KK[s_][2] * qv[1][2] + KK[s_][3] * qv[1][3]); \
        float d2 = (KK[s_][0] * qv[2][0] + KK[s_][1] * qv[2][1]) + (KK[s_][2] * qv[2][2] + KK[s_][3] * qv[2][3]); \
        float d3 = (KK[s_][0] * qv[3][0] + KK[s_][1] * qv[3][1]) + (KK[s_][2] * qv[3][2] + KK[s_][3] * qv[3][3]); \
        float ka = b4 ? d2 : d0, kb2 = b4 ? d3 : d1, sa = b4 ? d0 : d2, sb = b4 ? d1 : d3; \
        ka += xchg16(sa, b4); kb2 += xchg16(sb, b4);                                    \
        float kc = b3 ? kb2 : ka, sc2 = b3 ? ka : kb2; \
        kc += dppf<0x128>(sc2);                                                          \
        kc += dppf<0xB1>(kc); kc += dppf<0x4E>(kc); kc += dppf<0x141>(kc);               \
        const float e = fast_exp2(kc + bias2), f = 1.f + e; const float fo = xchg32(f, hi); const float Cn = C * f * fo; \
        const float A = e * fast_rcp(hi ? Cn : C * f); C = Cn; \
        const float Ab = dppf<0x128>(A); const float alo = b3 ? Ab : A, ahi = b3 ? A : Ab;     \
        const float olo = xchg16(alo, b4), ohi = xchg16(ahi, b4);                       \
        const float A0 = b4 ? olo : alo, A1 = b4 ? ohi : ahi, A2 = b4 ? alo : olo, A3 = b4 ? ahi : ohi; \
        o[0] += VV[s_] * A0; o[1] += VV[s_] * A1; o[2] += VV[s_] * A2; o[3] += VV[s_] * A3; } } while (0)
                            const bool b4 = (lane & 16) != 0, b3 = (lane & 8) != 0;
                            f32x4 kA[4], vA[4], kB[4], vB[4];
                            SA_LOAD(kA, vA, 63);
                            for (int ci = 63; ci >= 1; ci -= 2) {
                                SA_LOAD(kB, vB, ci - 1);
                                SA_COMPUTE(kA, vA);
                                if (ci >= 2) SA_LOAD(kA, vA, ci - 2);
                                SA_COMPUTE(kB, vB);
                            }
#undef SA_LOAD
#undef SA_COMPUTE
#pragma unroll
                            for (int qi = 0; qi < 4; ++qi) {
#pragma unroll
                                for (int j = 0; j < 4; ++j) o[qi][j] += xchg32(o[qi][j], hi);
                                if (hi == 0) *(f32x4*)(PO + ((size_t)pidx * 4 + qi) * HD + 4 * l32) = o[qi];
                            }
                            if ((lane & 39) == 0) PP[(size_t)pidx * 4 + qsel] = C;
                        }
                    }
                }
                xcd_barrier(bar);
                if (bx0 >= G0 - 32) {
                    FRESH_IDS();
                    const int cw_ = (bx0 - (G0 - 32)) * 8 + wave0;
                    const bf16_t* T0 = WSP(bf16_t, WS_T0); const bf16_t* T1 = WSP(bf16_t, WS_T1); const bf16_t* T2 = WSP(bf16_t, WS_T2); bf16_t* MIX = WSP(bf16_t, WS_MIX);
                    const float* sb_bias = INP(float, 15); const float* PO = WSP(float, WS_PO); const float* PP = WSP(float, WS_PP);
                    for (int bhi = cw_; bhi < 256; bhi += 256) {
                        const int bh = bhi >> 2, i = bhi & 3, b = bh >> 3, h = bh & 7; const float bias2 = sb_bias[h] * LOG2E;
                        float pp[32]; f32x2 po[32];
#pragma unroll
                        for (int run = 0; run < 32; ++run) { const size_t it = (size_t)bh * 32 + run; pp[run] = PP[it * 4 + i]; po[run] = *(const f32x2*)(PO + (it * 4 + i) * HD + 2 * lane); }
                        const size_t rq = (size_t)(MP + b * 4 + i) * 1024 + h * HD + 2 * lane;
                        const unsigned qw = *(const unsigned*)(T0 + rq); const float q0 = bf_lo(qw), q1 = bf_hi(qw);
                        float o0 = 0.f, o1 = 0.f, P = 1.f;
#pragma unroll
                        for (int j = 2; j >= 0; --j) {
                            if (j < i) {
                                const size_t rk = (size_t)(MP + b * 4 + j) * 1024 + h * HD + 2 * lane;
                                const unsigned kw = *(const unsigned*)(T1 + rk), vw = *(const unsigned*)(T2 + rk);
                                const float z = wave_sum(q0 * bf_lo(kw) + q1 * bf_hi(kw)) + bias2;
                                const float e = fast_exp2(z); P *= (1.f + e);
                                const float A = e / P; o0 += A * bf_lo(vw); o1 += A * bf_hi(vw);
                            }
                        }
                        float scale = 1.f / P;
#pragma unroll
                        for (int run = 31; run >= 0; --run) { o0 += po[run][0] * scale; o1 += po[run][1] * scale; scale = scale / pp[run]; }
                        *(unsigned*)(MIX + (size_t)(MP + b * 4 + i) * DM + 1024 + h * HD + 2 * lane) = cvt_pk_bf16(o0, o1);
                    }
                    GATE_ARRIVE(6);
                }
                {
                    pg8::Gemm g{WSP(bf16_t, WS_MIX), WSP(bf16_t, WS_WOUTE), DM * 2, DM * 2, DM, 0};
                    pg8::StaticOrder S; S.init(32, 8, G0, bx0, 0, 32);
                    pg8::EpiRes E{WSP(float, WS_Y), WSP(float, WS_Y), WSP(bf16_t, WS_XN), WSP(float, WS_PART), 1.0f, WSP(float, WS_SLAB), WSP(unsigned char, WS_XNQ), sqx_of(1)};
                    pg8::gemm_phase<pg8::EpiRes>(L, g, S, E, wave0);
                    if (bx0 < 64) {
                        GATE_WAIT(6, 32);
                        pg8::StaticOrder S2; S2.init(32, 8, G0, bx0, 8, 32); S2.i0 = (256 - bx0 + G0 - 1) / G0;
                        pg8::gemm_phase<pg8::EpiRes>(L, g, S2, E, wave0);
                    } else if (bx0 < G0 - 32) CONV_TAIL(50688, 53688, (bx0 - 64) * 8 + wave0, (G0 - 96) * 8);
                }
                xcd_barrier(bar);
            } else {
                {
                    pg8::Gemm g{WSP(bf16_t, WS_XN), WSP(bf16_t, WS_WINO), DM * 2, DM * 2, DM, 0};
                    pg8::StaticOrder S; S.init(32, 16, G0, bx0, 8, 32);
                    pg8::EpiInOdd E{SUMSQP(4), WSP(bf16_t, WS_T0), WSP(bf16_t, WS_T1), WSP(bf16_t, WS_T2), DOUT, WSP(float, WS_SLAB)};
                    if (bx0 >= G0 - 16) { const int w_ = (bx0 - (G0 - 16)) * 8 + wave0; const int lane_ = fresh_tid(wave0) & 63;
                        fixup_tasks(WSP(float, WS_PART), WSP(float, WS_SLAB), 0, WSP(float, WS_Y), WSP(float, WS_Y), WSP(bf16_t, WS_XN), SUMSQP(4), w_, 128, lane_);
                        GATE_ARRIVE(5); }
                    pg8::gemm_phase<pg8::EpiInOdd>(L, g, S, E, wave0, CTLP + CW_GATE + 64 * 5, 16u);
                    if (bx0 >= 128 && bx0 < G0 - 16) CONV_TAIL(79840, 80736, (bx0 - 128) * 8 + wave0, (G0 - 144) * 8);
                }
                xcd_barrier(bar);
                {
                    FRESH_IDS();
                    const bf16_t* T0 = WSP(bf16_t, WS_T0); const bf16_t* T1 = WSP(bf16_t, WS_T1); const bf16_t* T2 = WSP(bf16_t, WS_T2); bf16_t* T3 = WSP(bf16_t, WS_T3); bf16_t* MIX = WSP(bf16_t, WS_MIX);
                    const float* d_conv_w = INP(float, 23);
                    if (bx < 128) {
                        const int it = bx * 512 + tid;
                        const int grp = it >> 14, run = (it >> 5) & 511, c = grp * 256 + (it & 31) * 8, R0 = run * 16, t0 = R0 & (SEQ - 1);
                        if (grp == 0) pool_run<2>(T0, T3, R0, t0, c); else if (grp == 1) pool_run<4>(T0, T3, R0, t0, c); else if (grp == 2) pool_run<8>(T0, T3, R0, t0, c); else pool_run<16>(T0, T3, R0, t0, c);
                    } else if (bx >= NPAN * 4) {
                        for (int it = (bx - NPAN * 4) * 512 + tid; it < 512 * 128; it += (G - NPAN * 4) * 512) {
                            const int run = it >> 7, c = (it & 127) * 8, R0 = run * 16, t0 = R0 & (SEQ - 1);
                            conv_run8(T1, T2, d_conv_w, MIX, R0, t0, c); conv_run8(T1, T2, d_conv_w, MIX, R0 + 8, t0 + 8, c);
                        }
                    }
                    if (bx >= 128 && bx < NPAN * 4) {
                        const int g_ = bx - 128, win = 2 << g_;
                        const float* SP = WSP(float, WS_SLAB); const float* SQ = SUMSQP(4); const float* state_pool = INP(float, 4); const float* state_conv = INP(float, 5); float* dout = DOUT;
                        LAS float* XCs = (LAS float*)L; LAS float* GGs = XCs + 32 * 256; LAS float* GBs = GGs + 32 * 256;
                        for (int q = tid; q < MS * 32; q += 512) {
                            const int r = q >> 5, cc = (q & 31) * 8, c = g_ * 256 + cc, gcol = 2048 + 256 * (c >> 7) + (c & 127);
                            const float rs = __builtin_amdgcn_rsqf(SQ[MP + r] * (1.0f / DM) + EPS);
                            float xc[8], gc[8], gh[8], gb[8];
                            sp_sum8(SP, r, c, xc); sp_sum8(SP, r, gcol, gc); sp_sum8(SP, r, gcol + 128, gh); sp_sum8(SP, r, 1024 + c, gb);
#pragma unroll
                            for (int h = 0; h < 2; ++h) {
                                f32x4 a, d, e;
#pragma unroll
                                for (int j = 0; j < 4; ++j) { a[j] = xc[h * 4 + j] * rs; d[j] = gc[h * 4 + j] * gh[h * 4 + j] * rs * rs; e[j] = gb[h * 4 + j] * rs; }
                                *(LAS f32x4*)(XCs + r * 256 + cc + h * 4) = a; *(LAS f32x4*)(GGs + r * 256 + cc + h * 4) = d; *(LAS f32x4*)(GBs + r * 256 + cc + h * 4) = e;
                            }
                        }
                        __syncthreads();
                        for (int q = tid; q < MS * 32; q += 512) {
                            const int sr = q >> 5, cc = (q & 31) * 8, c = g_ * 256 + cc, b = sr >> 2, i = sr & 3, row = MP + sr;
                            float acc[8], self[8], gsum[8], gbv[8];
#pragma unroll
                            for (int h = 0; h < 2; ++h) { const f32x4 a = *(const LAS f32x4*)(XCs + sr * 256 + cc + h * 4), e = *(const LAS f32x4*)(GBs + sr * 256 + cc + h * 4);
#pragma unroll
                                for (int j = 0; j < 4; ++j) { self[h * 4 + j] = a[j]; acc[h * 4 + j] = a[j]; gbv[h * 4 + j] = e[j]; gsum[h * 4 + j] = 0.f; } }
#pragma unroll
                            for (int k = 1; k <= 3; ++k) {
                                const float mk = (k <= i && k < win) ? 1.f : 0.f; const int r2 = sr - (k <= i ? k : 0);
#pragma unroll
                                for (int h = 0; h < 2; ++h) { const f32x4 a = *(const LAS f32x4*)(XCs + r2 * 256 + cc + h * 4);
#pragma unroll
                                    for (int j = 0; j < 4; ++j) acc[h * 4 + j] += a[j] * mk; }
                            }
                            const int lo = 15 + i - (win - 1);
#pragma unroll 5
                            for (int fi = 0; fi < 15; ++fi) {
                                const float* sp = state_pool + ((size_t)b * 15 + fi) * 1024 + c; const f32x4 a = *(const f32x4*)sp, d = *(const f32x4*)(sp + 4); const float mk = fi >= lo ? 1.f : 0.f;
#pragma unroll
                                for (int j = 0; j < 4; ++j) { acc[j] += a[j] * mk; acc[4 + j] += d[j] * mk; }
                            }
#pragma unroll
                            for (int j = 0; j < 8; ++j) dout[O_PS + ((size_t)b * 15 + 11 + i) * 1024 + c + j] = self[j];
#pragma unroll
                            for (int k = 0; k < 3; ++k) {
                                const int gi = i - 2 + k; float gg[8];
                                if (gi >= 0) {
#pragma unroll
                                    for (int h = 0; h < 2; ++h) { const f32x4 d = *(const LAS f32x4*)(GGs + (b * 4 + gi) * 256 + cc + h * 4);
#pragma unroll
                                        for (int j = 0; j < 4; ++j) gg[h * 4 + j] = d[j]; }
                                    if (k == 2 && i >= 2) {
#pragma unroll
                                        for (int j = 0; j < 8; ++j) dout[O_CS + ((size_t)b * 2 + (i - 2)) * 1024 + c + j] = gg[j]; }
                                } else { const float* sp = state_conv + ((size_t)b * 2 + (gi + 2)) * 1024 + c;
#pragma unroll
                                    for (int j = 0; j < 8; ++j) gg[j] = sp[j]; }
                                const f32x4 w0 = *(const f32x4*)(d_conv_w + k * 1024 + c), w1 = *(const f32x4*)(d_conv_w + k * 1024 + c + 4);
#pragma unroll
                                for (int j = 0; j < 4; ++j) { gsum[j] += gg[j] * w0[j]; gsum[4 + j] += gg[4 + j] * w1[j]; }
                            }
                            const float ic = 1.0f / (float)win;
                            u32x4 wp, wd;
                            wp.x = cvt_pk_bf16(acc[0] * ic - self[0], acc[1] * ic - self[1]); wp.y = cvt_pk_bf16(acc[2] * ic - self[2], acc[3] * ic - self[3]);
                            wp.z = cvt_pk_bf16(acc[4] * ic - self[4], acc[5] * ic - self[5]); wp.w = cvt_pk_bf16(acc[6] * ic - self[6], acc[7] * ic - self[7]);
                            wd.x = cvt_pk_bf16(gbv[0] * gsum[0], gbv[1] * gsum[1]); wd.y = cvt_pk_bf16(gbv[2] * gsum[2], gbv[3] * gsum[3]);
                            wd.z = cvt_pk_bf16(gbv[4] * gsum[4], gbv[5] * gsum[5]); wd.w = cvt_pk_bf16(gbv[6] * gsum[6], gbv[7] * gsum[7]);
                            *(u32x4*)(T3 + (size_t)row * 1024 + c) = wp;
                            *(u32x4*)(MIX + (size_t)row * DM + 1024 + c) = wd;
                        }
                    }
                }
                if (bx0 < NPAN * 4) {
                    asm volatile("s_waitcnt vmcnt(0)" ::: "memory"); __syncthreads();
                    pg8::Gemm g{WSP(bf16_t, WS_T3), WSP(bf16_t, WS_CWGT), 1024 * 2, 256 * 2, 256, 256 * 2};
                    pg8::StaticOrder S; S.init(NPAN, 4, G0, bx0, 0, 4); S.dpm = bx0 < 128 ? (bx0 & 31) : 32; S.dpn = bx0 < 128 ? (bx0 >> 5) : bx0 - 128;
                    pg8::EpiPool E{WSP(bf16_t, WS_MIX), INP(float, 22)};
                    pg8::gemm_phase<pg8::EpiPool>(L, g, S, E, wave0);
                } else CONV_TAIL(78848, 79840, (bx0 - NPAN * 4) * 8 + wave0, (G0 - NPAN * 4) * 8);
                xcd_barrier(bar);
                {
                    pg8::Gemm g{WSP(bf16_t, WS_MIX), WSP(bf16_t, WS_WOUTO), DM * 2, DM * 2, DM, 0};
                    pg8::StaticOrder S; S.init(32, 8, G0, bx0, 8, 32);
                    pg8::EpiRes E{WSP(float, WS_Y), WSP(float, WS_Y), WSP(bf16_t, WS_XN), WSP(float, WS_PART), 1.0f, WSP(float, WS_SLAB), WSP(unsigned char, WS_XNQ), sqx_of(3)};
                    pg8::gemm_phase<pg8::EpiRes>(L, g, S, E, wave0);
                    if (bx0 >= 64) CONV_TAIL(39424, 41924, (bx0 - 64) * 8 + wave0, (G0 - 64) * 8);
                }
                xcd_barrier(bar);
            }
        }
    }
}

extern "C" void kernel_launch(void* const* d_in, const int* in_sizes, int n_in, void* d_out, int out_size, void* d_ws, size_t ws_size, hipStream_t stream) {
    static int grid = 0;
    if (grid == 0) {
        if (n_in != 24 || ws_size < WS_END || out_size != (int)O_END) { fprintf(stderr, "kernel_launch: unexpected problem (n_in %d, out %d, ws %zu)\n", n_in, out_size, ws_size); grid = -1; return; }
        int dev = 0, cus = 0, per_cu = 0;
        if (hipGetDevice(&dev) != hipSuccess || hipDeviceGetAttribute(&cus, hipDeviceAttributeMultiprocessorCount, dev) != hipSuccess) { grid = -1; return; }
        if (hipFuncSetAttribute((const void*)mega_fwd, hipFuncAttributeMaxDynamicSharedMemorySize, LDS_BYTES) != hipSuccess) { fprintf(stderr, "kernel_launch: hipFuncSetAttribute failed\n"); grid = -1; return; }
        if (hipOccupancyMaxActiveBlocksPerMultiprocessor(&per_cu, (const void*)mega_fwd, 512, LDS_BYTES) != hipSuccess || per_cu < 1) { fprintf(stderr, "kernel_launch: occupancy query says %d\n", per_cu); }
        (void)hipGetLastError();
        grid = cus;
    }
    if (grid < 0) return;
    (void)hipMemsetAsync((char*)d_ws + WS_CTL, 0, CTL_BYTES, stream);
    Args a{};
    for (int i = 0; i < 24; ++i) a.in[i] = d_in[i];
    a.out = (float*)d_out; a.ws = (unsigned char*)d_ws;
    hipLaunchKernelGGL(mega_fwd, dim3(grid), dim3(512), LDS_BYTES, stream, a);
}
```

```cpp
#include <hip/hip_runtime.h>
#include <cstdio>
#include <cstdint>

#define GAS __attribute__((address_space(1)))
#define LAS __attribute__((address_space(3)))
typedef unsigned short bf16_t;
typedef short bf16x8 __attribute__((ext_vector_type(8)));
typedef short s16x4 __attribute__((ext_vector_type(4)));
typedef float f32x4 __attribute__((ext_vector_type(4)));
typedef float f32x2 __attribute__((ext_vector_type(2)));
typedef float f32x16 __attribute__((ext_vector_type(16)));
typedef unsigned u32x4 __attribute__((ext_vector_type(4)));
typedef unsigned u32x2 __attribute__((ext_vector_type(2)));

#ifndef FP8_DOWN_FROM
#define FP8_DOWN_FROM 3
#endif
constexpr int G_UP = 242, G_INE = 220;
#ifndef REP_PRO
#define REP_PRO 1
#endif
#ifndef REP_UP
#define REP_UP 1
#endif
#ifndef REP_MIX
#define REP_MIX 1
#endif
#ifndef REP_BAR
#define REP_BAR 1
#endif
#ifndef REP_ODD
#define REP_ODD 1
#endif
#ifndef REP_CMB
#define REP_CMB 1
#endif
constexpr int DM = 2048, FF = 5632, SEQ = 2048, NBATCH = 4, MP = 8192, MS = 32, MT = 8448, NPAN = 33;
constexpr int NH = 8, HD = 128, AW = 1024, NPAGES = 128, PAGE = 128, DECB = 8, DECS = 4;
constexpr float EPS = 1e-6f;
constexpr float LOG2E = 1.4426950408889634f;
constexpr float QSCALE = 0.08838834764831845f * LOG2E;
constexpr size_t O_YP = 0, O_YS = 16777216, O_KP = 16842752, O_VP = 25231360, O_KS = 33619968, O_VS = 33652736, O_AV = 33685504,
                 O_PP = 33718272, O_PS = 33779712, O_CP = 33902592, O_CS = 33910784, O_END = 33927168;

constexpr size_t al(size_t x) { return (x + 1048575) & ~(size_t)1048575; }
constexpr size_t WS_CTL = 0, CTL_BYTES = 1048576;
constexpr size_t SZ_WGU = (size_t)2 * FF * DM * 2, SZ_WD = (size_t)DM * FF * 2;
constexpr size_t WS_WGU = al(WS_CTL + CTL_BYTES);
constexpr size_t WS_WD = al(WS_WGU + 4 * SZ_WGU);
constexpr size_t WS_WINE = al(WS_WD + 4 * SZ_WD);
constexpr size_t WS_WOUTE = al(WS_WINE + (size_t)5120 * DM * 2);
constexpr size_t WS_WINO = al(WS_WOUTE + (size_t)DM * DM * 2);
constexpr size_t WS_WOUTO = al(WS_WINO + (size_t)4096 * DM * 2);
constexpr size_t WS_AWS = al(WS_WOUTO + (size_t)DM * DM * 2);
constexpr size_t WS_CWGT = al(WS_AWS + 8 * 128 * 128 * 2);
constexpr size_t WS_XN = al(WS_CWGT + 1024 * 256 * 2);
constexpr size_t WS_ACT = al(WS_XN + (size_t)MT * DM * 2);
constexpr size_t WS_Y = al(WS_ACT + (size_t)MT * FF * 2);
constexpr size_t SZ_T = (size_t)MT * 1024 * 2;
constexpr size_t WS_T0 = al(WS_Y + (size_t)MT * DM * 4);
constexpr size_t WS_T1 = al(WS_T0 + SZ_T);
constexpr size_t WS_T2 = al(WS_T1 + SZ_T);
constexpr size_t WS_T3 = al(WS_T2 + SZ_T);
constexpr size_t WS_T4 = al(WS_T3 + SZ_T);
constexpr size_t WS_MIX = al(WS_T4 + SZ_T);
constexpr size_t WS_PO = al(WS_MIX + (size_t)MT * DM * 2);
constexpr size_t WS_PP = al(WS_PO + (size_t)64 * 32 * 4 * 128 * 4);
constexpr size_t WS_SLAB = al(WS_PP + 64 * 32 * 4 * 4);
constexpr size_t WS_PART = al(WS_SLAB + (size_t)22 * 32 * 2048 * 4);
constexpr size_t WS_XNQ = al(WS_PART + (size_t)MP * 32 * 4);
constexpr size_t WS_END = al(WS_XNQ + (size_t)MT * DM);
constexpr int CW_BAR = 4096, CW_QCTR = 8192, CW_CONV = 9216, CW_GATE = 12288  , CW_SUMSQ = 16384, CW_AVSQ = 16384 + 6 * MT + 512;
static_assert((CW_AVSQ + MT) * 4 <= 1048576, "ctl");

constexpr int RING_BYTES = 131072, RED_OFF = RING_BYTES, RED_BYTES = 8192, MISC_OFF = RED_OFF + RED_BYTES, LDS_BYTES = 147456;

#define LDS_WAIT() asm volatile("s_waitcnt lgkmcnt(0)" ::: "memory")
#define VM_WAIT() asm volatile("s_waitcnt vmcnt(0)" ::: "memory")
__device__ __forceinline__ unsigned cvt_pk_bf16(float lo, float hi) { unsigned r; asm volatile("v_cvt_pk_bf16_f32 %0, %1, %2" : "=v"(r) : "v"(lo), "v"(hi)); return r; }
__device__ __forceinline__ unsigned pk_fp8x4(float a, float b, float c, float d) {
    a = fminf(fmaxf(a, -440.f), 440.f); b = fminf(fmaxf(b, -440.f), 440.f); c = fminf(fmaxf(c, -440.f), 440.f); d = fminf(fmaxf(d, -440.f), 440.f);
    int w = __builtin_amdgcn_cvt_pk_fp8_f32(a, b, 0, false); w = __builtin_amdgcn_cvt_pk_fp8_f32(c, d, w, true); return (unsigned)w;
}
constexpr float S8_W = 64.f, S8_ACT = 8.f;
constexpr float SQ_W = 127.f / 0.0884f;
__host__ __device__ constexpr float sqx_of(int lf) { return 127.f / (lf == 0 ? 4.5f : (lf == 1 ? 5.5f : (lf == 2 ? 6.5f : 7.0f))); }
__device__ __forceinline__ unsigned pk_i8x4(float a, float b, float c, float d) {
    const int ia = (int)__builtin_rintf(fminf(fmaxf(a, -127.f), 127.f)), ib = (int)__builtin_rintf(fminf(fmaxf(b, -127.f), 127.f)),
              ic = (int)__builtin_rintf(fminf(fmaxf(c, -127.f), 127.f)), id = (int)__builtin_rintf(fminf(fmaxf(d, -127.f), 127.f));
    return ((unsigned)ia & 0xffu) | (((unsigned)ib & 0xffu) << 8) | (((unsigned)ic & 0xffu) << 16) | ((unsigned)id << 24);
}
__device__ __forceinline__ float bf_lo(unsigned w) { return __uint_as_float(w << 16); }
__device__ __forceinline__ float bf_hi(unsigned w) { return __uint_as_float(w & 0xffff0000u); }
__device__ __forceinline__ float fast_rcp(float x) { return __builtin_amdgcn_rcpf(x); }
__device__ __forceinline__ float fast_exp2(float x) { return __builtin_amdgcn_exp2f(x); }
__device__ __forceinline__ float gelu_tanh(float x) {
    const float t = x * (1.0f + 0.044715f * x * x) * (-2.0f * 0.7978845608028654f * LOG2E);
    return x * fast_rcp(1.0f + fast_exp2(t));
}
__device__ __forceinline__ float xchg32(float x, int hi) {
    auto rr = __builtin_amdgcn_permlane32_swap(__float_as_uint(x), __float_as_uint(x), false, false);
    return __uint_as_float(hi ? rr[0] : rr[1]);
}

template <int CTRL> __device__ __forceinline__ float dppf(float x) { return __int_as_float(__builtin_amdgcn_update_dpp(0, __float_as_int(x), CTRL, 0xf, 0xf, true)); }
__device__ __forceinline__ float xchg16(float x, bool b4) { auto rr = __builtin_amdgcn_permlane16_swap(__float_as_uint(x), __float_as_uint(x), false, false); return __uint_as_float(b4 ? rr[0] : rr[1]); }
__device__ __forceinline__ float sum_x16(float x) { auto rr = __builtin_amdgcn_permlane16_swap(__float_as_uint(x), __float_as_uint(x), false, false); return __uint_as_float(rr[0]) + __uint_as_float(rr[1]); }
__device__ __forceinline__ float sum_x32(float x) { auto rr = __builtin_amdgcn_permlane32_swap(__float_as_uint(x), __float_as_uint(x), false, false); return __uint_as_float(rr[0]) + __uint_as_float(rr[1]); }
__device__ __forceinline__ float sum_row16(float x) { x += dppf<0xB1>(x); x += dppf<0x4E>(x); x += dppf<0x141>(x); x += dppf<0x140>(x); return x; }
__device__ __forceinline__ int fresh_tid(int wave0) { int l; asm volatile("v_mbcnt_lo_u32_b32 %0, -1, 0\n\tv_mbcnt_hi_u32_b32 %0, -1, %0" : "=v"(l)); return wave0 * 64 + l; }
#define XB_TMO      128
#define XB_XCNT(j)  (256  + 64 * (j))
#define XB_XSUB(j)  (1280 + 64 * (j))
#define XB_XGEN(j)  (2304 + 64 * (j))
#define XB_TOP      3328
#define XB_TOPGEN   3392
#define XCD_BAR_WORDS 3456
#define XB_SPIN_CAP (1u << 22)
__device__ __forceinline__ unsigned xb_ld(unsigned* p)              { return __hip_atomic_load(p, __ATOMIC_RELAXED, __HIP_MEMORY_SCOPE_AGENT); }
__device__ __forceinline__ unsigned xb_add(unsigned* p, unsigned v) { return __hip_atomic_fetch_add(p, v, __ATOMIC_RELAXED, __HIP_MEMORY_SCOPE_AGENT); }
__device__ __forceinline__ unsigned xb_xcc_id() { return (unsigned)__builtin_amdgcn_s_getreg((3 << 11) | 20) & 0xFu; }
#define XB_SPIN(cond, bar) do { unsigned _sp = 0; while (cond) { __builtin_amdgcn_s_sleep(1); \
    if ((++_sp & 255u) == 0u) { if (xb_ld(&(bar)[XB_TMO])) break; if (_sp > XB_SPIN_CAP) { atomicAdd(&(bar)[XB_TMO], 1u); break; } } } } while (0)
struct XcdBarrier { unsigned* bar; unsigned x; volatile LAS unsigned* st; };
__device__ __forceinline__ XcdBarrier xcd_barrier_post(unsigned* bar, volatile LAS unsigned* st, int wave0) {
    XcdBarrier b; b.bar = bar; b.x = (unsigned)wave0; b.st = st;
    if (fresh_tid(wave0) == 0) (void)xb_add(&bar[XB_XCNT(xb_xcc_id())], 1u);
    return b;
}
__device__ __forceinline__ void xcd_barrier_complete(unsigned* bar, unsigned x, unsigned& nloc, unsigned& nx) {
    const unsigned G = gridDim.x * gridDim.y * gridDim.z;
    unsigned sum, cnt, mine, sp = 0u;
    for (;;) {
        sum = 0u; cnt = 0u; mine = 0u;
#pragma unroll
        for (unsigned j = 0; j < 16; ++j) { const unsigned c = xb_ld(&bar[XB_XCNT(j)]); sum += c; cnt += (c > 0u) ? 1u : 0u; }
        mine = xb_ld(&bar[XB_XCNT(x)]);
        if (sum == G) break;
        __builtin_amdgcn_s_sleep(1);
        if ((++sp & 255u) == 0u) { if (xb_ld(&bar[XB_TMO])) break; if (sp > XB_SPIN_CAP) { atomicAdd(&bar[XB_TMO], 1u); break; } }
    }
    nloc = mine > 0u ? mine : 1u; nx = cnt > 0u ? cnt : 1u;
}
__device__ __forceinline__ void xcd_barrier1(const XcdBarrier& b) {
    asm volatile("s_waitcnt vmcnt(0)" ::: "memory");
    __syncthreads();
    if (fresh_tid((int)b.x) == 0) {
        unsigned* bar = b.bar; asm volatile("" : "+s"(bar));
        unsigned bx_; asm volatile("s_getreg_b32 %0, hwreg(20, 0, 4)" : "=s"(bx_));
        bx_ &= 0xFu;
        __builtin_amdgcn_s_waitcnt(0);
        asm volatile("buffer_inv sc1" ::: "memory");
        unsigned nloc = b.st[0], nx = b.st[1];
        if (nloc == 0u) { xcd_barrier_complete(bar, bx_, nloc, nx); b.st[0] = nloc; b.st[1] = nx; }
        const unsigned old = xb_add(&bar[XB_XSUB(bx_)], 1u);
        const unsigned gen = old / nloc;
        if (old + 1u == (gen + 1u) * nloc) {
            __builtin_amdgcn_fence(__ATOMIC_RELEASE, "agent");
            asm volatile("s_waitcnt vmcnt(0)" ::: "memory");
            const unsigned og = xb_add(&bar[XB_TOP], 1u);
            const unsigned tg = og / nx;
            if (og + 1u == (tg + 1u) * nx) xb_add(&bar[XB_TOPGEN], 1u);
            else XB_SPIN(xb_ld(&bar[XB_TOPGEN]) == tg, bar);
            asm volatile("" ::: "memory");
            xb_add(&bar[XB_XGEN(bx_)], 1u);
            asm volatile("s_waitcnt vmcnt(0)" ::: "memory");
        } else {
            XB_SPIN(xb_ld(&bar[XB_XGEN(bx_)]) == gen, bar);
            asm volatile("s_waitcnt vmcnt(0)" ::: "memory");
        }
    }
    __syncthreads();
}

__device__ __forceinline__ void xcd_barrier(const XcdBarrier& b) { for (int r = 0; r < REP_BAR; ++r) xcd_barrier1(b); }
namespace pg8 {
constexpr int BM = 256, BK = 64, HALF = 128, HTB = HALF * BK * 2, NXCD = 8, WGM = 8;
__host__ __device__ __forceinline__ int lds_byte(int r, int c) { const int st = (r >> 4) * 2 + (c >> 5), rr = r & 15, cc = c & 31, ob = rr * 64 + cc * 2; return st * 1024 + (ob ^ (((ob >> 9) & 1) << 5)); }
__host__ __device__ __forceinline__ void stage_rc(int b, int& R, int& C) { const int st = b / 1024, sb = b % 1024, swz = sb ^ (((sb >> 9) & 1) << 5); R = (st >> 1) * 16 + swz / 64; C = (st & 1) * 32 + (swz % 64) / 2; }
__host__ __device__ __forceinline__ int perm32(int rho) { const int n = rho >> 4, i = rho & 15; return 8 * (i >> 2) + 4 * n + (i & 3); }
struct Unit { int pm, pn, kt0, nkt; };
struct Gemm { const void* A; const void* Bt; int lda, ldb, K, acs; };
struct StaticOrder {
    int nM, nN, nwg, G, c, S, ntk, i0 = 0, dpm = -1, dpn = 0; bool same = false;
    __device__ __forceinline__ void init(int nM_, int nN_, int G_, int c_, int S_ = 0, int ntk_ = 0) { asm volatile("" : "+s"(G_), "+s"(c_)); nM = nM_; nN = nN_; nwg = nM * nN; G = G_; c = c_; S = S_; ntk = ntk_; }
    __device__ __forceinline__ bool next(int i, Unit& u) const {
        if (dpm >= 0) { u.pm = dpm; u.pn = dpn; u.kt0 = 0; u.nkt = ntk; return i == 0; }
        const long L = (long)(i + i0) * G + c;
        const bool is_main = L < nwg;
        const int s = (int)(L - nwg), Sd = S > 0 ? S : 1;
        if (!is_main && s >= nN * S) return false;
        int wgid = is_main ? (int)L : 0; { const int q = nwg / NXCD, r = nwg % NXCD, xcd = wgid % NXCD, off = wgid / NXCD; wgid = (xcd < r ? xcd * (q + 1) : r * (q + 1) + (xcd - r) * q) + off; }
        const int nig = WGM * nN, gid = wgid / nig, fm = gid * WGM, gsz = (nM - fm) < WGM ? (nM - fm) : WGM;
        const int nks = ntk / Sd;
        u.pm = is_main ? fm + ((wgid % nig) % gsz) : 32; u.pn = is_main ? (wgid % nig) / gsz : s % nN;
        u.kt0 = is_main ? 0 : (s / nN) * nks; u.nkt = is_main ? ntk : nks; if (same) { u.pm = 0; u.pn = 0; } return true;
    }
};
template <class Epi, int MODE = 0  >
__device__ __forceinline__ void gemm_phase(LAS unsigned char* lds, const Gemm g, const StaticOrder& S, const Epi& E, int wave0, unsigned* gate = nullptr, unsigned need = 0u) {
    const int tid = fresh_tid(wave0);
    const int wid = __builtin_amdgcn_readfirstlane(tid >> 6), lane = tid & 63, wr = wid >> 2, wc = wid & 3, fr = lane & 15, fq = lane >> 4;
    int K = g.K, lda_ = g.lda, ldb_ = g.ldb; asm volatile("" : "+s"(K), "+s"(lda_), "+s"(ldb_));
    unsigned voffA[2], voffB[2];
#pragma unroll
    for (int i = 0; i < 2; ++i) { int R, C; stage_rc(tid * 16 + i * 8192, R, C); const int Rb = (R & ~31) + perm32(R & 31);
        voffA[i] = (unsigned)(R * lda_ + C * 2); voffB[i] = (unsigned)(Rb * ldb_ + C * 2); }
    const size_t kstep = (size_t)(BK * 2);
    const size_t hstepA = (size_t)HALF * lda_, hstepB = (size_t)HALF * ldb_;
    const size_t tstepA = 2 * hstepA, tstepB = 2 * hstepB;
    const unsigned ldsw = (unsigned)wid * 1024u;
    const int aoff = lds_byte(wr * 64 + fr, fq * 8), boff = lds_byte(wc * 32 + fr, fq * 8);
#define PG8_SA(b, h) (((b) * 2 + (h)) * HTB)
#define PG8_SB(b, h) ((4 + (b) * 2 + (h)) * HTB)
#define PG8_STAGE(bufoff, gbase, voff) do { _Pragma("unroll") for (int _i = 0; _i < 2; ++_i) \
        __builtin_amdgcn_global_load_lds((const GAS unsigned*)((gbase) + (voff)[_i]), (LAS unsigned*)(lds + (bufoff) + ldsw + _i * 8192), 16, 0, 0); } while (0)
#define PG8_LDA(dst, b, h) do { _Pragma("unroll") for (int m = 0; m < 4; ++m) _Pragma("unroll") for (int k = 0; k < 2; ++k) dst[m][k] = *(const LAS bf16x8*)(lds + PG8_SA(b, h) + aoff + m * 2048 + k * 1024); } while (0)
#define PG8_LDB(dst, b, h) do { _Pragma("unroll") for (int n = 0; n < 2; ++n) _Pragma("unroll") for (int k = 0; k < 2; ++k) dst[n][k] = *(const LAS bf16x8*)(lds + PG8_SB(b, h) + boff + n * 2048 + k * 1024); } while (0)
#define PG8_MMA(ai, bj, At, Bt) do { __builtin_amdgcn_s_setprio(1); _Pragma("unroll") for (int m = 0; m < 4; ++m) _Pragma("unroll") for (int n = 0; n < 2; ++n) { \
        if constexpr (MODE == 2) { typedef int v4i_ __attribute__((ext_vector_type(4))); \
            _Pragma("unroll") for (int k = 0; k < 2; ++k) acc[ai][bj][m][n] = __builtin_bit_cast(f32x4, __builtin_amdgcn_mfma_i32_16x16x64_i8(__builtin_bit_cast(v4i_, Bt[n][k]), __builtin_bit_cast(v4i_, At[m][k]), __builtin_bit_cast(v4i_, acc[ai][bj][m][n]), 0, 0, 0)); \
        } else if constexpr (MODE == 1) { typedef int v8i_ __attribute__((ext_vector_type(8))); typedef int v4i_ __attribute__((ext_vector_type(4))); \
            const v4i_ b0_ = __builtin_bit_cast(v4i_, Bt[n][0]), b1_ = __builtin_bit_cast(v4i_, Bt[n][1]), a0_ = __builtin_bit_cast(v4i_, At[m][0]), a1_ = __builtin_bit_cast(v4i_, At[m][1]); \
            const v8i_ bb_ = {b0_[0], b0_[1], b0_[2], b0_[3], b1_[0], b1_[1], b1_[2], b1_[3]}, aa_ = {a0_[0], a0_[1], a0_[2], a0_[3], a1_[0], a1_[1], a1_[2], a1_[3]}; \
            acc[ai][bj][m][n] = __builtin_amdgcn_mfma_scale_f32_16x16x128_f8f6f4(bb_, aa_, acc[ai][bj][m][n], 0, 0, 0, 0x7f7f7f7f, 0, 0x7f7f7f7f); \
        } else { _Pragma("unroll") for (int k = 0; k < 2; ++k) acc[ai][bj][m][n] = __builtin_amdgcn_mfma_f32_16x16x32_bf16(Bt[n][k], At[m][k], acc[ai][bj][m][n], 0, 0, 0); } } \
        __builtin_amdgcn_s_setprio(0); } while (0)
#define PG8_WAIT_V(n) asm volatile("s_waitcnt vmcnt(" #n ")" ::: "memory")
#define PG8_WAIT_L(n) asm volatile("s_waitcnt lgkmcnt(" #n ")" ::: "memory")
#define PG8_BAR __builtin_amdgcn_s_barrier()
#define PG8_SCHED __builtin_amdgcn_sched_barrier(0)
    Unit cur, nxt; int ui = 0;
    if (!S.next(0, cur)) return;
    f32x4 acc[2][2][4][2];
#pragma unroll
    for (int a = 0; a < 2; ++a)
#pragma unroll
        for (int b = 0; b < 2; ++b)
#pragma unroll
            for (int m = 0; m < 4; ++m)
#pragma unroll
                for (int n = 0; n < 2; ++n) acc[a][b][m][n] = (f32x4){0.f, 0.f, 0.f, 0.f};
    bf16x8 At[4][2], B0[2][2], B1[2][2];
    const GAS char* cA = (const GAS char*)g.A + (size_t)cur.pm * tstepA + (size_t)cur.pn * g.acs + (size_t)cur.kt0 * kstep; const GAS char* cB = (const GAS char*)g.Bt + (size_t)cur.pn * tstepB + (size_t)cur.kt0 * kstep;
    PG8_STAGE(PG8_SB(0, 0), cB, voffB); PG8_STAGE(PG8_SB(0, 1), cB + hstepB, voffB); PG8_STAGE(PG8_SA(0, 0), cA, voffA); PG8_STAGE(PG8_SA(0, 1), cA + hstepA, voffA);
    if (wr == 1) PG8_BAR;
    PG8_WAIT_V(2); PG8_BAR;
    PG8_STAGE(PG8_SB(1, 0), cB + kstep, voffB); PG8_STAGE(PG8_SA(1, 0), cA + kstep, voffA); PG8_STAGE(PG8_SB(1, 1), cB + hstepB + kstep, voffB);
    PG8_WAIT_V(6); PG8_BAR;
    for (;;) {
        const bool has_next = S.next(ui + 1, nxt);
        const GAS char* nA = has_next ? (const GAS char*)g.A + (size_t)nxt.pm * tstepA + (size_t)nxt.pn * g.acs + (size_t)nxt.kt0 * kstep : cA; const GAS char* nB = has_next ? (const GAS char*)g.Bt + (size_t)nxt.pn * tstepB + (size_t)nxt.kt0 * kstep : cB;
        const int nt = cur.nkt;
        for (int t = 0; t < nt; t += 2) {
            asm volatile("" : "+v"(voffA[0]), "+v"(voffA[1]), "+v"(voffB[0]), "+v"(voffB[1]));
            const bool last = (t == nt - 2);
            const GAS char* a1 = cA + (size_t)(t + 1) * kstep;
            const GAS char* a2 = last ? nA : cA + (size_t)(t + 2) * kstep; const GAS char* b2 = last ? nB : cB + (size_t)(t + 2) * kstep;
            const GAS char* a3 = a2 + kstep; const GAS char* b3 = b2 + kstep;
            PG8_LDB(B0, 0, 0); PG8_LDB(B1, 0, 1); PG8_SCHED; PG8_LDA(At, 0, 0); PG8_STAGE(PG8_SA(1, 1), a1 + hstepA, voffA);
            PG8_WAIT_V(8); PG8_WAIT_L(0); PG8_BAR; PG8_MMA(0, 0, At, B0); PG8_MMA(0, 1, At, B1); PG8_BAR; PG8_SCHED;
            PG8_LDA(At, 0, 1); PG8_STAGE(PG8_SB(0, 0), b2, voffB); PG8_STAGE(PG8_SB(0, 1), b2 + hstepB, voffB); PG8_STAGE(PG8_SA(0, 0), a2, voffA);
            PG8_WAIT_V(8); PG8_WAIT_L(0); PG8_BAR; PG8_MMA(1, 0, At, B0); PG8_MMA(1, 1, At, B1); PG8_BAR; PG8_SCHED;
            PG8_LDB(B0, 1, 0); PG8_LDB(B1, 1, 1); PG8_SCHED; PG8_LDA(At, 1, 0); PG8_STAGE(PG8_SA(0, 1), a2 + hstepA, voffA);
            PG8_WAIT_V(8); PG8_WAIT_L(0); PG8_BAR; PG8_MMA(0, 0, At, B0); PG8_MMA(0, 1, At, B1); PG8_BAR; PG8_SCHED;
            PG8_LDA(At, 1, 1); PG8_STAGE(PG8_SB(1, 0), b3, voffB); PG8_STAGE(PG8_SB(1, 1), b3 + hstepB, voffB); PG8_STAGE(PG8_SA(1, 0), a3, voffA);
            PG8_WAIT_V(8); PG8_WAIT_L(0); PG8_BAR; PG8_MMA(1, 0, At, B0); PG8_MMA(1, 1, At, B1); PG8_BAR; PG8_SCHED;
        }
        if (wr == 0) PG8_BAR;
        if (gate != nullptr && ui == 0) {
            if (wid == 0) {
                unsigned sp = 0u; while (xb_ld(gate) < need) { __builtin_amdgcn_s_sleep(2); if (++sp > XB_SPIN_CAP) break; }
                __builtin_amdgcn_fence(__ATOMIC_ACQUIRE, "agent"); asm volatile("s_waitcnt vmcnt(0)" ::: "memory");
            }
            asm volatile("" ::: "memory"); PG8_BAR; asm volatile("" ::: "memory");
        }
        { int fr2 = fr, fq2 = fq; asm volatile("" : "+v"(fr2), "+v"(fq2));
          E(acc, cur, wr, wc, fr2, fq2); }
        if (!has_next) break;
#pragma unroll
        for (int a = 0; a < 2; ++a)
#pragma unroll
            for (int b = 0; b < 2; ++b)
#pragma unroll
                for (int m = 0; m < 4; ++m)
#pragma unroll
                    for (int n = 0; n < 2; ++n) acc[a][b][m][n] = (f32x4){0.f, 0.f, 0.f, 0.f};
        cur = nxt; cA = nA; cB = nB; ++ui;
        if (wr == 1) PG8_BAR;
    }
    PG8_WAIT_V(0);
    PG8_BAR;
#undef PG8_SA
#undef PG8_SB
#undef PG8_STAGE
#undef PG8_LDA
#undef PG8_LDB
#undef PG8_MMA
#undef PG8_WAIT_V
#undef PG8_WAIT_L
#undef PG8_BAR
#undef PG8_SCHED
}

template <int IN  , bool OUT8> struct EpiUpT {
    void* ACT; const float* sumsq; float inq;
    __device__ __forceinline__ void operator()(const f32x4 (&acc)[2][2][4][2], const Unit& u, int wr, int wc, int fr, int fq) const {
        const int row0 = u.pm * BM + wr * 64 + fr, col0 = u.pn * 128 + wc * 32 + 8 * fq;
        float rs[2][4];
#pragma unroll
        for (int ai = 0; ai < 2; ++ai)
#pragma unroll
            for (int m = 0; m < 4; ++m) rs[ai][m] = sumsq[row0 + ai * HALF + m * 16];
#pragma unroll
        for (int ai = 0; ai < 2; ++ai)
#pragma unroll
            for (int m = 0; m < 4; ++m) {
                const int row = row0 + ai * HALF + m * 16;
                const float r = __builtin_amdgcn_rsqf(rs[ai][m] * (1.0f / DM) + EPS) * (IN == 2 ? inq : 1.0f);
                const float rg = r * -LOG2E, ru = r * ((OUT8 ? S8_ACT : 1.0f) * (-1.0f / LOG2E));
                float o[8];
#pragma unroll
                for (int n = 0; n < 2; ++n)
#pragma unroll
                    for (int j = 0; j < 4; j += 2) {
                        f32x2 gi, ui;
                        gi[0] = (IN == 2 ? (float)__float_as_int(acc[ai][0][m][n][j]) : acc[ai][0][m][n][j]); gi[1] = (IN == 2 ? (float)__float_as_int(acc[ai][0][m][n][j + 1]) : acc[ai][0][m][n][j + 1]);
                        ui[0] = (IN == 2 ? (float)__float_as_int(acc[ai][1][m][n][j]) : acc[ai][1][m][n][j]); ui[1] = (IN == 2 ? (float)__float_as_int(acc[ai][1][m][n][j + 1]) : acc[ai][1][m][n][j + 1]);
                        const f32x2 t = gi * rg, us = ui * ru, p = t * us;
                        f32x2 e; e[0] = fast_exp2(t[0]); e[1] = fast_exp2(t[1]);
                        const f32x2 d = e + 1.0f;
                        f32x2 rc; rc[0] = fast_rcp(d[0]); rc[1] = fast_rcp(d[1]);
                        const f32x2 o2 = p * rc;
                        o[n * 4 + j] = o2[0]; o[n * 4 + j + 1] = o2[1];
                    }
                if constexpr (OUT8) { u32x2 w; w.x = pk_fp8x4(o[0], o[1], o[2], o[3]); w.y = pk_fp8x4(o[4], o[5], o[6], o[7]);
                    *(u32x2*)((unsigned char*)ACT + (size_t)row * FF + col0) = w; }
                else { u32x4 w; w.x = cvt_pk_bf16(o[0], o[1]); w.y = cvt_pk_bf16(o[2], o[3]); w.z = cvt_pk_bf16(o[4], o[5]); w.w = cvt_pk_bf16(o[6], o[7]);
                    *(u32x4*)((bf16_t*)ACT + (size_t)row * FF + col0) = w; }
            }
    }
};
struct EpiRes {
    const float* base; float* out; bf16_t* XN; float* PART; float alpha_; float* SLAB; unsigned char* XN8 = nullptr; float sqx = 1.f;
    __device__ __forceinline__ void operator()(const f32x4 (&acc)[2][2][4][2], const Unit& u, int wr, int wc, int fr, int fq) const {
        const int col0 = u.pn * BM + wc * 32 + 8 * fq;
        const float alpha = alpha_;
        if (u.pm == 32) {
            if (wr == 0) {
                float* sl = SLAB + (size_t)(u.kt0 / u.nkt) * (MS * DM);
#pragma unroll
                for (int m = 0; m < 2; ++m)
#pragma unroll
                    for (int bj = 0; bj < 2; ++bj)
#pragma unroll
                        for (int n = 0; n < 2; ++n) *(f32x4*)(sl + (size_t)(m * 16 + fr) * DM + col0 + bj * HALF + n * 4) = acc[0][bj][m][n];
            }
            return;
        }
        const int row0 = u.pm * BM + wr * 64 + fr;
#pragma unroll
        for (int ai = 0; ai < 2; ++ai) {
            f32x4 bv[4][2][2];
#pragma unroll
            for (int m = 0; m < 4; ++m)
#pragma unroll
                for (int bj = 0; bj < 2; ++bj) { const float* bp = base + (size_t)(row0 + ai * HALF + m * 16) * DM + col0 + bj * HALF; bv[m][bj][0] = *(const f32x4*)bp; bv[m][bj][1] = *(const f32x4*)(bp + 4); }
#pragma unroll
            for (int m = 0; m < 4; ++m) {
                const int row = row0 + ai * HALF + m * 16; const size_t off = (size_t)row * DM + col0;
                float ss = 0.f;
#pragma unroll
                for (int bj = 0; bj < 2; ++bj) {
                    const f32x4 v0 = bv[m][bj][0] + acc[ai][bj][m][0] * alpha, v1 = bv[m][bj][1] + acc[ai][bj][m][1] * alpha;
                    *(f32x4*)(out + off + bj * HALF) = v0; *(f32x4*)(out + off + bj * HALF + 4) = v1;
                    if (XN8) { u32x2 w8; w8.x = pk_i8x4(v0[0] * sqx, v0[1] * sqx, v0[2] * sqx, v0[3] * sqx); w8.y = pk_i8x4(v1[0] * sqx, v1[1] * sqx, v1[2] * sqx, v1[3] * sqx);
                        *(u32x2*)(XN8 + off + bj * HALF) = w8; }
                    else { u32x4 w; w.x = cvt_pk_bf16(v0[0], v0[1]); w.y = cvt_pk_bf16(v0[2], v0[3]); w.z = cvt_pk_bf16(v1[0], v1[1]); w.w = cvt_pk_bf16(v1[2], v1[3]);
                        *(u32x4*)(XN + off + bj * HALF) = w; }
                    ss += (v0[0] * v0[0] + v0[1] * v0[1]) + (v0[2] * v0[2] + v0[3] * v0[3]) + (v1[0] * v1[0] + v1[1] * v1[1]) + (v1[2] * v1[2] + v1[3] * v1[3]);
                }
                ss = sum_x32(sum_x16(ss));
                if (fq == 0) PART[(size_t)row * 32 + u.pn * 4 + wc] = ss;
            }
            asm volatile("" ::: "memory");
        }
    }
};
struct EpiInEven {
    const float* sumsq; bf16_t *Q, *Kb, *V, *AU, *AV; float* dout; const float *qg, *kg; float* avsq; LAS float* red;
    __device__ __forceinline__ void operator()(const f32x4 (&acc)[2][2][4][2], const Unit& u, int wr, int wc, int fr, int fq) const {
        const int seg = u.pn >> 2, ct = (u.pn & 3) * BM;
        const int row0 = u.pm * BM + wr * 64 + fr, cw = wc * 32 + 8 * fq;
        float rs[2][4];
#pragma unroll
        for (int ai = 0; ai < 2; ++ai)
#pragma unroll
            for (int m = 0; m < 4; ++m) rs[ai][m] = __builtin_amdgcn_rsqf(sumsq[row0 + ai * HALF + m * 16] * (1.0f / DM) + EPS);
        if (seg < 2) {
#pragma unroll
            for (int ai = 0; ai < 2; ++ai)
#pragma unroll
                for (int m = 0; m < 4; ++m)
#pragma unroll
                    for (int bj = 0; bj < 2; ++bj) {
                        const f32x4 a = acc[ai][bj][m][0], b = acc[ai][bj][m][1];
                        float s = (a[0] * a[0] + a[1] * a[1]) + (a[2] * a[2] + a[3] * a[3]) + (b[0] * b[0] + b[1] * b[1]) + (b[2] * b[2] + b[3] * b[3]);
                        s = sum_x32(sum_x16(s));
                        if (fq == 0) red[((ai * HALF + wr * 64 + m * 16 + fr) * 2 + bj) * 4 + wc] = s;
                    }
            LDS_WAIT(); __builtin_amdgcn_s_barrier(); asm volatile("" ::: "memory");
            const float* gn = seg == 0 ? qg : kg;
            f32x4 g0 = *(const f32x4*)(gn + cw), g1 = *(const f32x4*)(gn + cw + 4);
            if (seg == 0) { g0 = g0 * QSCALE; g1 = g1 * QSCALE; }
            bf16_t* dst = seg == 0 ? Q : Kb;
#pragma unroll
            for (int ai = 0; ai < 2; ++ai)
#pragma unroll
                for (int m = 0; m < 4; ++m) {
                    const int row = row0 + ai * HALF + m * 16; const float r = rs[ai][m];
#pragma unroll
                    for (int bj = 0; bj < 2; ++bj) {
                        const f32x4 p = *(const LAS f32x4*)(red + ((ai * HALF + wr * 64 + m * 16 + fr) * 2 + bj) * 4);
                        const float ms = ((p[0] + p[1]) + (p[2] + p[3])) * r * r * (1.0f / HD);
                        const float sc = r * __builtin_amdgcn_rsqf(ms + EPS);
                        const f32x4 v0 = acc[ai][bj][m][0] * sc * g0, v1 = acc[ai][bj][m][1] * sc * g1;
                        const int col = ct + bj * HALF + cw;
                        u32x4 w; w.x = cvt_pk_bf16(v0[0], v0[1]); w.y = cvt_pk_bf16(v0[2], v0[3]); w.z = cvt_pk_bf16(v1[0], v1[1]); w.w = cvt_pk_bf16(v1[2], v1[3]);
                        *(u32x4*)(dst + (size_t)row * 1024 + col) = w;
                        if (seg == 1 && row < MP + MS) {
                            float* o = dout + (row < MP ? O_KP + (size_t)row * 1024 : O_KS + (size_t)(row - MP) * 1024) + col;
                            __builtin_nontemporal_store(v0, (f32x4*)o); __builtin_nontemporal_store(v1, (f32x4*)(o + 4));
                        }
                    }
                }
        } else if (seg == 2) {
#pragma unroll
            for (int ai = 0; ai < 2; ++ai)
#pragma unroll
                for (int m = 0; m < 4; ++m) {
                    const int row = row0 + ai * HALF + m * 16; const float r = rs[ai][m];
#pragma unroll
                    for (int bj = 0; bj < 2; ++bj) {
                        const f32x4 v0 = acc[ai][bj][m][0] * r, v1 = acc[ai][bj][m][1] * r;
                        const int col = ct + bj * HALF + cw;
                        u32x4 w; w.x = cvt_pk_bf16(v0[0], v0[1]); w.y = cvt_pk_bf16(v0[2], v0[3]); w.z = cvt_pk_bf16(v1[0], v1[1]); w.w = cvt_pk_bf16(v1[2], v1[3]);
                        *(u32x4*)(V + (size_t)row * 1024 + col) = w;
                        if (row < MP + MS) {
                            float* o = dout + (row < MP ? O_VP + (size_t)row * 1024 : O_VS + (size_t)(row - MP) * 1024) + col;
                            __builtin_nontemporal_store(v0, (f32x4*)o); __builtin_nontemporal_store(v1, (f32x4*)(o + 4));
                        }
                    }
                }
        } else {
            bf16_t* dst = seg == 3 ? AU : AV;
#pragma unroll
            for (int ai = 0; ai < 2; ++ai)
#pragma unroll
                for (int m = 0; m < 4; ++m) {
                    const int row = row0 + ai * HALF + m * 16; const float r = rs[ai][m];
                    float ss = 0.f;
#pragma unroll
                    for (int bj = 0; bj < 2; ++bj) {
                        float o[8];
#pragma unroll
                        for (int n = 0; n < 2; ++n)
#pragma unroll
                            for (int j = 0; j < 4; ++j) { o[n * 4 + j] = gelu_tanh(acc[ai][bj][m][n][j] * r); ss += o[n * 4 + j] * o[n * 4 + j]; }
                        const int col = ct + bj * HALF + cw;
                        u32x4 w; w.x = cvt_pk_bf16(o[0], o[1]); w.y = cvt_pk_bf16(o[2], o[3]); w.z = cvt_pk_bf16(o[4], o[5]); w.w = cvt_pk_bf16(o[6], o[7]);
                        *(u32x4*)(dst + (size_t)row * 1024 + col) = w;
                    }
                    if (seg == 4) { ss = sum_x32(sum_x16(ss)); if (fq == 0) atomicAdd(avsq + row, ss); }
                }
        }
    }
};
struct EpiInOdd {
    const float* sumsq; bf16_t *XC, *GB, *G; float* dout; float* SP;
    __device__ __forceinline__ void operator()(const f32x4 (&acc)[2][2][4][2], const Unit& u, int wr, int wc, int fr, int fq) const {
        const int row0 = u.pm * BM + wr * 64 + fr, cw = wc * 32 + 8 * fq;
        if (u.pm == 32) {
            if (wr == 0) {
                float* sl = SP + (size_t)(u.kt0 / u.nkt) * (MS * 4096);
#pragma unroll
                for (int m = 0; m < 2; ++m)
#pragma unroll
                    for (int bj = 0; bj < 2; ++bj)
#pragma unroll
                        for (int n = 0; n < 2; ++n) *(f32x4*)(sl + (size_t)(m * 16 + fr) * 4096 + u.pn * BM + bj * HALF + cw + n * 4) = acc[0][bj][m][n];
            }
            return;
        }
        if (u.pn < 8) {
            const int ct = (u.pn & 3) * BM; bf16_t* dst = u.pn < 4 ? XC : GB;
#pragma unroll
            for (int ai = 0; ai < 2; ++ai)
#pragma unroll
                for (int m = 0; m < 4; ++m) {
                    const int row = row0 + ai * HALF + m * 16; const float r = __builtin_amdgcn_rsqf(sumsq[row] * (1.0f / DM) + EPS);
#pragma unroll
                    for (int bj = 0; bj < 2; ++bj) {
                        const f32x4 v0 = acc[ai][bj][m][0] * r, v1 = acc[ai][bj][m][1] * r;
                        const int col = ct + bj * HALF + cw;
                        u32x4 w; w.x = cvt_pk_bf16(v0[0], v0[1]); w.y = cvt_pk_bf16(v0[2], v0[3]); w.z = cvt_pk_bf16(v1[0], v1[1]); w.w = cvt_pk_bf16(v1[2], v1[3]);
                        *(u32x4*)(dst + (size_t)row * 1024 + col) = w;
                        if (u.pn < 4) {
                            float* o = nullptr;
                            if (row < MP) { const int t = row & (SEQ - 1); if (t >= SEQ - 15) o = dout + O_PP + ((size_t)(row >> 11) * 15 + (t - (SEQ - 15))) * 1024 + col; }
                            else if (row < MP + MS) { const int sr = row - MP; o = dout + O_PS + ((size_t)(sr >> 2) * 15 + 11 + (sr & 3)) * 1024 + col; }
                            if (o) { *(f32x4*)o = v0; *(f32x4*)(o + 4) = v1; }
                        }
                    }
                }
        } else {
            const int col = (u.pn - 8) * 128 + cw;
#pragma unroll
            for (int ai = 0; ai < 2; ++ai)
#pragma unroll
                for (int m = 0; m < 4; ++m) {
                    const int row = row0 + ai * HALF + m * 16; const float r = __builtin_amdgcn_rsqf(sumsq[row] * (1.0f / DM) + EPS); const float r2 = r * r;
                    const f32x4 v0 = acc[ai][0][m][0] * acc[ai][1][m][0] * r2, v1 = acc[ai][0][m][1] * acc[ai][1][m][1] * r2;
                    u32x4 w; w.x = cvt_pk_bf16(v0[0], v0[1]); w.y = cvt_pk_bf16(v0[2], v0[3]); w.z = cvt_pk_bf16(v1[0], v1[1]); w.w = cvt_pk_bf16(v1[2], v1[3]);
                    *(u32x4*)(G + (size_t)row * 1024 + col) = w;
                    float* o = nullptr;
                    if (row < MP) { const int t = row & (SEQ - 1); if (t >= SEQ - 2) o = dout + O_CP + ((size_t)(row >> 11) * 2 + (t - (SEQ - 2))) * 1024 + col; }
                    else if (row < MP + MS) { const int sr = row - MP; if ((sr & 3) >= 2) o = dout + O_CS + ((size_t)(sr >> 2) * 2 + ((sr & 3) - 2)) * 1024 + col; }
                    if (o) { *(f32x4*)o = v0; *(f32x4*)(o + 4) = v1; }
                }
        }
    }
};
struct EpiPool {
    bf16_t* MIX; const float* cscale;
    __device__ __forceinline__ void operator()(const f32x4 (&acc)[2][2][4][2], const Unit& u, int wr, int wc, int fr, int fq) const {
        const int row0 = u.pm * BM + wr * 64 + fr, col0 = u.pn * BM + wc * 32 + 8 * fq;
#pragma unroll
        for (int bj = 0; bj < 2; ++bj) {
            const f32x4 s0 = *(const f32x4*)(cscale + col0 + bj * HALF), s1 = *(const f32x4*)(cscale + col0 + bj * HALF + 4);
#pragma unroll
            for (int ai = 0; ai < 2; ++ai)
#pragma unroll
                for (int m = 0; m < 4; ++m) {
                    const int row = row0 + ai * HALF + m * 16;
                    const f32x4 v0 = acc[ai][bj][m][0] * s0, v1 = acc[ai][bj][m][1] * s1;
                    u32x4 w; w.x = cvt_pk_bf16(v0[0], v0[1]); w.y = cvt_pk_bf16(v0[2], v0[3]); w.z = cvt_pk_bf16(v1[0], v1[1]); w.w = cvt_pk_bf16(v1[2], v1[3]);
                    *(u32x4*)(MIX + (size_t)row * DM + col0 + bj * HALF) = w;
                }
        }
    }
};
}

namespace sba {
constexpr int SHM_K = 64 * 128 * 2, SHM_V = SHM_K;
#define KSWZ(row, colB) ((row) * 256 + ((colB) ^ (((row) & 7) << 4)))
#define SBAR() __builtin_amdgcn_sched_barrier(0)
__device__ __forceinline__ int crow(int r, int hi) { return (r & 3) + 8 * (r >> 2) + 4 * hi; }
__device__ __forceinline__ int v_st(int k, int c) { const int kk = (k & ~0xC) | ((k & 4) << 1) | ((k & 8) >> 1); return ((kk >> 3) * 4 + (c >> 5)) * 512 + ((kk & 7) * 32 + (c & 31)) * 2; }
__device__ __forceinline__ int v_rd_base(int lane) { return ((lane & 3) << 3) | (((lane >> 2) & 3) << 6) | (((lane >> 4) & 1) << 5) | (((lane >> 5) & 1) << 8); }
constexpr int v_rd_off(int d0, int ks, int half) { return d0 * 512 + ks * 4096 + half * 2048; }
template <int OFF> __device__ __forceinline__ s16x4 tr_read(int vb) {
    s16x4 r; asm volatile("ds_read_b64_tr_b16 %0, %1 offset:%2" : "=&v"(r) : "v"(vb), "i"(OFF) : "memory"); return r;
}
template <int D0> __device__ __forceinline__ void pv_one(f32x16& od, int vb, bf16x8 pa0, bf16x8 pa1, bf16x8 pa2, bf16x8 pa3) {
    const s16x4 l0 = tr_read<v_rd_off(D0, 0, 0)>(vb), h0 = tr_read<v_rd_off(D0, 0, 1)>(vb), l1 = tr_read<v_rd_off(D0, 1, 0)>(vb), h1 = tr_read<v_rd_off(D0, 1, 1)>(vb);
    const s16x4 l2 = tr_read<v_rd_off(D0, 2, 0)>(vb), h2 = tr_read<v_rd_off(D0, 2, 1)>(vb), l3 = tr_read<v_rd_off(D0, 3, 0)>(vb), h3 = tr_read<v_rd_off(D0, 3, 1)>(vb);
    asm volatile("s_waitcnt lgkmcnt(0)" ::: "memory"); SBAR();
#define PK(L, H) (bf16x8){L[0], L[1], L[2], L[3], H[0], H[1], H[2], H[3]}
    od = __builtin_amdgcn_mfma_f32_32x32x16_bf16(pa0, PK(l0, h0), od, 0, 0, 0);
    od = __builtin_amdgcn_mfma_f32_32x32x16_bf16(pa1, PK(l1, h1), od, 0, 0, 0);
    od = __builtin_amdgcn_mfma_f32_32x32x16_bf16(pa2, PK(l2, h2), od, 0, 0, 0);
    od = __builtin_amdgcn_mfma_f32_32x32x16_bf16(pa3, PK(l3, h3), od, 0, 0, 0);
#undef PK
}
__device__ __forceinline__ void qkt(f32x16& p0, f32x16& p1, const char* Ks, const bf16x8 (&qr)[8], int r32, int hi) {
    p0 = f32x16{}; p1 = f32x16{};
#pragma unroll
    for (int d0 = 0; d0 < 8; ++d0) { const int cb = (d0 * 16 + hi * 8) * 2;
        const bf16x8 b0 = *reinterpret_cast<const bf16x8*>(Ks + KSWZ(r32, cb));
        const bf16x8 b1 = *reinterpret_cast<const bf16x8*>(Ks + KSWZ(32 + r32, cb));
        p0 = __builtin_amdgcn_mfma_f32_32x32x16_bf16(b0, qr[d0], p0, 0, 0, 0);
        p1 = __builtin_amdgcn_mfma_f32_32x32x16_bf16(b1, qr[d0], p1, 0, 0, 0); }
}
__device__ __forceinline__ void sb_tile(f32x16& p0, f32x16& p1, float& C, float bias2, bool masked, int t, int k0, int hi) {
#pragma unroll
    for (int r = 0; r < 16; ++r) {
        float e0 = fast_exp2(p0[r] + bias2), e1 = fast_exp2(p1[r] + bias2);
        if (masked) { const int key = k0 + crow(r, hi); e0 = key < t ? e0 : 0.f; e1 = (key + 32) < t ? e1 : 0.f; }
        p0[r] = e0; p1[r] = e1;
    }
    float a[8], SA[9], PB[9];
#pragma unroll
    for (int j = 0; j < 4; ++j) {
        a[j] = ((1.f + p0[4 * j]) * (1.f + p0[4 * j + 1])) * ((1.f + p0[4 * j + 2]) * (1.f + p0[4 * j + 3]));
        a[4 + j] = ((1.f + p1[4 * j]) * (1.f + p1[4 * j + 1])) * ((1.f + p1[4 * j + 2]) * (1.f + p1[4 * j + 3]));
    }
    SA[8] = 1.f; PB[8] = 1.f;
#pragma unroll
    for (int j = 7; j >= 0; --j) SA[j] = SA[j + 1] * a[j];
#pragma unroll
    for (int j = 0; j < 8; ++j) PB[j] = xchg32(SA[j], hi);
#pragma unroll
    for (int j = 0; j < 8; ++j) {
        const float suf = C * SA[j + 1] * (hi ? PB[j + 1] : PB[j]);
        float inv = fast_rcp(suf * a[j]);
        if (j < 4) {
            const float e0 = p0[4 * j], e1 = p0[4 * j + 1], e2 = p0[4 * j + 2], e3 = p0[4 * j + 3];
            p0[4 * j] = e0 * inv; inv *= (1.f + e0); p0[4 * j + 1] = e1 * inv; inv *= (1.f + e1); p0[4 * j + 2] = e2 * inv; inv *= (1.f + e2); p0[4 * j + 3] = e3 * inv;
        } else {
            const int q = 4 * (j - 4);
            const float e0 = p1[q], e1 = p1[q + 1], e2 = p1[q + 2], e3 = p1[q + 3];
            p1[q] = e0 * inv; inv *= (1.f + e0); p1[q + 1] = e1 * inv; inv *= (1.f + e1); p1[q + 2] = e2 * inv; inv *= (1.f + e2); p1[q + 3] = e3 * inv;
        }
    }
    C = C * SA[0] * PB[0];
}
__device__ __forceinline__ void pack_p(const f32x16& p0, const f32x16& p1, bf16x8& pa0, bf16x8& pa1, bf16x8& pa2, bf16x8& pa3) {
#define PK4(P, BASE, OUT) do { unsigned a0 = cvt_pk_bf16(P[BASE + 0], P[BASE + 1]), a1 = cvt_pk_bf16(P[BASE + 2], P[BASE + 3]);   \
    unsigned b0 = cvt_pk_bf16(P[BASE + 4], P[BASE + 5]), b1 = cvt_pk_bf16(P[BASE + 6], P[BASE + 7]);                              \
    auto r0 = __builtin_amdgcn_permlane32_swap(a0, b0, false, false); auto r1 = __builtin_amdgcn_permlane32_swap(a1, b1, false, false); \
    u32x4 w = {r0[0], r1[0], r0[1], r1[1]}; OUT = *reinterpret_cast<bf16x8*>(&w); } while (0)
    PK4(p0, 0, pa0); PK4(p0, 8, pa1); PK4(p1, 0, pa2); PK4(p1, 8, pa3);
#undef PK4
}
__device__ __forceinline__ void attn_unit(const bf16_t* __restrict__ Qb, const bf16_t* __restrict__ Kh, const bf16_t* __restrict__ Vh, bf16_t* __restrict__ Ob, int q0, float bias2, char* lds, int wave0) {
    const int tid = fresh_tid(wave0);
    const int wid = tid >> 6, lane = tid & 63, r32 = lane & 31, hi = lane >> 5;
    char* V_lds = lds; char* K_lds = lds + 2 * SHM_V;
    f32x16 o[4] = {}; bf16x8 qr[8];
    const bf16_t* Qw = Qb + (size_t)(wid * 32 + r32) * 1024 + hi * 8;
#pragma unroll
    for (int d0 = 0; d0 < 8; ++d0) qr[d0] = *reinterpret_cast<const bf16x8*>(Qw + d0 * 16);
    const int sr = tid >> 4, sc = (tid & 15) * 8, vst0 = v_st(sr, sc), vst1 = v_st(32 + sr, sc);
    const int vb0 = (int)(uintptr_t)V_lds + v_rd_base(lane);
    const int NT = (q0 + 256) >> 6, kmax = q0 + 192, tw = q0 + wid * 32, t = tw + r32;
    float C = 1.f;
    bf16x8 vs0, vs1, ks0, ks1;
#define SLOAD(k0) do { vs0 = *reinterpret_cast<const bf16x8*>(Vh + (size_t)((k0) + sr) * 1024 + sc); vs1 = *reinterpret_cast<const bf16x8*>(Vh + (size_t)((k0) + 32 + sr) * 1024 + sc); \
    ks0 = *reinterpret_cast<const bf16x8*>(Kh + (size_t)((k0) + sr) * 1024 + sc); ks1 = *reinterpret_cast<const bf16x8*>(Kh + (size_t)((k0) + 32 + sr) * 1024 + sc); } while (0)
#define SWRITE(b) do { *(bf16x8*)(V_lds + (b) * SHM_V + vst0) = vs0; *(bf16x8*)(V_lds + (b) * SHM_V + vst1) = vs1; const int kc = sc * 2; \
    *(bf16x8*)(K_lds + (b) * SHM_K + KSWZ(sr, kc)) = ks0; *(bf16x8*)(K_lds + (b) * SHM_K + KSWZ(32 + sr, kc)) = ks1; } while (0)
    __syncthreads();
    SLOAD(kmax); SWRITE(0);
    for (int j = 0; j < NT; ++j) {
        __syncthreads();
        const int k0 = kmax - 64 * j, b = j & 1;
        if (j + 1 < NT) SLOAD(k0 - 64);
        if (k0 <= tw + 30) {
            f32x16 p0, p1; bf16x8 pa0, pa1, pa2, pa3;
            qkt(p0, p1, K_lds + b * SHM_K, qr, r32, hi);
            sb_tile(p0, p1, C, bias2, k0 + 63 >= tw, t, k0, hi);
            pack_p(p0, p1, pa0, pa1, pa2, pa3);
            const int vb = vb0 + b * SHM_V;
            pv_one<0>(o[0], vb, pa0, pa1, pa2, pa3); pv_one<1>(o[1], vb, pa0, pa1, pa2, pa3); pv_one<2>(o[2], vb, pa0, pa1, pa2, pa3); pv_one<3>(o[3], vb, pa0, pa1, pa2, pa3);
        }
        if (j + 1 < NT) SWRITE(b ^ 1);
    }
#undef SLOAD
#undef SWRITE
    bf16_t* Ow = Ob + (size_t)(wid * 32) * DM;
#pragma unroll
    for (int r = 0; r < 16; ++r) { const int orow = crow(r, hi);
#pragma unroll
        for (int d0 = 0; d0 < 4; ++d0) Ow[(size_t)orow * DM + d0 * 32 + r32] = (bf16_t)(cvt_pk_bf16(o[d0][r], 0.f) & 0xffffu); }
}
__device__ __forceinline__ void gate_unit(const bf16_t* __restrict__ AVb, const bf16_t* __restrict__ AUb, const bf16_t* __restrict__ AWS, const float* __restrict__ avsq,
                                          const float* __restrict__ avg, const float* __restrict__ abs_, bf16_t* __restrict__ MIX, int R0, int g, char* lds, int wave0) {
    const int tid = fresh_tid(wave0);
    const int wid = tid >> 6, lane = tid & 63, r32 = lane & 31, hi = lane >> 5, wp = wid & 3, wd = wid >> 2;
    char* V_lds = lds;
    const int sr = tid >> 4, sc = (tid & 15) * 8;
    __syncthreads();
#pragma unroll
    for (int q4 = 0; q4 < 4; ++q4) {
        const int row = q4 * 32 + sr;
        const u32x4 x = *reinterpret_cast<const u32x4*>(AVb + (size_t)(R0 + row) * 1024 + g * 128 + sc);
        const float rs = __builtin_amdgcn_rsqf(avsq[R0 + row] * (1.0f / AW) + EPS);
        u32x4 w; w.x = cvt_pk_bf16(bf_lo(x.x) * rs, bf_hi(x.x) * rs); w.y = cvt_pk_bf16(bf_lo(x.y) * rs, bf_hi(x.y) * rs);
        w.z = cvt_pk_bf16(bf_lo(x.z) * rs, bf_hi(x.z) * rs); w.w = cvt_pk_bf16(bf_lo(x.w) * rs, bf_hi(x.w) * rs);
        *(u32x4*)(V_lds + (row >> 6) * SHM_V + v_st(row & 63, sc)) = w;
    }
    __syncthreads();
    f32x16 o0 = {}, o1 = {};
    const int vb0 = (int)(uintptr_t)V_lds + v_rd_base(lane);
    const bf16_t* Wrow = AWS + (size_t)(g * 128 + wp * 32 + r32) * 128 + hi * 8;
#pragma unroll
    for (int tile = 0; tile < 2; ++tile) {
        if (tile == 1 && wp < 2) break;
        const bf16x8 pa0 = *reinterpret_cast<const bf16x8*>(Wrow + tile * 64), pa1 = *reinterpret_cast<const bf16x8*>(Wrow + tile * 64 + 16),
                     pa2 = *reinterpret_cast<const bf16x8*>(Wrow + tile * 64 + 32), pa3 = *reinterpret_cast<const bf16x8*>(Wrow + tile * 64 + 48);
        const int vb = vb0 + tile * SHM_V;
        if (wd == 0) { pv_one<0>(o0, vb, pa0, pa1, pa2, pa3); pv_one<1>(o1, vb, pa0, pa1, pa2, pa3); }
        else         { pv_one<2>(o0, vb, pa0, pa1, pa2, pa3); pv_one<3>(o1, vb, pa0, pa1, pa2, pa3); }
    }
#pragma unroll
    for (int r = 0; r < 16; ++r) {
        const int p = wp * 32 + crow(r, hi); const float bsv = abs_[g * 128 + p];
#pragma unroll
        for (int dd = 0; dd < 2; ++dd) {
            const int col = g * 128 + (wd * 2 + dd) * 32 + r32;
            const float acc = dd == 0 ? o0[r] : o1[r];
            const float mixv = acc * avg[col] + bsv;
            const float au = __uint_as_float((unsigned)AUb[(size_t)(R0 + p) * 1024 + col] << 16);
            MIX[(size_t)(R0 + p) * DM + col] = (bf16_t)(cvt_pk_bf16(au * mixv, 0.f) & 0xffffu);
        }
    }
}
}

constexpr int PTAB_OFF = MISC_OFF + 256;
__device__ __forceinline__ unsigned char* opaque_ptr(unsigned char* p) { asm volatile("" : "+s"(p)); return p; }
__device__ __forceinline__ const void* lds_ptr(volatile LAS unsigned* tab, int i) {
    const unsigned lo = __builtin_amdgcn_readfirstlane(tab[2 * i]), hi = __builtin_amdgcn_readfirstlane(tab[2 * i + 1]);
    return (const void*)(((unsigned long long)hi << 32) | lo);
}
struct Args { const void* in[24]; float* out; unsigned char* ws; };

__device__ __forceinline__ void ld8(const bf16_t* p, float (&o)[8]) { const u32x4 x = *(const u32x4*)p; o[0] = bf_lo(x.x); o[1] = bf_hi(x.x); o[2] = bf_lo(x.y); o[3] = bf_hi(x.y); o[4] = bf_lo(x.z); o[5] = bf_hi(x.z); o[6] = bf_lo(x.w); o[7] = bf_hi(x.w); }
__device__ __forceinline__ void sp_sum8(const float* __restrict__ SP, int r, int col, float (&o)[8]) {
    f32x4 a = {0.f, 0.f, 0.f, 0.f}, b = {0.f, 0.f, 0.f, 0.f};
#pragma unroll
    for (int s = 0; s < 8; ++s) { const float* p = SP + ((size_t)s * MS + r) * 4096 + col; a += *(const f32x4*)p; b += *(const f32x4*)(p + 4); }
    o[0] = a[0]; o[1] = a[1]; o[2] = a[2]; o[3] = a[3]; o[4] = b[0]; o[5] = b[1]; o[6] = b[2]; o[7] = b[3];
}
__device__ __forceinline__ float wave_sum(float v) {
    v = sum_x32(sum_x16(sum_row16(v)));
    return v;
}
__device__ __forceinline__ void tr_item(const float* __restrict__ W, int K, int N, const float* __restrict__ gain, bf16_t* __restrict__ WT, int kind, LAS float* scr, int item, int lane) {
    const int nblk = N / 32, kb = item / nblk, nb = item % nblk, k0 = 64 * kb, n0 = 32 * nb;
    int drow0 = n0;
    if (kind == 1) drow0 = 256 * (n0 >> 7) + (n0 & 127);
    else if (kind == 2) drow0 = 256 * (n0 >> 7) + 128 + (n0 & 127);
    else if (kind == 3) { if (n0 >= 3072) { const int j = n0 - 3072; drow0 = 2048 + 256 * (j >> 7) + 128 + (j & 127); } else if (n0 >= 2048) { const int j = n0 - 2048; drow0 = 2048 + 256 * (j >> 7) + (j & 127); } }
    {
        const int kr = lane >> 3, nc = (lane & 7) * 4;
        f32x4 v[8];
#pragma unroll
        for (int i = 0; i < 8; ++i) v[i] = __builtin_nontemporal_load((const f32x4*)(W + (size_t)(k0 + 8 * i + kr) * N + n0 + nc));
#pragma unroll
        for (int i = 0; i < 8; ++i) { const int kk = 8 * i + kr; f32x4 x = v[i]; if (gain) x = x * gain[k0 + kk];
            scr[kk * 33 + nc] = x[0]; scr[kk * 33 + nc + 1] = x[1]; scr[kk * 33 + nc + 2] = x[2]; scr[kk * 33 + nc + 3] = x[3]; }
    }
    LDS_WAIT(); asm volatile("" ::: "memory");
    const int c = lane & 7;
#pragma unroll
    for (int j = 0; j < 4; ++j) { const int n = (lane >> 3) + 8 * j; const LAS float* s = scr + (8 * c) * 33 + n;
        u32x4 o; o.x = cvt_pk_bf16(s[0 * 33], s[1 * 33]); o.y = cvt_pk_bf16(s[2 * 33], s[3 * 33]); o.z = cvt_pk_bf16(s[4 * 33], s[5 * 33]); o.w = cvt_pk_bf16(s[6 * 33], s[7 * 33]);
        *(u32x4*)(WT + (size_t)(drow0 + n) * K + k0 + 8 * c) = o; }
    LDS_WAIT(); asm volatile("" ::: "memory");
}

__device__ __forceinline__ void tr_item8(const float* __restrict__ W, int K, int N, const float* __restrict__ gain, unsigned char* __restrict__ WT8, int kind, LAS float* scr, int item, int lane, float scale, bool i8) {
    const int nblk = N / 32, kb = item / nblk, nb = item % nblk, k0 = 64 * kb, n0 = 32 * nb;
    int drow0 = n0;
    if (kind == 1) drow0 = 256 * (n0 >> 7) + (n0 & 127);
    else if (kind == 2) drow0 = 256 * (n0 >> 7) + 128 + (n0 & 127);
    {
        const int kr = lane >> 3, nc = (lane & 7) * 4;
        f32x4 v[8];
#pragma unroll
        for (int i = 0; i < 8; ++i) v[i] = __builtin_nontemporal_load((const f32x4*)(W + (size_t)(k0 + 8 * i + kr) * N + n0 + nc));
#pragma unroll
        for (int i = 0; i < 8; ++i) { const int kk = 8 * i + kr; const f32x4 x = v[i] * (gain ? gain[k0 + kk] * scale : scale);
            scr[kk * 33 + nc] = x[0]; scr[kk * 33 + nc + 1] = x[1]; scr[kk * 33 + nc + 2] = x[2]; scr[kk * 33 + nc + 3] = x[3]; }
    }
    LDS_WAIT(); asm volatile("" ::: "memory");
    const int c = lane & 7;
#pragma unroll
    for (int j = 0; j < 4; ++j) { const int n = (lane >> 3) + 8 * j; const LAS float* s = scr + (8 * c) * 33 + n;
        u32x2 o;
        if (i8) { o.x = pk_i8x4(s[0 * 33], s[1 * 33], s[2 * 33], s[3 * 33]); o.y = pk_i8x4(s[4 * 33], s[5 * 33], s[6 * 33], s[7 * 33]); }
        else    { o.x = pk_fp8x4(s[0 * 33], s[1 * 33], s[2 * 33], s[3 * 33]); o.y = pk_fp8x4(s[4 * 33], s[5 * 33], s[6 * 33], s[7 * 33]); }
        *(u32x2*)(WT8 + (size_t)(drow0 + n) * K + k0 + 8 * c) = o; }
    LDS_WAIT(); asm volatile("" ::: "memory");
}
__device__ __forceinline__ void unpack8(const u32x4& x, float (&o)[8]) { o[0] = bf_lo(x.x); o[1] = bf_hi(x.x); o[2] = bf_lo(x.y); o[3] = bf_hi(x.y); o[4] = bf_lo(x.z); o[5] = bf_hi(x.z); o[6] = bf_lo(x.w); o[7] = bf_hi(x.w); }
template <int WIN> __device__ __forceinline__ void pool_run(const bf16_t* __restrict__ XC, bf16_t* __restrict__ PO_, int R0, int t0, int c) {
    u32x4 x[15 + WIN];
#pragma unroll
    for (int i = 0; i < 15 + WIN; ++i) { const int dt = i - (WIN - 1); const bool ok = t0 + dt >= 0;
        x[i] = *(const u32x4*)(XC + (size_t)(R0 + (ok ? dt : 0)) * 1024 + c); if (!ok) x[i] = (u32x4){0u, 0u, 0u, 0u}; }
    float S[8] = {0.f, 0.f, 0.f, 0.f, 0.f, 0.f, 0.f, 0.f};
#pragma unroll
    for (int i = 0; i < WIN - 1; ++i) { float v[8]; unpack8(x[i], v);
#pragma unroll
        for (int j = 0; j < 8; ++j) S[j] += v[j]; }
#pragma unroll
    for (int j = 0; j < 16; ++j) {
        float v[8]; unpack8(x[j + WIN - 1], v);
#pragma unroll
        for (int e = 0; e < 8; ++e) S[e] += v[e];
        const int n = t0 + j + 1 < WIN ? t0 + j + 1 : WIN; const float ic = 1.0f / (float)n;
        u32x4 w; w.x = cvt_pk_bf16(S[0] * ic - v[0], S[1] * ic - v[1]); w.y = cvt_pk_bf16(S[2] * ic - v[2], S[3] * ic - v[3]);
        w.z = cvt_pk_bf16(S[4] * ic - v[4], S[5] * ic - v[5]); w.w = cvt_pk_bf16(S[6] * ic - v[6], S[7] * ic - v[7]);
        *(u32x4*)(PO_ + (size_t)(R0 + j) * 1024 + c) = w;
        float u[8]; unpack8(x[j], u);
#pragma unroll
        for (int e = 0; e < 8; ++e) S[e] -= u[e];
    }
}
__device__ __forceinline__ void conv_run8(const bf16_t* __restrict__ GBp, const bf16_t* __restrict__ Gp, const float* __restrict__ cwp, bf16_t* __restrict__ MIX, int R0, int t0, int c) {
    u32x4 g[10], gb[8];
#pragma unroll
    for (int i = 0; i < 10; ++i) { const int dt = i - 2; const bool ok = t0 + dt >= 0; g[i] = *(const u32x4*)(Gp + (size_t)(R0 + (ok ? dt : 0)) * 1024 + c); if (!ok) g[i] = (u32x4){0u, 0u, 0u, 0u}; }
#pragma unroll
    for (int i = 0; i < 8; ++i) gb[i] = *(const u32x4*)(GBp + (size_t)(R0 + i) * 1024 + c);
    float cw[3][8];
#pragma unroll
    for (int k = 0; k < 3; ++k) { const f32x4 a = *(const f32x4*)(cwp + k * 1024 + c), b2 = *(const f32x4*)(cwp + k * 1024 + c + 4);
        cw[k][0] = a[0]; cw[k][1] = a[1]; cw[k][2] = a[2]; cw[k][3] = a[3]; cw[k][4] = b2[0]; cw[k][5] = b2[1]; cw[k][6] = b2[2]; cw[k][7] = b2[3]; }
#pragma unroll
    for (int j = 0; j < 8; ++j) {
        float a0[8], a1[8], a2[8], b[8], o[8]; unpack8(g[j], a0); unpack8(g[j + 1], a1); unpack8(g[j + 2], a2); unpack8(gb[j], b);
#pragma unroll
        for (int e = 0; e < 8; ++e) o[e] = b[e] * (a0[e] * cw[0][e] + a1[e] * cw[1][e] + a2[e] * cw[2][e]);
        u32x4 w; w.x = cvt_pk_bf16(o[0], o[1]); w.y = cvt_pk_bf16(o[2], o[3]); w.z = cvt_pk_bf16(o[4], o[5]); w.w = cvt_pk_bf16(o[6], o[7]);
        *(u32x4*)(MIX + (size_t)(R0 + j) * DM + 1024 + c) = w;
    }
}
__device__ __forceinline__ void residual_fixup(const float* __restrict__ PART, const float* __restrict__ SLAB, int mode, const float* __restrict__ Y, float* __restrict__ out, bf16_t* __restrict__ XN,
                                               float* __restrict__ sumsq, int gw, int NGW, int lane, unsigned char* __restrict__ XN8 = nullptr, float sqx = 1.f) {
    const int S = mode == 0 ? 22 : (mode == 1 ? 11 : 8); const float alpha = mode == 0 ? 0.5f : (mode == 1 ? 0.5f / (S8_ACT * S8_W) : 1.0f);
    for (int it = gw; it < MS * 8; it += NGW) {
        const int r = it >> 3, c = (it & 7) * 256 + 4 * lane; const size_t ro = (size_t)(MP + r) * DM + c;
        f32x4 a = {0.f, 0.f, 0.f, 0.f};
        {
            f32x4 sv[22];
#pragma unroll
            for (int s = 0; s < 22; ++s) sv[s] = *(const f32x4*)(SLAB + ((size_t)(s < S ? s : 0) * MS + r) * DM + c);
#pragma unroll
            for (int s = 0; s < 22; ++s) a += sv[s] * (s < S ? 1.f : 0.f);
        }
        const f32x4 v = *(const f32x4*)(Y + ro) + a * alpha;
        *(f32x4*)(out + ro) = v;
        if (XN8) *(unsigned*)(XN8 + ro) = pk_i8x4(v[0] * sqx, v[1] * sqx, v[2] * sqx, v[3] * sqx);
        else { u32x2 w; w.x = cvt_pk_bf16(v[0], v[1]); w.y = cvt_pk_bf16(v[2], v[3]); *(u32x2*)(XN + ro) = w; }
        const float ss = wave_sum((v[0] * v[0] + v[1] * v[1]) + (v[2] * v[2] + v[3] * v[3]));
        if (lane == 0) atomicAdd(sumsq + MP + r, ss);
    }
}

__device__ __forceinline__ void fixup_tasks(const float* __restrict__ PART, const float* __restrict__ SLAB, int mode, const float* __restrict__ Y, float* __restrict__ out, bf16_t* __restrict__ XN,
                                            float* __restrict__ sumsq, int w, int NW, int lane, unsigned char* __restrict__ XN8 = nullptr, float sqx = 1.f) {
    const int S = mode == 0 ? 22 : (mode == 1 ? 11 : 8); const float alpha = mode == 0 ? 0.5f : (mode == 1 ? 0.5f / (S8_ACT * S8_W) : 1.0f);
    for (int b = w * 4; b < MP / 8; b += NW * 4) {
        f32x4 p[4];
#pragma unroll
        for (int j = 0; j < 4; ++j) p[j] = *(const f32x4*)(PART + ((size_t)(b + j) * 8 + (lane >> 3)) * 32 + (lane & 7) * 4);
#pragma unroll
        for (int j = 0; j < 4; ++j) {
            float v = (p[j][0] + p[j][1]) + (p[j][2] + p[j][3]);
            v += dppf<0xB1>(v); v += dppf<0x4E>(v); v += dppf<0x141>(v);
            if ((lane & 7) == 0) sumsq[(b + j) * 8 + (lane >> 3)] = v;
        }
    }
    for (int it = w; it < MS * 8; it += NW) {
        const int r = it >> 3, c = (it & 7) * 256 + 4 * lane; const size_t ro = (size_t)(MP + r) * DM + c;
        f32x4 a = {0.f, 0.f, 0.f, 0.f};
        {
            f32x4 sv[22];
#pragma unroll
            for (int s = 0; s < 22; ++s) sv[s] = *(const f32x4*)(SLAB + ((size_t)(s < S ? s : 0) * MS + r) * DM + c);
#pragma unroll
            for (int s = 0; s < 22; ++s) a += sv[s] * (s < S ? 1.f : 0.f);
        }
        const f32x4 v = *(const f32x4*)(Y + ro) + a * alpha;
        *(f32x4*)(out + ro) = v;
        if (XN8) *(unsigned*)(XN8 + ro) = pk_i8x4(v[0] * sqx, v[1] * sqx, v[2] * sqx, v[3] * sqx);
        else { u32x2 w2; w2.x = cvt_pk_bf16(v[0], v[1]); w2.y = cvt_pk_bf16(v[2], v[3]); *(u32x2*)(XN + ro) = w2; }
        const float ss = wave_sum((v[0] * v[0] + v[1] * v[1]) + (v[2] * v[2] + v[3] * v[3]));
        if (lane == 0) atomicAdd(sumsq + MP + r, ss);
    }
}

__global__ void __launch_bounds__(512, 2) mega_fwd(Args args) {
    extern __shared__ __attribute__((aligned(16))) unsigned char lds[];
    LAS unsigned char* L = (LAS unsigned char*)lds;
#define FRESH_IDS() const int tid = fresh_tid(wave0); int G = G0, bx = bx0; asm volatile("" : "+s"(G), "+s"(bx)); const int lane = tid & 63, wave = wave0; const int gw = bx * 8 + wave, NGW = G * 8; (void)lane; (void)gw; (void)NGW
    const int G0 = gridDim.x, bx0 = blockIdx.x;
#define WSP(T, off) ((T*)(opaque_ptr(args.ws) + (off)))
#define INP(T, i) ((const T*)lds_ptr((volatile LAS unsigned*)(L + PTAB_OFF), (i)))
#define CTLP ((unsigned*)(opaque_ptr(args.ws) + WS_CTL))
#define SUMSQP(k) ((float*)(opaque_ptr(args.ws) + WS_CTL) + CW_SUMSQ + (k) * MT)
#define AVSQP ((float*)(opaque_ptr(args.ws) + WS_CTL) + CW_AVSQ)
#define DOUT ((float*)opaque_ptr((unsigned char*)args.out))
    const int wave0 = __builtin_amdgcn_readfirstlane(threadIdx.x >> 6);
    { const int tid = fresh_tid(wave0);
    for (int u = tid; u < (LDS_BYTES - MISC_OFF) / 4; u += 512) ((LAS unsigned*)(L + MISC_OFF))[u] = 0u;
    __syncthreads();
    if (tid < 24) { const unsigned long long p = (unsigned long long)args.in[tid]; ((LAS unsigned*)(L + PTAB_OFF))[2 * tid] = (unsigned)p; ((LAS unsigned*)(L + PTAB_OFF))[2 * tid + 1] = (unsigned)(p >> 32); }
    __syncthreads(); }
    XcdBarrier bar = xcd_barrier_post(CTLP + CW_BAR, (volatile LAS unsigned*)(L + MISC_OFF + 32), wave0);

    constexpr int IT_G = 32 * 176, IT_INE = 32 * 160, IT_O = 32 * 64, IT_INO = 32 * 128, IT_CW = 4 * 32;
    constexpr int NIT = 12 * IT_G + IT_INE + IT_O + IT_INO + IT_O + IT_CW;
#define CONV_IT(it_) do { \
            int r = (it_); \
            if (r < 12 * IT_G) { \
                const int seg = r / IT_G, which = seg >> 2, lf = seg & 3, l = lf >> 1, f = lf & 1; r -= seg * IT_G; \
                  \
                if (which == 0) tr_item8(INP(float, 8) + (size_t)lf * DM * FF, DM, FF, norm_g + (l * 3 + f * 2) * DM, (unsigned char*)(WSP(bf16_t, WS_WGU) + (size_t)lf * 2 * FF * DM), 1, scr, r, lane, SQ_W, true); \
                else if (which == 1) tr_item8(INP(float, 9) + (size_t)lf * DM * FF, DM, FF, norm_g + (l * 3 + f * 2) * DM, (unsigned char*)(WSP(bf16_t, WS_WGU) + (size_t)lf * 2 * FF * DM), 2, scr, r, lane, SQ_W, true); \
                else if (lf >= FP8_DOWN_FROM) tr_item8(INP(float, 10) + (size_t)lf * FF * DM, FF, DM, nullptr, (unsigned char*)(WSP(bf16_t, WS_WD) + (size_t)lf * DM * FF), 0, scr, r, lane, S8_W, false); \
                else tr_item(INP(float, 10) + (size_t)lf * FF * DM, FF, DM, nullptr, WSP(bf16_t, WS_WD) + (size_t)lf * DM * FF, 0, scr, r, lane); \
                break; \
            } \
            r -= 12 * IT_G; \
            if (r < IT_INE) { tr_item(INP(float, 11), DM, 5120, norm_g + 1 * DM, WSP(bf16_t, WS_WINE), 0, scr, r, lane); break; } r -= IT_INE; \
            if (r < IT_O) { tr_item(INP(float, 12), DM, DM, nullptr, WSP(bf16_t, WS_WOUTE), 0, scr, r, lane); break; } r -= IT_O; \
            if (r < IT_INO) { tr_item(INP(float, 19), DM, 4096, norm_g + 4 * DM, WSP(bf16_t, WS_WINO), 3, scr, r, lane); break; } r -= IT_INO; \
            if (r < IT_O) { tr_item(INP(float, 20), DM, DM, nullptr, WSP(bf16_t, WS_WOUTO), 0, scr, r, lane); break; } r -= IT_O; \
            { const int gi = r / 32; tr_item(INP(float, 21) + (size_t)gi * 65536, 256, 256, nullptr, WSP(bf16_t, WS_CWGT) + (size_t)gi * 65536, 0, scr, r % 32, lane); } \
        } while (0)

#define CONV_WIN2(lo1_, hi1_, lo2_, hi2_, k_) do { FRESH_IDS(); LAS float* scr = (LAS float*)(L + wave * 16384); const float* norm_g = INP(float, 7); unsigned* ctr_ = CTLP + CW_CONV + 64 * (k_); \
        const int n1_ = (hi1_) - (lo1_), nt_ = n1_ + (hi2_) - (lo2_); \
        for (;;) { int base_ = 0; if (lane == 0) base_ = (int)atomicAdd(ctr_, 4u); base_ = __builtin_amdgcn_readfirstlane(base_); if (base_ >= nt_) break; \
            for (int j_ = 0; j_ < 4; ++j_) { const int w_ = base_ + j_; if (w_ < nt_) CONV_IT(w_ < n1_ ? (lo1_) + w_ : (lo2_) + (w_ - n1_)); } } } while (0)
#define CONV_TAIL(lo_, hi_, w_, nw_) do { FRESH_IDS(); LAS float* scr = (LAS float*)(L + wave * 16384); const float* norm_g = INP(float, 7); \
        for (int q_ = (lo_) + (w_); q_ < (hi_); q_ += (nw_)) CONV_IT(q_); } while (0)
#define GATE_ARRIVE(k_) do { asm volatile("s_waitcnt vmcnt(0)" ::: "memory"); __syncthreads(); \
        if (fresh_tid(wave0) == 0) { __builtin_amdgcn_fence(__ATOMIC_RELEASE, "agent"); asm volatile("s_waitcnt vmcnt(0)" ::: "memory"); (void)xb_add(CTLP + CW_GATE + 64 * (k_), 1u); } } while (0)
#define GATE_WAIT(k_, need_) do { if (wave0 == 0) { unsigned sp_ = 0u; while (xb_ld(CTLP + CW_GATE + 64 * (k_)) < (unsigned)(need_)) { __builtin_amdgcn_s_sleep(2); if (++sp_ > XB_SPIN_CAP) break; } \
            __builtin_amdgcn_fence(__ATOMIC_ACQUIRE, "agent"); asm volatile("s_waitcnt vmcnt(0)" ::: "memory"); } __syncthreads(); } while (0)
    for (int rep = 0; rep < REP_PRO; ++rep) {
        if (rep) xcd_barrier(bar);
        FRESH_IDS();
        LAS float* scr = (LAS float*)(L + wave * 16384);
        const float* norm_g = INP(float, 7);
        constexpr int NDEF = 9632 + 4000 + 2820 + 2500 + 3000 + 4000 + 3048 + 992 + 896;
        for (int k = gw; k < NIT - NDEF; k += NGW) {
            int it = k;
            if (it >= 5632) it += 15264 - 5632;
            if (it >= 16896) it += 20896 - 16896;
            if (it >= 28160) it += 30980 - 28160;
            if (it >= 39424) it += 41924 - 39424;
            if (it >= 50688) it += 53688 - 50688;
            if (it >= 61952) it += 65952 - 61952;
            if (it >= 71704) it += 74752 - 71704;
            if (it >= 78848) it += 80736 - 78848;
            CONV_IT(it);
        }
        {
            const float* x_prompt = INP(float, 0); const float* x_sample = INP(float, 1);
            unsigned char* XNQ = WSP(unsigned char, WS_XNQ); float* SQ = SUMSQP(0);
            for (int m = NGW - 1 - gw; m < MT; m += NGW) {
                const float* src = m < MP ? x_prompt + (size_t)m * DM : (m < MP + MS ? x_sample + (size_t)(m - MP) * DM : nullptr);
                float ss = 0.f;
#pragma unroll
                for (int j = 0; j < 8; ++j) {
                    const int c = 4 * lane + 256 * j;
                    f32x4 v = src ? __builtin_nontemporal_load((const f32x4*)(src + c)) : (f32x4){0.f, 0.f, 0.f, 0.f};
                    *(unsigned*)(XNQ + (size_t)m * DM + c) = pk_i8x4(v[0] * sqx_of(0), v[1] * sqx_of(0), v[2] * sqx_of(0), v[3] * sqx_of(0));
                    ss += (v[0] * v[0] + v[1] * v[1]) + (v[2] * v[2] + v[3] * v[3]);
                }
                ss = wave_sum(ss);
                if (lane == 0) SQ[m] = ss;
            }
        }
        {
            const float* a_ws = INP(float, 17); bf16_t* AWS = WSP(bf16_t, WS_AWS);
            for (int i = bx * 512 + tid; i < 8 * 128 * 128; i += G * 512) { const int p = (i >> 7) & 127, q = i & 127; AWS[i] = q <= p ? (bf16_t)(cvt_pk_bf16(a_ws[i], 0.f) & 0xffffu) : (bf16_t)0; }
            const float* state_pool = INP(float, 4); float* dout = DOUT;
            for (int i = bx * 512 + tid; i < DECB * 11 * 1024; i += G * 512) { const int b = i / (11 * 1024), rem = i % (11 * 1024); dout[O_PS + (size_t)b * 15 * 1024 + rem] = state_pool[(size_t)b * 15 * 1024 + 4 * 1024 + rem]; }
        }
    }
    xcd_barrier(bar);

    for (int layer = 0; layer < 2; ++layer) {
        for (int hs = 0; hs < 2; ++hs) {
            const int lf = layer * 2 + hs;
            const bool dn8 = (lf >= FP8_DOWN_FROM);
            for (int rep = 0; rep < REP_UP; ++rep) {
                if (rep) xcd_barrier(bar);
                if (bx0 >= G_UP) {
                    if (rep == 0 && lf > 0) {
                        const int w_ = (bx0 - G_UP) * 8 + wave0, nw_ = (G0 - G_UP) * 8; const int lane_ = fresh_tid(wave0) & 63;
                        if (lf == 1)      fixup_tasks(WSP(float, WS_PART), WSP(float, WS_SLAB), 2, WSP(float, WS_Y), WSP(float, WS_Y), WSP(bf16_t, WS_XN), SUMSQP(2), w_, nw_, lane_, WSP(unsigned char, WS_XNQ), sqx_of(1));
                        else if (lf == 2) fixup_tasks(WSP(float, WS_PART), WSP(float, WS_SLAB), 0, WSP(float, WS_Y), WSP(float, WS_Y), WSP(bf16_t, WS_XN), SUMSQP(3), w_, nw_, lane_, WSP(unsigned char, WS_XNQ), sqx_of(2));
                        else              fixup_tasks(WSP(float, WS_PART), WSP(float, WS_SLAB), 2, WSP(float, WS_Y), WSP(float, WS_Y), WSP(bf16_t, WS_XN), SUMSQP(5), w_, nw_, lane_, WSP(unsigned char, WS_XNQ), sqx_of(3));
                        GATE_ARRIVE(lf);
                    }
                    if (rep == 0) { if (lf == 0) CONV_WIN2(71704, 74752, 5632, 6584, 1); else if (lf == 1) CONV_WIN2(11264, 15264, 0, 0, 3); else if (lf == 2) CONV_WIN2(16896, 20896, 0, 0, 4); else CONV_WIN2(61952, 65952, 0, 0, 5); }
                } else if (dn8) {
                    pg8::Gemm g{WSP(unsigned char, WS_XNQ), (const unsigned char*)(WSP(bf16_t, WS_WGU) + (size_t)lf * 2 * FF * DM), DM, DM, DM, 0};
                    pg8::StaticOrder S; S.init(NPAN, 44, G_UP, bx0, 0, 16);
                    pg8::EpiUpT<2, true> E{WSP(unsigned char, WS_ACT), SUMSQP(layer * 3 + hs * 2), 1.0f / (sqx_of(3) * SQ_W)};
                    pg8::gemm_phase<pg8::EpiUpT<2, true>, 2>(L, g, S, E, wave0, lf > 0 ? CTLP + CW_GATE + 64 * lf : nullptr, (unsigned)(G0 - G_UP));
                } else {
                    pg8::Gemm g{WSP(unsigned char, WS_XNQ), (const unsigned char*)(WSP(bf16_t, WS_WGU) + (size_t)lf * 2 * FF * DM), DM, DM, DM, 0};
                    pg8::StaticOrder S; S.init(NPAN, 44, G_UP, bx0, 0, 16);
                    pg8::EpiUpT<2, false> E{WSP(bf16_t, WS_ACT), SUMSQP(layer * 3 + hs * 2), 1.0f / ((lf == 0 ? sqx_of(0) : (lf == 1 ? sqx_of(1) : sqx_of(2))) * SQ_W)};
                    pg8::gemm_phase<pg8::EpiUpT<2, false>, 2>(L, g, S, E, wave0, lf > 0 ? CTLP + CW_GATE + 64 * lf : nullptr, (unsigned)(G0 - G_UP));
                }
            }
            xcd_barrier(bar);
            const bool fin = (layer == 1 && hs == 1);
            const int ni = hs == 0 ? layer * 3 + 1 : (layer + 1) * 3;
            if (dn8) {
                pg8::Gemm g{WSP(unsigned char, WS_ACT), (const unsigned char*)(WSP(bf16_t, WS_WD) + (size_t)lf * DM * FF), FF, FF, FF, 0};
                pg8::StaticOrder S; S.init(32, 8, G0, bx0, 11, 44);
                pg8::EpiRes E{WSP(float, WS_Y), fin ? DOUT : WSP(float, WS_Y), WSP(bf16_t, WS_XN), WSP(float, WS_PART), 0.5f / (S8_ACT * S8_W), WSP(float, WS_SLAB)};
                pg8::gemm_phase<pg8::EpiRes, 1>(L, g, S, E, wave0);
            } else {
                pg8::Gemm g{WSP(bf16_t, WS_ACT), WSP(bf16_t, WS_WD) + (size_t)lf * DM * FF, FF * 2, FF * 2, FF, 0};
                pg8::StaticOrder S; S.init(32, 8, G0, bx0, 22, 88);
                pg8::EpiRes E{lf == 0 ? INP(float, 0) : WSP(float, WS_Y), fin ? DOUT : WSP(float, WS_Y), WSP(bf16_t, WS_XN), WSP(float, WS_PART), 0.5f, WSP(float, WS_SLAB), hs == 1 ? WSP(unsigned char, WS_XNQ) : nullptr, sqx_of(2)};
                pg8::gemm_phase<pg8::EpiRes>(L, g, S, E, wave0);
            }
            xcd_barrier(bar);
            if (fin) {
                if (dn8) { FRESH_IDS(); residual_fixup(WSP(float, WS_PART), WSP(float, WS_SLAB), 1, WSP(float, WS_Y), DOUT, WSP(bf16_t, WS_XN), AVSQP, gw, NGW, lane); }
                else     { FRESH_IDS(); residual_fixup(WSP(float, WS_PART), WSP(float, WS_SLAB), 0, WSP(float, WS_Y), DOUT, WSP(bf16_t, WS_XN), AVSQP, gw, NGW, lane); }
                break;
            }
            if (hs == 1) continue;
            if (layer == 0) {
                {
                    pg8::Gemm g{WSP(bf16_t, WS_XN), WSP(bf16_t, WS_WINE), DM * 2, DM * 2, DM, 0};
                    pg8::StaticOrder S; S.init(NPAN, 20, G_INE, bx0, 0, 32);
                    pg8::EpiInEven E{SUMSQP(1), WSP(bf16_t, WS_T0), WSP(bf16_t, WS_T1), WSP(bf16_t, WS_T2), WSP(bf16_t, WS_T3), WSP(bf16_t, WS_T4), DOUT, INP(float, 13), INP(float, 14), AVSQP, (LAS float*)(L + RED_OFF)};
                    if (bx0 < G_INE) pg8::gemm_phase<pg8::EpiInEven>(L, g, S, E, wave0, CTLP + CW_GATE + 64 * 4, (unsigned)(G0 - G_INE));
                    else {
                        { const int w_ = (bx0 - G_INE) * 8 + wave0, nw_ = (G0 - G_INE) * 8; const int lane_ = fresh_tid(wave0) & 63;
                          fixup_tasks(WSP(float, WS_PART), WSP(float, WS_SLAB), 0, INP(float, 1) - (size_t)MP * DM, WSP(float, WS_Y), WSP(bf16_t, WS_XN), SUMSQP(1), w_, nw_, lane_);
                          GATE_ARRIVE(4); }
                        CONV_WIN2(6584, 11264, 28160, 30980, 2);
                    }
                }
                xcd_barrier(bar);
                for (int rep = 0; rep < REP_MIX; ++rep) {
                    if (rep) xcd_barrier(bar);
                    FRESH_IDS();
                    if (rep == 0 && (bx < G / 2 || G < 2)) {
                        const int nb = G < 2 ? 1 : G / 2, b0 = bx;
                        for (int gu = b0; gu < 512; gu += nb)
                            sba::gate_unit(WSP(bf16_t, WS_T4), WSP(bf16_t, WS_T3), WSP(bf16_t, WS_AWS), AVSQP, INP(float, 16), INP(float, 18), WSP(bf16_t, WS_MIX), (gu >> 3) * 128, gu & 7, (char*)lds, wave0);
                    }
                    if (rep == 0 && (bx < G / 2 || G < 2)) {
                        const int na = G < 2 ? 1 : G / 2;
                        for (int pu = bx; pu < 128; pu += na) {
#pragma unroll 1
                            for (int half = 0; half < 2; ++half) {
                                const int j = pu >> 5, qb = half == 0 ? 7 - j : j, bh = pu & 31, b = bh >> 3, h = bh & 7;
                                const size_t rb = (size_t)b * SEQ;
                                sba::attn_unit(WSP(bf16_t, WS_T0) + (rb + qb * 256) * 1024 + h * HD, WSP(bf16_t, WS_T1) + rb * 1024 + h * HD, WSP(bf16_t, WS_T2) + rb * 1024 + h * HD,
                                               WSP(bf16_t, WS_MIX) + (rb + qb * 256) * DM + 1024 + h * HD, qb * 256, INP(float, 15)[h] * LOG2E, (char*)lds, wave0);
                            }
                        }
                    }
                    if (bx < MS) {
                        const int row = MP + bx, b = bx >> 2, p = bx & 3;
                        const bf16_t* T3 = WSP(bf16_t, WS_T3); const bf16_t* T4 = WSP(bf16_t, WS_T4); bf16_t* MIX = WSP(bf16_t, WS_MIX);
                        const float* AVSQ = AVSQP; const float* a_v_norm_g = INP(float, 16); const float* a_ws = INP(float, 17); const float* a_bs = INP(float, 18); float* dout = DOUT;
                        for (int c = tid; c < AW; c += 512) {
                            const int gi = c >> 7; float mixv = a_bs[gi * 128 + p];
                            for (int q = 0; q <= p; ++q) {
                                const int rq = MP + b * 4 + q;
                                const float avn = __uint_as_float((unsigned)T4[(size_t)rq * 1024 + c] << 16) * __builtin_amdgcn_rsqf(AVSQ[rq] * (1.0f / AW) + EPS) * a_v_norm_g[c];
                                mixv += a_ws[(size_t)gi * 16384 + p * 128 + q] * avn;
                                if (q == p) dout[O_AV + (size_t)bx * 1024 + c] = avn;
                            }
                            const float au = __uint_as_float((unsigned)T3[(size_t)row * 1024 + c] << 16);
                            MIX[(size_t)row * DM + c] = (bf16_t)(cvt_pk_bf16(au * mixv, 0.f) & 0xffffu);
                        }
                    }
                    {
                        const bf16_t* T0 = WSP(bf16_t, WS_T0); const float* cache_k = INP(float, 2); const float* cache_v = INP(float, 3); const int* page_table = INP(int, 6);
                        const float* sb_bias = INP(float, 15); float* PO = WSP(float, WS_PO); float* PP = WSP(float, WS_PP); unsigned* qctr = CTLP + CW_QCTR + 64 * rep;
                        for (;;) {
                            int item = 0;
                            if (lane == 0) item = (int)atomicAdd(qctr, 1u);
                            item = __builtin_amdgcn_readfirstlane(item);
                            if (item >= 64 * 32) break;
                            const int h = item & 7, run = (item >> 3) & 31, b = item >> 8, bh = b * 8 + h, pidx = bh * 32 + run, hi = lane >> 5, l32 = lane & 31;
                            f32x4 qv[4];
#pragma unroll
                            for (int qi = 0; qi < 4; ++qi) { const u32x2 w = *(const u32x2*)(T0 + (size_t)(MP + b * 4 + qi) * 1024 + h * HD + 4 * l32);
                                qv[qi] = (f32x4){bf_lo(w.x), bf_hi(w.x), bf_lo(w.y), bf_hi(w.y)}; }
                            const float bias2 = sb_bias[h] * LOG2E;
                            f32x4 o[4] = {};
                            float C = 1.f;
                            const int qsel = (lane >> 3) & 3;
                            int phys[4];
#pragma unroll
                            for (int p4 = 0; p4 < 4; ++p4) phys[p4] = page_table[b * NPAGES + run * 4 + p4];
                            const size_t lane_off = (size_t)h * HD + 4 * l32;
#define SA_LOAD(KK, VV, ci) do { const int _pg = (ci) >> 4, _c8 = (ci) & 15; const int _ph = _pg == 0 ? phys[0] : (_pg == 1 ? phys[1] : (_pg == 2 ? phys[2] : phys[3])); \
    const size_t _base = ((size_t)_ph * PAGE) * (NH * HD) + lane_off; _Pragma("unroll") for (int s_ = 0; s_ < 4; ++s_) { const int tok = _c8 * 8 + 7 - 2 * s_ - hi; \
        KK[s_] = __builtin_nontemporal_load((const f32x4*)(cache_k + _base + (size_t)tok * (NH * HD))); VV[s_] = __builtin_nontemporal_load((const f32x4*)(cache_v + _base + (size_t)tok * (NH * HD))); } } while (0)
#define SA_COMPUTE(KK, VV) do { _Pragma("unroll") for (int s_ = 0; s_ < 4; ++s_) { \
        float d0 = (KK[s_][0] * qv[0][0] + KK[s_][1] * qv[0][1]) + (KK[s_][2] * qv[0][2] + KK[s_][3] * qv[0][3]); \
        float d1 = (KK[s_][0] * qv[1][0] + KK[s_][1] * qv[1][1]) + (KK[s_][2] * qv[1][2] + KK[s_][3] * qv[1][3]); \
        float d2 = (KK[s_][0] * qv[2][0] + KK[s_][1] * qv[2][1]) + (KK[s_][2] * qv[2][2] + KK[s_][3] * qv[2][3]); \
        float d3 = (KK[s_][0] * qv[3][0] + KK[s_][1] * qv[3][1]) + (KK[s_][2] * qv[3][2] + KK[s_][3] * qv[3][3]); \
        float ka = b4 ? d2 : d0, kb2 = b4 ? d3 : d1, sa = b4 ? d0 : d2, sb = b4 ? d1 : d3; \
        ka += xchg16(sa, b4); kb2 += xchg16(sb, b4);                                    \
        float kc = b3 ? kb2 : ka, sc2 = b3 ? ka : kb2; \
        kc += dppf<0x128>(sc2);                                                          \
        kc += dppf<0xB1>(kc); kc += dppf<0x4E>(kc); kc += dppf<0x141>(kc);               \
        const float e = fast_exp2(kc + bias2), f = 1.f + e; const float fo = xchg32(f, hi); const float Cn = C * f * fo; \
        const float A = e * fast_rcp(hi ? Cn : C * f); C = Cn; \
        const float Ab = dppf<0x128>(A); const float alo = b3 ? Ab : A, ahi = b3 ? A : Ab;     \
        const float olo = xchg16(alo, b4), ohi = xchg16(ahi, b4);                       \
        const float A0 = b4 ? olo : alo, A1 = b4 ? ohi : ahi, A2 = b4 ? alo : olo, A3 = b4 ? ahi : ohi; \
        o[0] += VV[s_] * A0; o[1] += VV[s_] * A1; o[2] += VV[s_] * A2; o[3] += VV[s_] * A3; } } while (0)
                            const bool b4 = (lane & 16) != 0, b3 = (lane & 8) != 0;
                            f32x4 kA[4], vA[4], kB[4], vB[4];
                            SA_LOAD(kA, vA, 63);
                            for (int ci = 63; ci >= 1; ci -= 2) {
                                SA_LOAD(kB, vB, ci - 1);
                                SA_COMPUTE(kA, vA);
                                if (ci >= 2) SA_LOAD(kA, vA, ci - 2);
                                SA_COMPUTE(kB, vB);
                            }
#undef SA_LOAD
#undef SA_COMPUTE
#pragma unroll
                            for (int qi = 0; qi < 4; ++qi) {
#pragma unroll
                                for (int j = 0; j < 4; ++j) o[qi][j] += xchg32(o[qi][j], hi);
                                if (hi == 0) *(f32x4*)(PO + ((size_t)pidx * 4 + qi) * HD + 4 * l32) = o[qi];
                            }
                            if ((lane & 39) == 0) PP[(size_t)pidx * 4 + qsel] = C;
                        }
                    }
                }
                xcd_barrier(bar);
                if (bx0 >= G0 - 32) {
                    FRESH_IDS();
                    const int cw_ = (bx0 - (G0 - 32)) * 8 + wave0;
                    const bf16_t* T0 = WSP(bf16_t, WS_T0); const bf16_t* T1 = WSP(bf16_t, WS_T1); const bf16_t* T2 = WSP(bf16_t, WS_T2); bf16_t* MIX = WSP(bf16_t, WS_MIX);
                    const float* sb_bias = INP(float, 15); const float* PO = WSP(float, WS_PO); const float* PP = WSP(float, WS_PP);
                    for (int bhi = cw_; bhi < 256; bhi += 256) {
                        const int bh = bhi >> 2, i = bhi & 3, b = bh >> 3, h = bh & 7; const float bias2 = sb_bias[h] * LOG2E;
                        float pp[32]; f32x2 po[32];
#pragma unroll
                        for (int run = 0; run < 32; ++run) { const size_t it = (size_t)bh * 32 + run; pp[run] = PP[it * 4 + i]; po[run] = *(const f32x2*)(PO + (it * 4 + i) * HD + 2 * lane); }
                        const size_t rq = (size_t)(MP + b * 4 + i) * 1024 + h * HD + 2 * lane;
                        const unsigned qw = *(const unsigned*)(T0 + rq); const float q0 = bf_lo(qw), q1 = bf_hi(qw);
                        float o0 = 0.f, o1 = 0.f, P = 1.f;
#pragma unroll
                        for (int j = 2; j >= 0; --j) {
                            if (j < i) {
                                const size_t rk = (size_t)(MP + b * 4 + j) * 1024 + h * HD + 2 * lane;
                                const unsigned kw = *(const unsigned*)(T1 + rk), vw = *(const unsigned*)(T2 + rk);
                                const float z = wave_sum(q0 * bf_lo(kw) + q1 * bf_hi(kw)) + bias2;
                                const float e = fast_exp2(z); P *= (1.f + e);
                                const float A = e / P; o0 += A * bf_lo(vw); o1 += A * bf_hi(vw);
                            }
                        }
                        float scale = 1.f / P;
#pragma unroll
                        for (int run = 31; run >= 0; --run) { o0 += po[run][0] * scale; o1 += po[run][1] * scale; scale = scale / pp[run]; }
                        *(unsigned*)(MIX + (size_t)(MP + b * 4 + i) * DM + 1024 + h * HD + 2 * lane) = cvt_pk_bf16(o0, o1);
                    }
                    GATE_ARRIVE(6);
                }
                {
                    pg8::Gemm g{WSP(bf16_t, WS_MIX), WSP(bf16_t, WS_WOUTE), DM * 2, DM * 2, DM, 0};
                    pg8::StaticOrder S; S.init(32, 8, G0, bx0, 0, 32);
                    pg8::EpiRes E{WSP(float, WS_Y), WSP(float, WS_Y), WSP(bf16_t, WS_XN), WSP(float, WS_PART), 1.0f, WSP(float, WS_SLAB), WSP(unsigned char, WS_XNQ), sqx_of(1)};
                    pg8::gemm_phase<pg8::EpiRes>(L, g, S, E, wave0);
                    if (bx0 < 64) {
                        GATE_WAIT(6, 32);
                        pg8::StaticOrder S2; S2.init(32, 8, G0, bx0, 8, 32); S2.i0 = (256 - bx0 + G0 - 1) / G0;
                        pg8::gemm_phase<pg8::EpiRes>(L, g, S2, E, wave0);
                    } else if (bx0 < G0 - 32) CONV_TAIL(50688, 53688, (bx0 - 64) * 8 + wave0, (G0 - 96) * 8);
                }
                xcd_barrier(bar);
            } else {
                {
                    pg8::Gemm g{WSP(bf16_t, WS_XN), WSP(bf16_t, WS_WINO), DM * 2, DM * 2, DM, 0};
                    pg8::StaticOrder S; S.init(32, 16, G0, bx0, 8, 32);
                    pg8::EpiInOdd E{SUMSQP(4), WSP(bf16_t, WS_T0), WSP(bf16_t, WS_T1), WSP(bf16_t, WS_T2), DOUT, WSP(float, WS_SLAB)};
                    if (bx0 >= G0 - 16) { const int w_ = (bx0 - (G0 - 16)) * 8 + wave0; const int lane_ = fresh_tid(wave0) & 63;
                        fixup_tasks(WSP(float, WS_PART), WSP(float, WS_SLAB), 0, WSP(float, WS_Y), WSP(float, WS_Y), WSP(bf16_t, WS_XN), SUMSQP(4), w_, 128, lane_);
                        GATE_ARRIVE(5); }
                    pg8::gemm_phase<pg8::EpiInOdd>(L, g, S, E, wave0, CTLP + CW_GATE + 64 * 5, 16u);
                    if (bx0 >= 128 && bx0 < G0 - 16) CONV_TAIL(79840, 80736, (bx0 - 128) * 8 + wave0, (G0 - 144) * 8);
                }
                xcd_barrier(bar);
                {
                    FRESH_IDS();
                    const bf16_t* T0 = WSP(bf16_t, WS_T0); const bf16_t* T1 = WSP(bf16_t, WS_T1); const bf16_t* T2 = WSP(bf16_t, WS_T2); bf16_t* T3 = WSP(bf16_t, WS_T3); bf16_t* MIX = WSP(bf16_t, WS_MIX);
                    const float* d_conv_w = INP(float, 23);
                    if (bx < 128) {
                        const int it = bx * 512 + tid;
                        const int grp = it >> 14, run = (it >> 5) & 511, c = grp * 256 + (it & 31) * 8, R0 = run * 16, t0 = R0 & (SEQ - 1);
                        if (grp == 0) pool_run<2>(T0, T3, R0, t0, c); else if (grp == 1) pool_run<4>(T0, T3, R0, t0, c); else if (grp == 2) pool_run<8>(T0, T3, R0, t0, c); else pool_run<16>(T0, T3, R0, t0, c);
                    } else if (bx >= NPAN * 4) {
                        for (int it = (bx - NPAN * 4) * 512 + tid; it < 512 * 128; it += (G - NPAN * 4) * 512) {
                            const int run = it >> 7, c = (it & 127) * 8, R0 = run * 16, t0 = R0 & (SEQ - 1);
                            conv_run8(T1, T2, d_conv_w, MIX, R0, t0, c); conv_run8(T1, T2, d_conv_w, MIX, R0 + 8, t0 + 8, c);
                        }
                    }
                    if (bx >= 128 && bx < NPAN * 4) {
                        const int g_ = bx - 128, win = 2 << g_;
                        const float* SP = WSP(float, WS_SLAB); const float* SQ = SUMSQP(4); const float* state_pool = INP(float, 4); const float* state_conv = INP(float, 5); float* dout = DOUT;
                        LAS float* XCs = (LAS float*)L; LAS float* GGs = XCs + 32 * 256; LAS float* GBs = GGs + 32 * 256;
                        for (int q = tid; q < MS * 32; q += 512) {
                            const int r = q >> 5, cc = (q & 31) * 8, c = g_ * 256 + cc, gcol = 2048 + 256 * (c >> 7) + (c & 127);
                            const float rs = __builtin_amdgcn_rsqf(SQ[MP + r] * (1.0f / DM) + EPS);
                            float xc[8], gc[8], gh[8], gb[8];
                            sp_sum8(SP, r, c, xc); sp_sum8(SP, r, gcol, gc); sp_sum8(SP, r, gcol + 128, gh); sp_sum8(SP, r, 1024 + c, gb);
#pragma unroll
                            for (int h = 0; h < 2; ++h) {
                                f32x4 a, d, e;
#pragma unroll
                                for (int j = 0; j < 4; ++j) { a[j] = xc[h * 4 + j] * rs; d[j] = gc[h * 4 + j] * gh[h * 4 + j] * rs * rs; e[j] = gb[h * 4 + j] * rs; }
                                *(LAS f32x4*)(XCs + r * 256 + cc + h * 4) = a; *(LAS f32x4*)(GGs + r * 256 + cc + h * 4) = d; *(LAS f32x4*)(GBs + r * 256 + cc + h * 4) = e;
                            }
                        }
                        __syncthreads();
                        for (int q = tid; q < MS * 32; q += 512) {
                            const int sr = q >> 5, cc = (q & 31) * 8, c = g_ * 256 + cc, b = sr >> 2, i = sr & 3, row = MP + sr;
                            float acc[8], self[8], gsum[8], gbv[8];
#pragma unroll
                            for (int h = 0; h < 2; ++h) { const f32x4 a = *(const LAS f32x4*)(XCs + sr * 256 + cc + h * 4), e = *(const LAS f32x4*)(GBs + sr * 256 + cc + h * 4);
#pragma unroll
                                for (int j = 0; j < 4; ++j) { self[h * 4 + j] = a[j]; acc[h * 4 + j] = a[j]; gbv[h * 4 + j] = e[j]; gsum[h * 4 + j] = 0.f; } }
#pragma unroll
                            for (int k = 1; k <= 3; ++k) {
                                const float mk = (k <= i && k < win) ? 1.f : 0.f; const int r2 = sr - (k <= i ? k : 0);
#pragma unroll
                                for (int h = 0; h < 2; ++h) { const f32x4 a = *(const LAS f32x4*)(XCs + r2 * 256 + cc + h * 4);
#pragma unroll
                                    for (int j = 0; j < 4; ++j) acc[h * 4 + j] += a[j] * mk; }
                            }
                            const int lo = 15 + i - (win - 1);
#pragma unroll 5
                            for (int fi = 0; fi < 15; ++fi) {
                                const float* sp = state_pool + ((size_t)b * 15 + fi) * 1024 + c; const f32x4 a = *(const f32x4*)sp, d = *(const f32x4*)(sp + 4); const float mk = fi >= lo ? 1.f : 0.f;
#pragma unroll
                                for (int j = 0; j < 4; ++j) { acc[j] += a[j] * mk; acc[4 + j] += d[j] * mk; }
                            }
#pragma unroll
                            for (int j = 0; j < 8; ++j) dout[O_PS + ((size_t)b * 15 + 11 + i) * 1024 + c + j] = self[j];
#pragma unroll
                            for (int k = 0; k < 3; ++k) {
                                const int gi = i - 2 + k; float gg[8];
                                if (gi >= 0) {
#pragma unroll
                                    for (int h = 0; h < 2; ++h) { const f32x4 d = *(const LAS f32x4*)(GGs + (b * 4 + gi) * 256 + cc + h * 4);
#pragma unroll
                                        for (int j = 0; j < 4; ++j) gg[h * 4 + j] = d[j]; }
                                    if (k == 2 && i >= 2) {
#pragma unroll
                                        for (int j = 0; j < 8; ++j) dout[O_CS + ((size_t)b * 2 + (i - 2)) * 1024 + c + j] = gg[j]; }
                                } else { const float* sp = state_conv + ((size_t)b * 2 + (gi + 2)) * 1024 + c;
#pragma unroll
                                    for (int j = 0; j < 8; ++j) gg[j] = sp[j]; }
                                const f32x4 w0 = *(const f32x4*)(d_conv_w + k * 1024 + c), w1 = *(const f32x4*)(d_conv_w + k * 1024 + c + 4);
#pragma unroll
                                for (int j = 0; j < 4; ++j) { gsum[j] += gg[j] * w0[j]; gsum[4 + j] += gg[4 + j] * w1[j]; }
                            }
                            const float ic = 1.0f / (float)win;
                            u32x4 wp, wd;
                            wp.x = cvt_pk_bf16(acc[0] * ic - self[0], acc[1] * ic - self[1]); wp.y = cvt_pk_bf16(acc[2] * ic - self[2], acc[3] * ic - self[3]);
                            wp.z = cvt_pk_bf16(acc[4] * ic - self[4], acc[5] * ic - self[5]); wp.w = cvt_pk_bf16(acc[6] * ic - self[6], acc[7] * ic - self[7]);
                            wd.x = cvt_pk_bf16(gbv[0] * gsum[0], gbv[1] * gsum[1]); wd.y = cvt_pk_bf16(gbv[2] * gsum[2], gbv[3] * gsum[3]);
                            wd.z = cvt_pk_bf16(gbv[4] * gsum[4], gbv[5] * gsum[5]); wd.w = cvt_pk_bf16(gbv[6] * gsum[6], gbv[7] * gsum[7]);
                            *(u32x4*)(T3 + (size_t)row * 1024 + c) = wp;
                            *(u32x4*)(MIX + (size_t)row * DM + 1024 + c) = wd;
                        }
                    }
                }
                if (bx0 < NPAN * 4) {
                    asm volatile("s_waitcnt vmcnt(0)" ::: "memory"); __syncthreads();
                    pg8::Gemm g{WSP(bf16_t, WS_T3), WSP(bf16_t, WS_CWGT), 1024 * 2, 256 * 2, 256, 256 * 2};
                    pg8::StaticOrder S; S.init(NPAN, 4, G0, bx0, 0, 4); S.dpm = bx0 < 128 ? (bx0 & 31) : 32; S.dpn = bx0 < 128 ? (bx0 >> 5) : bx0 - 128;
                    pg8::EpiPool E{WSP(bf16_t, WS_MIX), INP(float, 22)};
                    pg8::gemm_phase<pg8::EpiPool>(L, g, S, E, wave0);
                } else CONV_TAIL(78848, 79840, (bx0 - NPAN * 4) * 8 + wave0, (G0 - NPAN * 4) * 8);
                xcd_barrier(bar);
                {
                    pg8::Gemm g{WSP(bf16_t, WS_MIX), WSP(bf16_t, WS_WOUTO), DM * 2, DM * 2, DM, 0};
                    pg8::StaticOrder S; S.init(32, 8, G0, bx0, 8, 32);
                    pg8::EpiRes E{WSP(float, WS_Y), WSP(float, WS_Y), WSP(bf16_t, WS_XN), WSP(float, WS_PART), 1.0f, WSP(float, WS_SLAB), WSP(unsigned char, WS_XNQ), sqx_of(3)};
                    pg8::gemm_phase<pg8::EpiRes>(L, g, S, E, wave0);
                    if (bx0 >= 64) CONV_TAIL(39424, 41924, (bx0 - 64) * 8 + wave0, (G0 - 64) * 8);
                }
                xcd_barrier(bar);
            }
        }
    }
}

extern "C" void kernel_launch(void* const* d_in, const int* in_sizes, int n_in, void* d_out, int out_size, void* d_ws, size_t ws_size, hipStream_t stream) {
    static int grid = 0;
    if (grid == 0) {
        if (n_in != 24 || ws_size < WS_END || out_size != (int)O_END) { fprintf(stderr, "kernel_launch: unexpected problem (n_in %d, out %d, ws %zu)\n", n_in, out_size, ws_size); grid = -1; return; }
        int dev = 0, cus = 0, per_cu = 0;
        if (hipGetDevice(&dev) != hipSuccess || hipDeviceGetAttribute(&cus, hipDeviceAttributeMultiprocessorCount, dev) != hipSuccess) { grid = -1; return; }
        if (hipFuncSetAttribute((const void*)mega_fwd, hipFuncAttributeMaxDynamicSharedMemorySize, LDS_BYTES) != hipSuccess) { fprintf(stderr, "kernel_launch: hipFuncSetAttribute failed\n"); grid = -1; return; }
        if (hipOccupancyMaxActiveBlocksPerMultiprocessor(&per_cu, (const void*)mega_fwd, 512, LDS_BYTES) != hipSuccess || per_cu < 1) { fprintf(stderr, "kernel_launch: occupancy query says %d\n", per_cu); }
        (void)hipGetLastError();
        grid = cus;
    }
    if (grid < 0) return;
    (void)hipMemsetAsync((char*)d_ws + WS_CTL, 0, CTL_BYTES, stream);
    Args a{};
    for (int i = 0; i < 24; ++i) a.in[i] = d_in[i];
    a.out = (float*)d_out; a.ws = (unsigned char*)d_ws;
    hipLaunchKernelGGL(mega_fwd, dim3(grid), dim3(512), LDS_BYTES, stream, a);
}
```
